# Optimizing an MI355X kernel written in HIP

```python
import jax, jax.numpy as jnp
from jax import lax
import numpy as np

D_MODEL = 1024
BATCH = 8
SEQ = 2048
DEPTH = 1
DEC_BATCH = 128
DEC_SEQ = 1
PAST_LEN = 2048
PAGE_SIZE = 128

POOL_WIDTH = D_MODEL // 2
POOL_WINDOWS = (2, 4, 8, 16)
POOL_GROUPS = len(POOL_WINDOWS)
POOL_GC = POOL_WIDTH // POOL_GROUPS
POOL_STATE = max(POOL_WINDOWS) - 1
ATTN_WIDTH = D_MODEL - POOL_WIDTH
HEAD_DIM = 64
N_HEADS = ATTN_WIDTH // HEAD_DIM
MOBA_BLOCK = 256
MOBA_TOPK = 3
QBLK = 32
ROPE_THETA = 10000.0
MEM_LEN = 256
MEM_HEADS = 4
MEM_HEAD_DIM = D_MODEL // MEM_HEADS
D_FF = 4 * D_MODEL
EPS = 1e-6
NEG = -1e30

kernel_name = "hymba_pool_moba_memxattn_step"


def rmsnorm(x, g):
    xf = x.astype(jnp.float32)
    y = xf * lax.rsqrt(jnp.mean(xf * xf, axis=-1, keepdims=True) + EPS)
    return (y * g.astype(jnp.float32)).astype(x.dtype)


def rope(x, pos):
    half = x.shape[-1] // 2
    inv_freq = ROPE_THETA ** (-jnp.arange(half, dtype=jnp.float32) / half)
    ang = pos.astype(jnp.float32)[:, None] * inv_freq[None, :]
    cos = jnp.cos(ang)[None, :, None, :]
    sin = jnp.sin(ang)[None, :, None, :]
    xf = x.astype(jnp.float32)
    x1, x2 = xf[..., :half], xf[..., half:]
    return jnp.concatenate([x1 * cos - x2 * sin, x2 * cos + x1 * sin], axis=-1).astype(x.dtype)


def pool_mix(u, prev, pos0, w_pool, s_pool):
    B, S, _ = u.shape
    ext = jnp.concatenate([prev, u], axis=1)
    extf = ext.astype(jnp.float32)
    cs = jnp.concatenate([jnp.zeros_like(extf[:, :1]), jnp.cumsum(extf, axis=1)], axis=1)
    pos = pos0 + jnp.arange(S)
    outs = []
    for g, w in enumerate(POOL_WINDOWS):
        sl = slice(g * POOL_GC, (g + 1) * POOL_GC)
        wsum = cs[:, POOL_STATE + 1:, sl] - cs[:, POOL_STATE + 1 - w:POOL_STATE + 1 - w + S, sl]
        cnt = jnp.minimum(w, pos + 1).astype(jnp.float32)[None, :, None]
        outs.append(wsum / cnt - extf[:, POOL_STATE:, sl])
    d = jnp.stack(outs, axis=2)
    mixed = jnp.einsum('bsgc,gcd->bsgd', d, w_pool.astype(jnp.float32)).reshape(B, S, POOL_WIDTH)
    out = (mixed * s_pool.astype(jnp.float32)).astype(u.dtype)
    return out, ext[:, -POOL_STATE:]


def moba_attend(q, k, v, q_pos):
    B, Q, H, D = q.shape
    L = k.shape[1]
    nb = -(-L // MOBA_BLOCK)
    pad = nb * MOBA_BLOCK - L
    kb = jnp.pad(k, ((0, 0), (0, pad), (0, 0), (0, 0))).reshape(B, nb, MOBA_BLOCK, H, D).transpose(0, 3, 1, 2, 4)
    vb = jnp.pad(v, ((0, 0), (0, pad), (0, 0), (0, 0))).reshape(B, nb, MOBA_BLOCK, H, D).transpose(0, 3, 1, 2, 4)
    kmean = jnp.mean(kb.astype(jnp.float32), axis=3)
    ksel = min(MOBA_TOPK, nb)
    J = ksel + 1
    scale = D ** -0.5
    bi = jnp.arange(B)[:, None, None, None]
    hi = jnp.arange(H)[None, :, None, None]
    offs = jnp.arange(MOBA_BLOCK)

    def chunk(args):
        qc, pc = args
        C = qc.shape[1]
        qb = pc // MOBA_BLOCK
        s = jnp.einsum('bchd,bhnd->bhcn', qc.astype(jnp.float32), kmean)
        fully_past = jnp.arange(nb)[None, :] < qb[:, None]
        s = jnp.where(fully_past[None, None], s, NEG)
        _, sel = lax.top_k(s, ksel)
        own = jnp.broadcast_to(qb[None, None, :, None], sel.shape[:3] + (1,))
        idx = jnp.concatenate([sel, own], axis=-1)
        ok_blk = jnp.concatenate([sel < qb[None, None, :, None], jnp.ones_like(own, dtype=bool)], axis=-1)
        kg = kb[bi, hi, idx]
        vg = vb[bi, hi, idx]
        kpos = idx[..., None] * MOBA_BLOCK + offs
        ok = ok_blk[..., None] & (kpos <= pc[None, None, :, None, None])
        logits = jnp.einsum('bchd,bhcjkd->bhcjk', qc, kg).astype(jnp.float32) * scale
        logits = jnp.where(ok, logits, NEG)
        p = jax.nn.softmax(logits.reshape(B, H, C, J * MOBA_BLOCK), axis=-1).reshape(B, H, C, J, MOBA_BLOCK)
        return jnp.einsum('bhcjk,bhcjkd->bchd', p.astype(v.dtype), vg)

    C = min(QBLK, Q)
    nq = -(-Q // C)
    padq = nq * C - Q
    qp = jnp.pad(q, ((0, 0), (0, padq), (0, 0), (0, 0))).reshape(B, nq, C, H, D).transpose(1, 0, 2, 3, 4)
    pp = jnp.pad(q_pos, (0, padq), mode='edge').reshape(nq, C)
    out = lax.map(chunk, (qp, pp))
    return out.transpose(1, 0, 2, 3, 4).reshape(B, nq * C, H, D)[:, :Q]


def mem_kv(mem, g_mem, w_ck, w_cv):
    B = mem.shape[0]
    m = rmsnorm(mem, g_mem)
    mk = (m @ w_ck).reshape(B, MEM_LEN, MEM_HEADS, MEM_HEAD_DIM)
    mv = (m @ w_cv).reshape(B, MEM_LEN, MEM_HEADS, MEM_HEAD_DIM)
    return mk, mv


def cross_attend(h, mk, mv, w_cq, w_co):
    B, S, _ = h.shape
    q = (h @ w_cq).reshape(B, S, MEM_HEADS, MEM_HEAD_DIM)
    logits = jnp.einsum('bshd,bmhd->bhsm', q, mk).astype(jnp.float32) * (MEM_HEAD_DIM ** -0.5)
    p = jax.nn.softmax(logits, axis=-1)
    o = jnp.einsum('bhsm,bmhd->bshd', p.astype(mv.dtype), mv).reshape(B, S, D_MODEL)
    return o @ w_co


def decoder_layer(x, pos0, k_past, v_past, pool_prev, mk, mv,
                  g_mix, w_in, w_pool, s_pool, w_out, g_cross, w_cq, w_co, g_mlp, w_up, w_down):
    B, S, _ = x.shape
    pos = pos0 + jnp.arange(S)
    h = rmsnorm(x, g_mix)
    proj = h @ w_in
    o = POOL_WIDTH
    u = proj[..., :o]
    q = rope(proj[..., o:o + ATTN_WIDTH].reshape(B, S, N_HEADS, HEAD_DIM), pos)
    k = rope(proj[..., o + ATTN_WIDTH:o + 2 * ATTN_WIDTH].reshape(B, S, N_HEADS, HEAD_DIM), pos)
    v = proj[..., o + 2 * ATTN_WIDTH:].reshape(B, S, N_HEADS, HEAD_DIM)
    pool_out, pool_new = pool_mix(u, pool_prev, pos0, w_pool, s_pool)
    k_all = jnp.concatenate([k_past, k], axis=1)
    v_all = jnp.concatenate([v_past, v], axis=1)
    attn = moba_attend(q, k_all, v_all, pos).reshape(B, S, ATTN_WIDTH)
    x = x + jnp.concatenate([pool_out, attn], axis=-1) @ w_out
    x = x + cross_attend(rmsnorm(x, g_cross), mk, mv, w_cq, w_co)
    hm = rmsnorm(x, g_mlp)
    x = x + jnp.square(jax.nn.relu(hm @ w_up)) @ w_down
    return x, k, v, pool_new


def setup_inputs(seed: int = 0) -> dict:
    key = jax.random.key(seed)
    ks = jax.random.split(key, 32)
    f32 = jnp.float32

    def nrm(k, shape, scale=1.0):
        return jax.random.normal(k, shape, f32) * scale

    def gain(k, shape):
        return 1.0 + 0.02 * jax.random.normal(k, shape, f32)

    n_pages = PAST_LEN // PAGE_SIZE
    n_used = DEC_BATCH * n_pages
    n_phys = (n_used * 5) // 4
    perm = jax.random.permutation(ks[0], n_phys)
    page_table = perm[:n_used].reshape(DEC_BATCH, n_pages).astype(jnp.int32)
    d = D_MODEL
    return {
        "x_prompt": nrm(ks[1], (BATCH, SEQ, d)),
        "x_sample": nrm(ks[2], (DEC_BATCH, DEC_SEQ, d)),
        "cache_k": nrm(ks[3], (DEPTH, n_phys, PAGE_SIZE, N_HEADS, HEAD_DIM)),
        "cache_v": nrm(ks[4], (DEPTH, n_phys, PAGE_SIZE, N_HEADS, HEAD_DIM)),
        "cache_mem_k": nrm(ks[5], (DEPTH, DEC_BATCH, MEM_LEN, MEM_HEADS, MEM_HEAD_DIM)),
        "cache_mem_v": nrm(ks[6], (DEPTH, DEC_BATCH, MEM_LEN, MEM_HEADS, MEM_HEAD_DIM)),
        "state_pool": nrm(ks[7], (DEPTH, DEC_BATCH, POOL_STATE, POOL_WIDTH)),
        "page_table": page_table,
        "mem_prompt": nrm(ks[8], (BATCH, MEM_LEN, d)),
        "g_mix": gain(ks[9], (DEPTH, d)),
        "w_in": nrm(ks[10], (DEPTH, d, POOL_WIDTH + 3 * ATTN_WIDTH), d ** -0.5),
        "w_pool": nrm(ks[11], (DEPTH, POOL_GROUPS, POOL_GC, POOL_GC), POOL_GC ** -0.5),
        "s_pool": gain(ks[12], (DEPTH, POOL_WIDTH)),
        "w_out": nrm(ks[13], (DEPTH, d, d), d ** -0.5),
        "g_cross": gain(ks[14], (DEPTH, d)),
        "g_mem": gain(ks[15], (DEPTH, d)),
        "w_cq": nrm(ks[16], (DEPTH, d, d), d ** -0.5),
        "w_ck": nrm(ks[17], (DEPTH, d, d), d ** -0.5),
        "w_cv": nrm(ks[18], (DEPTH, d, d), d ** -0.5),
        "w_co": nrm(ks[19], (DEPTH, d, d), d ** -0.5),
        "g_mlp": gain(ks[20], (DEPTH, d)),
        "w_up": nrm(ks[21], (DEPTH, d, D_FF), d ** -0.5),
        "w_down": nrm(ks[22], (DEPTH, D_FF, d), D_FF ** -0.5),
        "g_final": gain(ks[23], (d,)),
    }


def reference(x_prompt, x_sample, cache_k, cache_v, cache_mem_k, cache_mem_v, state_pool, page_table,
              mem_prompt, g_mix, w_in, w_pool, s_pool, w_out, g_cross, g_mem, w_cq, w_ck, w_cv, w_co,
              g_mlp, w_up, w_down, g_final):
    bp = x_prompt.shape[0]
    bs = x_sample.shape[0]
    past_len = page_table.shape[1] * cache_k.shape[2]
    xp, xs = x_prompt, x_sample
    kp_l, vp_l, poolp_l, mkp_l, mvp_l, ks_l, vs_l, pools_l = [], [], [], [], [], [], [], []
    for l in range(DEPTH):
        lp = (g_mix[l], w_in[l], w_pool[l], s_pool[l], w_out[l], g_cross[l], w_cq[l], w_co[l],
              g_mlp[l], w_up[l], w_down[l])
        mk_p, mv_p = mem_kv(mem_prompt, g_mem[l], w_ck[l], w_cv[l])
        empty = jnp.zeros((bp, 0, N_HEADS, HEAD_DIM), xp.dtype)
        pool0 = jnp.zeros((bp, POOL_STATE, POOL_WIDTH), xp.dtype)
        xp, kp, vp, poolp = decoder_layer(xp, 0, empty, empty, pool0, mk_p, mv_p, *lp)
        past_k = cache_k[l][page_table].reshape(bs, past_len, N_HEADS, HEAD_DIM)
        past_v = cache_v[l][page_table].reshape(bs, past_len, N_HEADS, HEAD_DIM)
        xs, ks, vs, pools = decoder_layer(xs, past_len, past_k, past_v, state_pool[l],
                                          cache_mem_k[l], cache_mem_v[l], *lp)
        kp_l.append(kp); vp_l.append(vp); poolp_l.append(poolp); mkp_l.append(mk_p); mvp_l.append(mv_p)
        ks_l.append(ks); vs_l.append(vs); pools_l.append(pools)
    y_prompt = rmsnorm(xp, g_final)
    y_sample = rmsnorm(xs, g_final)
    return (y_prompt, y_sample, jnp.stack(kp_l), jnp.stack(vp_l), jnp.stack(poolp_l), jnp.stack(mkp_l),
            jnp.stack(mvp_l), jnp.stack(ks_l), jnp.stack(vs_l), jnp.stack(pools_l))
```

```cpp
#include <hip/hip_runtime.h>
#include <cstdio>
#include <cstdint>
#include <cmath>
namespace pg8 {
#define PG8_LAS __attribute__((address_space(3)))
typedef unsigned short bf16_t;
typedef short bf16x8 __attribute__((ext_vector_type(8)));
typedef float f32x4 __attribute__((ext_vector_type(4)));
typedef unsigned u32x4 __attribute__((ext_vector_type(4)));
constexpr int BM = 256, BK = 64, HALF = 128, HTB = HALF * BK * 2  , STAGE_BYTES = 8 * HTB, NXCD = 8, WGM = 8;

__host__ __device__ __forceinline__ int lds_byte(int r, int c) { const int st = (r >> 4) * 2 + (c >> 5), rr = r & 15, cc = c & 31, ob = rr * 64 + cc * 2; return st * 1024 + (ob ^ (((ob >> 9) & 1) << 5)); }
__host__ __device__ __forceinline__ void stage_rc(int b, int& R, int& C) { const int st = b / 1024, sb = b % 1024, swz = sb ^ (((sb >> 9) & 1) << 5); R = (st >> 1) * 16 + swz / 64; C = (st & 1) * 32 + (swz % 64) / 2; }
__host__ __device__ __forceinline__ int perm32(int rho) { const int n = rho >> 4, i = rho & 15; return 8 * (i >> 2) + 4 * n + (i & 3); }

struct Unit { int pm, pn; };
struct Gemm { const bf16_t* A; const bf16_t* Bt; int K, lda, ldb; };

struct StaticOrder {
    int nM, nN, nwg, G, c;
    __host__ __device__ void init(int M, int N, int G_, int c_) { nM = M / BM; nN = N / BM; nwg = nM * nN; G = G_; c = c_; }
    __host__ __device__ bool next(int i, Unit& u) const {
        const long L = (long)i * G + c; if (L >= nwg) return false;
        int wgid = (int)L; { const int q = nwg / NXCD, r = nwg % NXCD, xcd = wgid % NXCD, off = wgid / NXCD; wgid = (xcd < r ? xcd * (q + 1) : r * (q + 1) + (xcd - r) * q) + off; }
        const int nig = WGM * nN, gid = wgid / nig, fm = gid * WGM, gsz = (nM - fm) < WGM ? (nM - fm) : WGM;
        u.pm = fm + ((wgid % nig) % gsz); u.pn = (wgid % nig) / gsz; return true;
    }
    __device__ __forceinline__ void a_ready(const Unit&) const {}
    __device__ __forceinline__ void done(const Unit&) const {}
};

__device__ __forceinline__ unsigned cvt_pk_bf16(float lo, float hi) { unsigned r; asm volatile("v_cvt_pk_bf16_f32 %0, %1, %2" : "=v"(r) : "v"(lo), "v"(hi)); return r; }
typedef float f32x2 __attribute__((ext_vector_type(2)));
__device__ __forceinline__ u32x4 pack8(const f32x4 a, const f32x4 b) { u32x4 w; w.x = cvt_pk_bf16(a[0], a[1]); w.y = cvt_pk_bf16(a[2], a[3]); w.z = cvt_pk_bf16(b[0], b[1]); w.w = cvt_pk_bf16(b[2], b[3]); return w; }
__device__ __forceinline__ unsigned short bf16_1(float v) { return (unsigned short)(cvt_pk_bf16(v, 0.f) & 0xffffu); }


struct EpiQKV {
    static constexpr bool PERM = true, AFTER_DRAIN = false;
    bf16_t *U, *Q, *Kb, *V, *MKB, *MVT; float *QS, *ksum; const float *ropeC, *ropeS;
    float *o_kp, *o_vp, *o_poolp, *o_mk, *o_mv, *o_ks, *o_vs, *o_pools; float qscale;
    __device__ __forceinline__ void operator()(const f32x4 (&acc)[2][2][4][2], const Unit& u, int wr, int wc, int fr, int fq) const {
        const int pm = u.pm, pn = u.pn;
        if (pm >= 65) {
            const int isv = (pn - 8) >> 2, ct = (pn - 8) & 3;
#pragma unroll
            for (int ai = 0; ai < 2; ++ai)
#pragma unroll
                for (int m = 0; m < 4; ++m) { const int mrow = (pm - 65) * 256 + ai * 128 + wr * 64 + m * 16 + fr;
#pragma unroll
                    for (int bj = 0; bj < 2; ++bj) { const int cl = bj * 128 + wc * 32 + 8 * fq, col = ct * 256 + cl; const f32x4 v0 = acc[ai][bj][m][0], v1 = acc[ai][bj][m][1];
                        float* o = (isv ? o_mv : o_mk) + (size_t)mrow * 1024 + col; *(f32x4*)o = v0; *(f32x4*)(o + 4) = v1;
                        if (!isv) { *(u32x4*)(MKB + (size_t)mrow * 1024 + col) = pack8(v0, v1); }
                        else { const int b = mrow >> 8, key = mrow & 255; bf16_t* t = MVT + ((size_t)(b * 4 + ct) * 256 + cl) * 256 + key;
                            t[0 * 256] = bf16_1(v0[0]); t[1 * 256] = bf16_1(v0[1]); t[2 * 256] = bf16_1(v0[2]); t[3 * 256] = bf16_1(v0[3]);
                            t[4 * 256] = bf16_1(v1[0]); t[5 * 256] = bf16_1(v1[1]); t[6 * 256] = bf16_1(v1[2]); t[7 * 256] = bf16_1(v1[3]); } } }
            return;
        }
        const int kind = pn >> 1, half = pn & 1; const bool samp = (pm == 64);
        if (kind == 0) {
#pragma unroll
            for (int ai = 0; ai < 2; ++ai)
#pragma unroll
                for (int m = 0; m < 4; ++m) { const int row = pm * 256 + ai * 128 + wr * 64 + m * 16 + fr;
#pragma unroll
                    for (int bj = 0; bj < 2; ++bj) { const int col = half * 256 + bj * 128 + wc * 32 + 8 * fq; const f32x4 v0 = acc[ai][bj][m][0], v1 = acc[ai][bj][m][1];
                        *(u32x4*)(U + (size_t)row * 512 + col) = pack8(v0, v1);
                        if (!samp) { const int pos = row & 2047; if (pos >= 2033) { float* o = o_poolp + ((size_t)((row >> 11) * 15 + pos - 2033) * 512 + col); *(f32x4*)o = v0; *(f32x4*)(o + 4) = v1; } }
                        else { const int s = row - 16384; if (s < 128) { float* o = o_pools + ((size_t)(s * 15 + 14) * 512 + col); *(f32x4*)o = v0; *(f32x4*)(o + 4) = v1; } } } }
        } else if (kind == 3) {
#pragma unroll
            for (int ai = 0; ai < 2; ++ai)
#pragma unroll
                for (int m = 0; m < 4; ++m) { const int row = pm * 256 + ai * 128 + wr * 64 + m * 16 + fr;
#pragma unroll
                    for (int bj = 0; bj < 2; ++bj) { const int col = half * 256 + bj * 128 + wc * 32 + 8 * fq; const f32x4 v0 = acc[ai][bj][m][0], v1 = acc[ai][bj][m][1];
                        *(u32x4*)(V + (size_t)row * 512 + col) = pack8(v0, v1);
                        if (!samp) { float* o = o_vp + (size_t)row * 512 + col; *(f32x4*)o = v0; *(f32x4*)(o + 4) = v1; }
                        else { const int s = row - 16384; if (s < 128) { float* o = o_vs + (size_t)s * 512 + col; *(f32x4*)o = v0; *(f32x4*)(o + 4) = v1; } } } }
        } else {
            const int head = half * 4 + wc, i0 = 8 * fq, col1 = head * 64 + i0, col2 = col1 + 32;
            f32x4 cs1a = {0.f, 0.f, 0.f, 0.f}, cs1b = cs1a, cs2a = cs1a, cs2b = cs1a;
#pragma unroll
            for (int ai = 0; ai < 2; ++ai)
#pragma unroll
                for (int m = 0; m < 4; ++m) { const int row = pm * 256 + ai * 128 + wr * 64 + m * 16 + fr; const int pos = samp ? 2048 : (row & 2047);
                    const f32x4 c0 = *(const f32x4*)(ropeC + pos * 32 + i0), c1 = *(const f32x4*)(ropeC + pos * 32 + i0 + 4), s0 = *(const f32x4*)(ropeS + pos * 32 + i0), s1 = *(const f32x4*)(ropeS + pos * 32 + i0 + 4);
                    const f32x4 x1a = acc[ai][0][m][0], x1b = acc[ai][0][m][1], x2a = acc[ai][1][m][0], x2b = acc[ai][1][m][1];
                    const f32x4 o1a = x1a * c0 - x2a * s0, o1b = x1b * c1 - x2b * s1, o2a = x2a * c0 + x1a * s0, o2b = x2b * c1 + x1b * s1;
                    if (kind == 1) {
                        *(u32x4*)(Q + (size_t)row * 512 + col1) = pack8(o1a * qscale, o1b * qscale); *(u32x4*)(Q + (size_t)row * 512 + col2) = pack8(o2a * qscale, o2b * qscale);
                        if (samp) { const int s = row - 16384; if (s < 128) { float* o = QS + (size_t)s * 512; *(f32x4*)(o + col1) = o1a; *(f32x4*)(o + col1 + 4) = o1b; *(f32x4*)(o + col2) = o2a; *(f32x4*)(o + col2 + 4) = o2b; } }
                    } else {
                        *(u32x4*)(Kb + (size_t)row * 512 + col1) = pack8(o1a, o1b); *(u32x4*)(Kb + (size_t)row * 512 + col2) = pack8(o2a, o2b);
                        if (!samp) { float* o = o_kp + (size_t)row * 512; *(f32x4*)(o + col1) = o1a; *(f32x4*)(o + col1 + 4) = o1b; *(f32x4*)(o + col2) = o2a; *(f32x4*)(o + col2 + 4) = o2b;
                            cs1a += o1a; cs1b += o1b; cs2a += o2a; cs2b += o2b; }
                        else { const int s = row - 16384; if (s < 128) { float* o = o_ks + (size_t)s * 512; *(f32x4*)(o + col1) = o1a; *(f32x4*)(o + col1 + 4) = o1b; *(f32x4*)(o + col2) = o2a; *(f32x4*)(o + col2 + 4) = o2b; } }
                    } }
            if (kind == 2 && !samp) {
                float cs[16] = {cs1a[0], cs1a[1], cs1a[2], cs1a[3], cs1b[0], cs1b[1], cs1b[2], cs1b[3], cs2a[0], cs2a[1], cs2a[2], cs2a[3], cs2b[0], cs2b[1], cs2b[2], cs2b[3]};
#pragma unroll
                for (int j = 0; j < 16; ++j) { float v = cs[j]; v += __shfl_xor(v, 1); v += __shfl_xor(v, 2); v += __shfl_xor(v, 4); v += __shfl_xor(v, 8); cs[j] = v; }
                if (fr == 0) { float* kp = ksum + (size_t)pm * 512;
#pragma unroll
                    for (int j = 0; j < 8; ++j) { unsafeAtomicAdd(kp + col1 + j, cs[j]); unsafeAtomicAdd(kp + col2 + j, cs[8 + j]); } }
            }
        }
    }
};

struct EpiRes {
    static constexpr bool PERM = true, AFTER_DRAIN = false;
    const float *base_p, *base_s; float *out_p, *out_s; bf16_t* XG; const float* gain; float* rowss;
    __device__ __forceinline__ void operator()(const f32x4 (&acc)[2][2][4][2], const Unit& u, int wr, int wc, int fr, int fq) const {
#pragma unroll
        for (int ai = 0; ai < 2; ++ai)
#pragma unroll
            for (int m = 0; m < 4; ++m) { const int row = u.pm * 256 + ai * 128 + wr * 64 + m * 16 + fr; const bool valid = row < 16384 + 128;
                const float* bp = row < 16384 ? base_p + (size_t)row * 1024 : base_s + (size_t)(row - 16384) * 1024; float* op = row < 16384 ? out_p + (size_t)row * 1024 : out_s + (size_t)(row - 16384) * 1024;
                float ss = 0.f;
                if (valid) {
#pragma unroll
                    for (int bj = 0; bj < 2; ++bj) { const int col = u.pn * 256 + bj * 128 + wc * 32 + 8 * fq;
                        const f32x4 x0 = *(const f32x4*)(bp + col) + acc[ai][bj][m][0], x1 = *(const f32x4*)(bp + col + 4) + acc[ai][bj][m][1];
                        *(f32x4*)(op + col) = x0; *(f32x4*)(op + col + 4) = x1;
                        ss += (x0[0] * x0[0] + x0[1] * x0[1]) + (x0[2] * x0[2] + x0[3] * x0[3]) + (x1[0] * x1[0] + x1[1] * x1[1]) + (x1[2] * x1[2] + x1[3] * x1[3]);
                        if (XG) { const f32x4 g0 = *(const f32x4*)(gain + col), g1 = *(const f32x4*)(gain + col + 4); *(u32x4*)(XG + (size_t)row * 1024 + col) = pack8(x0 * g0, x1 * g1); } }
                }
                ss += __shfl_xor(ss, 16); ss += __shfl_xor(ss, 32);
                if (valid && fq == 0) unsafeAtomicAdd(rowss + row, ss);
            }
    }
};
template <int ACT> struct EpiScale {
    static constexpr bool PERM = true, AFTER_DRAIN = false;
    bf16_t* O; int ldc; const float* rowss; float sc;
    __device__ __forceinline__ void operator()(const f32x4 (&acc)[2][2][4][2], const Unit& u, int wr, int wc, int fr, int fq) const {
#pragma unroll
        for (int ai = 0; ai < 2; ++ai)
#pragma unroll
            for (int m = 0; m < 4; ++m) { const int row = u.pm * 256 + ai * 128 + wr * 64 + m * 16 + fr;
                const float r = __builtin_amdgcn_rsqf(rowss[row] * (1.0f / 1024.0f) + 1e-6f) * sc;
#pragma unroll
                for (int bj = 0; bj < 2; ++bj) { const int col = u.pn * 256 + bj * 128 + wc * 32 + 8 * fq; f32x4 v0 = acc[ai][bj][m][0] * r, v1 = acc[ai][bj][m][1] * r;
                    if (ACT == 1) { v0 = __builtin_elementwise_max(v0, (f32x4){0.f, 0.f, 0.f, 0.f}); v1 = __builtin_elementwise_max(v1, (f32x4){0.f, 0.f, 0.f, 0.f}); v0 = v0 * v0; v1 = v1 * v1; }
                    *(u32x4*)(O + (size_t)row * ldc + col) = pack8(v0, v1); } }
    }
};
struct EpiTile {
    static constexpr bool PERM = true, AFTER_DRAIN = false;
    bf16_t* O; int ldc;
    __device__ __forceinline__ void operator()(const f32x4 (&acc)[2][2][4][2], const Unit&, int wr, int wc, int fr, int fq) const {
#pragma unroll
        for (int ai = 0; ai < 2; ++ai)
#pragma unroll
            for (int m = 0; m < 4; ++m) { const int row = ai * 128 + wr * 64 + m * 16 + fr;
#pragma unroll
                for (int bj = 0; bj < 2; ++bj) { const int col = bj * 128 + wc * 32 + 8 * fq; *(u32x4*)(O + (size_t)row * ldc + col) = pack8(acc[ai][bj][m][0], acc[ai][bj][m][1]); } }
    }
};
struct EpiSoftmaxP {
    static constexpr bool PERM = true, AFTER_DRAIN = true;
    bf16_t* P;
    __device__ __forceinline__ void fused(f32x4 (&acc)[2][2][4][2], const Unit&, int wr, int wc, int fr, int fq, PG8_LAS unsigned char* lds, int, int) const {
        PG8_LAS float* MX = (PG8_LAS float*)lds; PG8_LAS float* SM = (PG8_LAS float*)(lds + 4096);
#pragma unroll
        for (int ai = 0; ai < 2; ++ai)
#pragma unroll
            for (int m = 0; m < 4; ++m) { float mx = -INFINITY;
#pragma unroll
                for (int bj = 0; bj < 2; ++bj)
#pragma unroll
                    for (int n = 0; n < 2; ++n) { const f32x4 x = acc[ai][bj][m][n]; mx = __builtin_fmaxf(mx, __builtin_fmaxf(__builtin_fmaxf(x[0], x[1]), __builtin_fmaxf(x[2], x[3]))); }
                mx = __builtin_fmaxf(mx, __shfl_xor(mx, 16)); mx = __builtin_fmaxf(mx, __shfl_xor(mx, 32));
                if (fq == 0) MX[(ai * 128 + wr * 64 + m * 16 + fr) * 4 + wc] = mx; }
        asm volatile("s_waitcnt lgkmcnt(0)" ::: "memory"); __builtin_amdgcn_s_barrier(); asm volatile("" ::: "memory");
#pragma unroll
        for (int ai = 0; ai < 2; ++ai)
#pragma unroll
            for (int m = 0; m < 4; ++m) { const int r = ai * 128 + wr * 64 + m * 16 + fr; const f32x4 mv = *(const PG8_LAS f32x4*)(MX + r * 4);
                const float rm = __builtin_fmaxf(__builtin_fmaxf(mv[0], mv[1]), __builtin_fmaxf(mv[2], mv[3])); float s = 0.f;
#pragma unroll
                for (int bj = 0; bj < 2; ++bj)
#pragma unroll
                    for (int n = 0; n < 2; ++n) { f32x4 x = acc[ai][bj][m][n]; x[0] = __builtin_amdgcn_exp2f(x[0] - rm); x[1] = __builtin_amdgcn_exp2f(x[1] - rm); x[2] = __builtin_amdgcn_exp2f(x[2] - rm); x[3] = __builtin_amdgcn_exp2f(x[3] - rm);
                        s += (x[0] + x[1]) + (x[2] + x[3]); acc[ai][bj][m][n] = x; }
                s += __shfl_xor(s, 16); s += __shfl_xor(s, 32);
                if (fq == 0) SM[r * 4 + wc] = s; }
        asm volatile("s_waitcnt lgkmcnt(0)" ::: "memory"); __builtin_amdgcn_s_barrier(); asm volatile("" ::: "memory");
#pragma unroll
        for (int ai = 0; ai < 2; ++ai)
#pragma unroll
            for (int m = 0; m < 4; ++m) { const int r = ai * 128 + wr * 64 + m * 16 + fr; const f32x4 sv = *(const PG8_LAS f32x4*)(SM + r * 4);
                const float inv = 1.0f / ((sv[0] + sv[1]) + (sv[2] + sv[3]));
#pragma unroll
                for (int bj = 0; bj < 2; ++bj) { const int col = bj * 128 + wc * 32 + 8 * fq; *(u32x4*)(P + (size_t)r * 256 + col) = pack8(acc[ai][bj][m][0] * inv, acc[ai][bj][m][1] * inv); } }
    }
};
struct OneUnit {
    __device__ __forceinline__ bool next(int i, Unit& u) const { if (i) return false; u.pm = 0; u.pn = 0; return true; }
    __device__ __forceinline__ void a_ready(const Unit&) const {}
    __device__ __forceinline__ void done(const Unit&) const {}
};
struct SchedP1 {
    StaticOrder S1; int G, c;
    __device__ __forceinline__ void init(int G_, int c_) { S1.init(65 * 256, 2048, G_, c_); G = G_; c = c_; }
    __device__ __forceinline__ bool next(int i, Unit& u) const { if (S1.next(i, u)) return true; const long L = (long)i * G + c - 520; if (L < 0 || L >= 64) return false; u.pm = 65 + (int)(L & 7); u.pn = 8 + (int)(L >> 3); return true; }
    __device__ __forceinline__ void a_ready(const Unit&) const {}
    __device__ __forceinline__ void done(const Unit&) const {}
};

template <class Epi, class Sched, bool ALIGN_EPI = false, bool SP2 = false>
__device__ __forceinline__ void gemm_phase(PG8_LAS unsigned char* lds, const Gemm g, const Sched& S, const Epi& E) {
    int tid_ = threadIdx.x; asm volatile("" : "+v"(tid_));
    const int tid = tid_, wid = __builtin_amdgcn_readfirstlane(tid >> 6), lane = tid & 63, wr = wid >> 2, wc = wid & 3, fr = lane & 15, fq = lane >> 4;
    const int K = g.K, nt = K / BK;
    unsigned voffA[2], voffB[2];
#pragma unroll
    for (int i = 0; i < 2; ++i) { int R, C; stage_rc(tid * 16 + i * 8192, R, C); const int Rb = Epi::PERM ? ((R & ~31) + perm32(R & 31)) : R;
        voffA[i] = (unsigned)(R * g.lda + C) * 2u; voffB[i] = (unsigned)(Rb * g.ldb + C) * 2u; }
    const size_t kstep = (size_t)(BK * 2);
    const size_t hstepA = (size_t)HALF * g.lda * 2, hstepB = (size_t)HALF * g.ldb * 2;
    const size_t tstepA = 2 * hstepA, tstepB = 2 * hstepB;
    const unsigned ldsw = (unsigned)wid * 1024u;
    const int aoff = lds_byte(wr * 64 + fr, fq * 8), boff = lds_byte(wc * 32 + fr, fq * 8);
#define PG8_SA(b, h) (((b) * 2 + (h)) * HTB)
#define PG8_SB(b, h) ((4 + (b) * 2 + (h)) * HTB)
#define PG8_STAGE(bufoff, gbase, voff) do { _Pragma("unroll") for (int _i = 0; _i < 2; ++_i) \
        __builtin_amdgcn_global_load_lds((const unsigned*)((const char*)(gbase) + (voff)[_i]), (PG8_LAS unsigned*)(lds + (bufoff) + ldsw + _i * 8192), 16, 0, 0); } while (0)
#define PG8_LDA(dst, b, h) do { _Pragma("unroll") for (int m = 0; m < 4; ++m) _Pragma("unroll") for (int k = 0; k < 2; ++k) dst[m][k] = *(const PG8_LAS bf16x8*)(lds + PG8_SA(b, h) + aoff + m * 2048 + k * 1024); } while (0)
#define PG8_LDB(dst, b, h) do { _Pragma("unroll") for (int n = 0; n < 2; ++n) _Pragma("unroll") for (int k = 0; k < 2; ++k) dst[n][k] = *(const PG8_LAS bf16x8*)(lds + PG8_SB(b, h) + boff + n * 2048 + k * 1024); } while (0)
#define PG8_MMA(ai, bj, At, Bt) do { __builtin_amdgcn_s_setprio(1); _Pragma("unroll") for (int m = 0; m < 4; ++m) _Pragma("unroll") for (int n = 0; n < 2; ++n) _Pragma("unroll") for (int k = 0; k < 2; ++k) \
        acc[ai][bj][m][n] = __builtin_amdgcn_mfma_f32_16x16x32_bf16(Bt[n][k], At[m][k], acc[ai][bj][m][n], 0, 0, 0); __builtin_amdgcn_s_setprio(0); } while (0)
#define PG8_WAIT_V(n) asm volatile("s_waitcnt vmcnt(" #n ")" ::: "memory")
#define PG8_WAIT_L(n) asm volatile("s_waitcnt lgkmcnt(" #n ")" ::: "memory")
#define PG8_BAR __builtin_amdgcn_s_barrier()
#define PG8_SCHED __builtin_amdgcn_sched_barrier(0)
    Unit cur, nxt; int ui = 0;
    if (!S.next(0, cur)) return;
    f32x4 acc[2][2][4][2];
#pragma unroll
    for (int a = 0; a < 2; ++a)
#pragma unroll
        for (int b = 0; b < 2; ++b)
#pragma unroll
            for (int m = 0; m < 4; ++m)
#pragma unroll
                for (int n = 0; n < 2; ++n) acc[a][b][m][n] = (f32x4){0.f, 0.f, 0.f, 0.f};
    bf16x8 At[4][2], B0[2][2], B1[2][2];
    const char* cA = (const char*)g.A + (size_t)cur.pm * tstepA; const char* cB = (const char*)g.Bt + (size_t)cur.pn * tstepB;
    S.a_ready(cur);
    if constexpr (SP2) {
        PG8_STAGE(PG8_SB(0, 0), cB, voffB); PG8_STAGE(PG8_SB(0, 1), cB + hstepB, voffB); PG8_STAGE(PG8_SA(0, 0), cA, voffA); PG8_STAGE(PG8_SA(0, 1), cA + hstepA, voffA);
        if (wr == 1) PG8_BAR;
        PG8_WAIT_V(2); PG8_BAR;
        PG8_STAGE(PG8_SB(1, 0), cB + kstep, voffB); PG8_STAGE(PG8_SA(1, 0), cA + kstep, voffA); PG8_STAGE(PG8_SB(1, 1), cB + hstepB + kstep, voffB);
        PG8_WAIT_V(6); PG8_BAR;
    } else {
        PG8_STAGE(PG8_SB(0, 0), cB, voffB); PG8_STAGE(PG8_SA(0, 0), cA, voffA); PG8_STAGE(PG8_SB(0, 1), cB + hstepB, voffB); PG8_STAGE(PG8_SA(0, 1), cA + hstepA, voffA);
        if (wr == 1) PG8_BAR;
        PG8_WAIT_V(4); PG8_BAR;
        PG8_STAGE(PG8_SB(1, 0), cB + kstep, voffB); PG8_STAGE(PG8_SA(1, 0), cA + kstep, voffA); PG8_STAGE(PG8_SB(1, 1), cB + hstepB + kstep, voffB);
        PG8_WAIT_V(6); PG8_BAR;
    }
    for (;;) {
        const bool has_next = S.next(ui + 1, nxt);
        const char* nA = has_next ? (const char*)g.A + (size_t)nxt.pm * tstepA : cA; const char* nB = has_next ? (const char*)g.Bt + (size_t)nxt.pn * tstepB : cB;
        for (int t = 0; t < nt; t += 2) {
            const bool last = (t == nt - 2);
            const char* a1 = cA + (size_t)(t + 1) * kstep;
            const char* a2 = last ? nA : cA + (size_t)(t + 2) * kstep; const char* b2 = last ? nB : cB + (size_t)(t + 2) * kstep;
            const char* a3 = a2 + kstep; const char* b3 = b2 + kstep;
            if (last && has_next) S.a_ready(nxt);
            if constexpr (SP2) {
            PG8_LDB(B0, 0, 0); PG8_LDB(B1, 0, 1); PG8_SCHED; PG8_LDA(At, 0, 0); PG8_STAGE(PG8_SA(1, 1), a1 + hstepA, voffA);
            PG8_WAIT_V(8); PG8_WAIT_L(0); PG8_BAR; PG8_MMA(0, 0, At, B0); PG8_MMA(0, 1, At, B1); PG8_BAR; PG8_SCHED;
            PG8_LDA(At, 0, 1); PG8_STAGE(PG8_SB(0, 0), b2, voffB); PG8_STAGE(PG8_SB(0, 1), b2 + hstepB, voffB); PG8_STAGE(PG8_SA(0, 0), a2, voffA);
            PG8_WAIT_V(8); PG8_WAIT_L(0); PG8_BAR; PG8_MMA(1, 0, At, B0); PG8_MMA(1, 1, At, B1); PG8_BAR; PG8_SCHED;
            PG8_LDB(B0, 1, 0); PG8_LDB(B1, 1, 1); PG8_SCHED; PG8_LDA(At, 1, 0); PG8_STAGE(PG8_SA(0, 1), a2 + hstepA, voffA);
            PG8_WAIT_V(8); PG8_WAIT_L(0); PG8_BAR; PG8_MMA(0, 0, At, B0); PG8_MMA(0, 1, At, B1); PG8_BAR; PG8_SCHED;
            PG8_LDA(At, 1, 1); PG8_STAGE(PG8_SB(1, 0), b3, voffB); PG8_STAGE(PG8_SB(1, 1), b3 + hstepB, voffB); PG8_STAGE(PG8_SA(1, 0), a3, voffA);
            PG8_WAIT_V(8); PG8_WAIT_L(0); PG8_BAR; PG8_MMA(1, 0, At, B0); PG8_MMA(1, 1, At, B1); PG8_BAR; PG8_SCHED;
            } else {
            PG8_LDB(B0, 0, 0); PG8_SCHED; PG8_LDA(At, 0, 0); PG8_STAGE(PG8_SA(1, 1), a1 + hstepA, voffA);
            PG8_WAIT_L(8); PG8_BAR; PG8_WAIT_L(0); PG8_MMA(0, 0, At, B0); PG8_BAR; PG8_SCHED;
            PG8_LDB(B1, 0, 1); PG8_STAGE(PG8_SB(0, 0), b2, voffB);
            PG8_BAR; PG8_WAIT_L(0); PG8_MMA(0, 1, At, B1); PG8_BAR;
            PG8_LDA(At, 0, 1); PG8_STAGE(PG8_SA(0, 0), a2, voffA);
            PG8_BAR; PG8_WAIT_L(0); PG8_MMA(1, 0, At, B0); PG8_BAR; PG8_SCHED;
            PG8_STAGE(PG8_SB(0, 1), b2 + hstepB, voffB);
            PG8_WAIT_V(6); PG8_BAR; PG8_MMA(1, 1, At, B1); PG8_BAR;
            PG8_LDB(B0, 1, 0); PG8_SCHED; PG8_LDA(At, 1, 0); PG8_STAGE(PG8_SA(0, 1), a2 + hstepA, voffA);
            PG8_WAIT_L(8); PG8_BAR; PG8_WAIT_L(0); PG8_MMA(0, 0, At, B0); PG8_BAR; PG8_SCHED;
            PG8_LDB(B1, 1, 1); PG8_STAGE(PG8_SB(1, 0), b3, voffB);
            PG8_BAR; PG8_WAIT_L(0); PG8_MMA(0, 1, At, B1); PG8_BAR;
            PG8_LDA(At, 1, 1); PG8_STAGE(PG8_SA(1, 0), a3, voffA);
            PG8_BAR; PG8_WAIT_L(0); PG8_MMA(1, 0, At, B0); PG8_BAR; PG8_SCHED;
            PG8_STAGE(PG8_SB(1, 1), b3 + hstepB, voffB);
            PG8_WAIT_V(6); PG8_BAR; PG8_MMA(1, 1, At, B1); PG8_BAR;
            }
        }
        if constexpr (ALIGN_EPI) { if (wr == 0) PG8_BAR; }
        if constexpr (!Epi::AFTER_DRAIN) { E(acc, cur, wr, wc, fr, fq); S.done(cur); }
        if (!has_next) break;
#pragma unroll
        for (int a = 0; a < 2; ++a)
#pragma unroll
            for (int b = 0; b < 2; ++b)
#pragma unroll
                for (int m = 0; m < 4; ++m)
#pragma unroll
                    for (int n = 0; n < 2; ++n) acc[a][b][m][n] = (f32x4){0.f, 0.f, 0.f, 0.f};
        cur = nxt; cA = nA; cB = nB; ++ui;
        if constexpr (ALIGN_EPI) { if (wr == 1) PG8_BAR; }
    }
    PG8_WAIT_V(0);
    if constexpr (!ALIGN_EPI) { if (wr == 0) PG8_BAR; }
    PG8_BAR;
    if constexpr (Epi::AFTER_DRAIN) { E.fused(acc, cur, wr, wc, fr, fq, lds, wid, lane); S.done(cur); }
#undef PG8_SA
#undef PG8_SB
#undef PG8_STAGE
#undef PG8_LDA
#undef PG8_LDB
#undef PG8_MMA
#undef PG8_WAIT_V
#undef PG8_WAIT_L
#undef PG8_BAR
#undef PG8_SCHED
}
}

#include <hip/hip_bf16.h>
namespace attn_body {
using bf16=__hip_bfloat16;
using bf16x8=__attribute__((ext_vector_type(8)))short;
using s16x4=__attribute__((ext_vector_type(4)))short;
using f32x16=__attribute__((ext_vector_type(16)))float;
using u32x4=__attribute__((ext_vector_type(4)))unsigned;
constexpr int BATCH=8,NHEAD=8,SEQ=2048,D=64,DM=NHEAD*D;
constexpr int NW=8,QBLK=32,QB=QBLK*NW,KVBLK=64,NQB=SEQ/QB;
constexpr int ATTN_PITCH=DM, ATTN_UNIT_ROWS=QB;
__device__ __forceinline__ int crow(int r,int hi){return (r&3)+8*(r>>2)+4*hi;}
#define SBAR() __builtin_amdgcn_sched_barrier(0)
__device__ __forceinline__ void cmask(f32x16&p0,f32x16&p1,int jb,int qrel,int hi){
  const float NEG=-INFINITY; int kb=64*jb+4*hi;
  #pragma unroll
  for(int r=0;r<16;++r){int kv=kb+(r&3)+8*(r>>2); if(kv>qrel)p0[r]=NEG; if(kv+32>qrel)p1[r]=NEG;}
}

constexpr int NSLOT=3, SLOTB=8192;
constexpr int LDS_K=0, LDS_V=NSLOT*SLOTB, LDS_WS=2*NSLOT*SLOTB, LDS_OST=LDS_WS+NW*64*4, LDS_BYTES=LDS_OST+NW*4096;
constexpr float C2=0.125f*1.4426950408889634f;
__device__ __forceinline__ void glds16(const void*gsrc,unsigned lds_dst){unsigned keep;
  asm volatile("s_mov_b32 %0, m0\n\ts_mov_b32 m0, %2\n\ts_nop 0\n\tglobal_load_lds_dwordx4 %1, off\n\ts_mov_b32 m0, %0":"=&s"(keep):"v"(gsrc),"s"(lds_dst):"memory");}
__device__ __forceinline__ float max3f(float a,float b,float c){float r;asm("v_max3_f32 %0, %1, %2, %3":"=v"(r):"v"(a),"v"(b),"v"(c));return r;}
__device__ __forceinline__ float max2f(float a,float b){float r;asm("v_max_f32_e32 %0, %1, %2":"=v"(r):"v"(a),"v"(b));return r;}
__device__ __forceinline__ float fadd_s(float a,float b){float r;asm("v_add_f32_e32 %0, %1, %2":"=v"(r):"v"(a),"v"(b));return r;}
__device__ __forceinline__ float fsub_s(float a,float b){float r;asm("v_sub_f32_e32 %0, %1, %2":"=v"(r):"v"(a),"v"(b));return r;}
typedef float f32x2_t __attribute__((ext_vector_type(2))); typedef __bf16 bf16x2_t __attribute__((ext_vector_type(2)));
__device__ __forceinline__ unsigned cvtpk_s(float lo,float hi){f32x2_t v={lo,hi};bf16x2_t b=__builtin_convertvector(v,bf16x2_t);return __builtin_bit_cast(unsigned,b);}
#define WAIT_BAR(N) asm volatile("s_waitcnt vmcnt(" #N ") lgkmcnt(0)\n\ts_barrier":::"memory")

__device__ __forceinline__ void qkt(f32x16&p0,f32x16&p1,const char*Kslot,const bf16x8*qr,const f32x16&negm,int r32,int hi){
  const char*kb=Kslot+hi*1024+r32*16;
  #pragma unroll
  for(int d0=0;d0<4;++d0){
    const bf16x8 b0=*reinterpret_cast<const bf16x8*>(kb+d0*2048);
    const bf16x8 b1=*reinterpret_cast<const bf16x8*>(kb+d0*2048+512);
    if(d0==0){p0=__builtin_amdgcn_mfma_f32_32x32x16_bf16(b0,qr[0],negm,0,0,0);p1=__builtin_amdgcn_mfma_f32_32x32x16_bf16(b1,qr[0],negm,0,0,0);}
    else{p0=__builtin_amdgcn_mfma_f32_32x32x16_bf16(b0,qr[d0],p0,0,0,0);p1=__builtin_amdgcn_mfma_f32_32x32x16_bf16(b1,qr[d0],p1,0,0,0);}}
}
typedef __attribute__((address_space(3))) const char* lds_cptr;
typedef short v4i16_t __attribute__((ext_vector_type(4)));
__device__ __forceinline__ void kload8(bf16x8*kf,lds_cptr kp){
  kf[0]=*(const __attribute__((address_space(3))) bf16x8*)(kp);      kf[1]=*(const __attribute__((address_space(3))) bf16x8*)(kp+512);
  kf[2]=*(const __attribute__((address_space(3))) bf16x8*)(kp+2048); kf[3]=*(const __attribute__((address_space(3))) bf16x8*)(kp+2560);
  kf[4]=*(const __attribute__((address_space(3))) bf16x8*)(kp+4096); kf[5]=*(const __attribute__((address_space(3))) bf16x8*)(kp+4608);
  kf[6]=*(const __attribute__((address_space(3))) bf16x8*)(kp+6144); kf[7]=*(const __attribute__((address_space(3))) bf16x8*)(kp+6656);
}
__device__ __forceinline__ void kload2(bf16x8*kf,lds_cptr kp,int j){ kf[2*j]=*(const __attribute__((address_space(3))) bf16x8*)(kp+j*2048); kf[2*j+1]=*(const __attribute__((address_space(3))) bf16x8*)(kp+j*2048+512); }
__device__ __forceinline__ s16x4 vtr(lds_cptr p){ return __builtin_bit_cast(s16x4,__builtin_amdgcn_ds_read_tr16_b64_v4i16((__attribute__((address_space(3))) v4i16_t*)p)); }
__device__ __forceinline__ float rowmax(const f32x16&p0,const f32x16&p1){
  float a=max3f(p0[0],p0[1],p1[0]),b=max3f(p0[2],p0[3],p1[1]);a=max3f(a,p1[2],p1[3]);
  #pragma unroll
  for(int r=4;r<16;r+=4){a=max3f(a,p0[r],p0[r+1]);b=max3f(b,p0[r+2],p0[r+3]);a=max3f(a,p1[r],p1[r+1]);b=max3f(b,p1[r+2],p1[r+3]);}
  const float m=max2f(a,b);
  auto rr=__builtin_amdgcn_permlane32_swap(__float_as_uint(m),__float_as_uint(m),false,false);
  return max2f(__uint_as_float(rr[0]),__uint_as_float(rr[1]));
}
__device__ __forceinline__ void pv(f32x16*o,int vb,bf16x8 pa0,bf16x8 pa1,bf16x8 pa2,bf16x8 pa3){
  #pragma unroll
  for(int d0=0;d0<2;++d0){s16x4 lo[4],hi[4];
    #pragma unroll
    for(int ks=0;ks<4;++ks){
      asm volatile("ds_read_b64_tr_b16 %0,%1 offset:%c2":"=&v"(lo[ks]):"v"(vb),"i"(d0*4096+ks*1024):"memory");
      asm volatile("ds_read_b64_tr_b16 %0,%1 offset:%c2":"=&v"(hi[ks]):"v"(vb),"i"(d0*4096+ks*1024+512):"memory");}
    asm volatile("s_waitcnt lgkmcnt(0)":::"memory");SBAR();
    #define PK(k) (bf16x8){lo[k][0],lo[k][1],lo[k][2],lo[k][3],hi[k][0],hi[k][1],hi[k][2],hi[k][3]}
    o[d0]=__builtin_amdgcn_mfma_f32_32x32x16_bf16(pa0,PK(0),o[d0],0,0,0);
    o[d0]=__builtin_amdgcn_mfma_f32_32x32x16_bf16(pa1,PK(1),o[d0],0,0,0);
    o[d0]=__builtin_amdgcn_mfma_f32_32x32x16_bf16(pa2,PK(2),o[d0],0,0,0);
    o[d0]=__builtin_amdgcn_mfma_f32_32x32x16_bf16(pa3,PK(3),o[d0],0,0,0);
    #undef PK
  }
}

#ifndef ATTN_STORE16
#define ATTN_STORE16(p,v) (*(u32x4*)(p)=(v))
#endif
template<int THRL> __device__ __forceinline__ void attn_unit(int b,int h,int qb,const bf16*Q,const bf16*__restrict__ K,const bf16*__restrict__ V,bf16*O,int opitch,const float*__restrict__ KS,char*shm){
  int tid_=threadIdx.x; asm volatile("":"+v"(tid_)); const int tid=tid_,lane=tid&63,r32=lane&31,hi=lane>>5; const int wid=__builtin_amdgcn_readfirstlane(tid>>6);
  const long rowbase=(long)b*SEQ; const int q0=qb*QB;
  const bf16*Qw=Q+(rowbase+q0+wid*QBLK)*DM+h*D;
  const bf16*Kh=K+rowbase*DM+h*D,*Vh=V+rowbase*DM+h*D;
  const unsigned lds0=(unsigned)(uintptr_t)shm;
  float*wsf=(float*)(shm+LDS_WS)+wid*64;
  const bf16*ksrc=Kh+(long)lane*DM+wid*8;
  const bf16*vsrc=Vh+(long)(16*(wid&3)+(lane>>2))*DM+(wid>>2)*32+(lane&3)*8;
  const unsigned kdst=lds0+LDS_K+wid*1024, vdst=lds0+LDS_V+wid*1024;
  #define DMA_K(t,slot) glds16(ksrc+(long)(t)*KVBLK*DM,(unsigned)__builtin_amdgcn_readfirstlane(kdst+(slot)))
  #define DMA_V(t,slot) glds16(vsrc+(long)(t)*KVBLK*DM,(unsigned)__builtin_amdgcn_readfirstlane(vdst+(slot)))
  const int vb0=(int)(lds0+LDS_V)+((lane>>4)&1)*32+(lane&3)*8+(4*hi+((lane&15)>>2))*64;
  const char*Kbase=shm+LDS_K; bf16x8 kf[8];
  const lds_cptr shm3=(lds_cptr)shm; const lds_cptr kp0=shm3+LDS_K+hi*1024+r32*16; const lds_cptr vp0=shm3+LDS_V+((lane>>4)&1)*32+(lane&3)*8+(4*hi+((lane&15)>>2))*64;
  const int NT=(q0+QB)/KVBLK;
  DMA_K(0,0);DMA_V(0,0);DMA_K(1,SLOTB);
  bf16x8 qr[4];
  #pragma unroll
  for(int d0=0;d0<4;++d0)qr[d0]=*reinterpret_cast<const bf16x8*>(&Qw[(long)r32*DM+d0*16+hi*8]);
  unsigned selmask=(1u<<qb)-1u;
  if(qb>3){
    float sc[7];
    #pragma unroll
    for(int n=0;n<7;++n){ sc[n]=-INFINITY;
      if(n<qb){ const float*kp=KS+((long)(b*8+n)*DM+h*D+hi*8); float a=0.f;
        #pragma unroll
        for(int d0=0;d0<4;++d0){ const float4 k0=*reinterpret_cast<const float4*>(kp+d0*16),k1=*reinterpret_cast<const float4*>(kp+d0*16+4);
          #define QF(j) __uint_as_float(((unsigned)(unsigned short)qr[d0][j])<<16)
          a+=QF(0)*k0.x+QF(1)*k0.y+QF(2)*k0.z+QF(3)*k0.w+QF(4)*k1.x+QF(5)*k1.y+QF(6)*k1.z+QF(7)*k1.w;
          #undef QF
        }
        a+=__shfl_xor(a,32); sc[n]=a; }
      asm volatile("":::"memory"); }
    selmask=0u;
    #pragma unroll
    for(int n=0;n<7;++n){ int rk=0;
      #pragma unroll
      for(int m2=0;m2<7;++m2){ if(m2!=n) rk+=(sc[m2]>sc[n]||(sc[m2]==sc[n]&&m2<n))?1:0; }
      if(n<qb&&rk<3)selmask|=(1u<<n); }
  }
  float mhat=0.f,l_reg=0.f;f32x16 o[2];o[0]=f32x16{};o[1]=f32x16{};const f32x16 negm=f32x16{};
  const int qrel=wid*QBLK+r32;
  #define CMASK(P0,P1,t) do{const int t_=(t); const int jb_=t_-(NT-4); if(jb_>=0)cmask(P0,P1,jb_,qrel,hi); else if(!((selmask>>(t_>>2))&1u)){ _Pragma("unroll") for(int r_=0;r_<16;++r_){P0[r_]=-INFINITY;P1[r_]=-INFINITY;} } }while(0)
  bool resc=false;
  #define START(P0,P1) do{ const float rm=rowmax(P0,P1); resc=false; \
    { const float dl=__builtin_fmaxf(rm,-100.f); mhat=fadd_s(mhat,dl); \
      _Pragma("unroll") for(int r=0;r<16;++r){P0[r]=fsub_s(P0[r],dl);P1[r]=fsub_s(P1[r],dl);} \
      } \
    _Pragma("unroll") for(int r=0;r<16;++r)P0[r]=__builtin_amdgcn_exp2f(P0[r]); }while(0)
  #define RESC() do{ if(resc){ asm volatile("s_waitcnt lgkmcnt(0)":::"memory"); \
      _Pragma("unroll") for(int d_=0;d_<2;++d_) _Pragma("unroll") for(int r=0;r<16;++r)o[d_][r]*=wsf[crow(r,hi)]; } }while(0)
  f32x16 pA0,pA1,pB0,pB1;
  int sl_prev=0,sl_cur=0,sl_next=SLOTB;
  #define ROT() do{sl_prev=sl_cur;sl_cur=sl_next;sl_next=(sl_next==(NSLOT-1)*SLOTB)?0:sl_next+SLOTB;}while(0)
  DMA_K(2,2*SLOTB);
  WAIT_BAR(3);
  qkt(pA0,pA1,Kbase,qr,negm,r32,hi);asm volatile("s_nop 15\n\ts_nop 7":"+v"(pA0),"+v"(pA1));CMASK(pA0,pA1,0);
  START(pA0,pA1);
  _Pragma("unroll") for(int r=0;r<16;++r)pA1[r]=__builtin_amdgcn_exp2f(pA1[r]);
  WAIT_BAR(0);
  DMA_K(3,0);DMA_V(1,SLOTB);
  ROT();
  kload8(kf,kp0+sl_cur);
  WAIT_BAR(2);
  s16x4 vlo[8],vhi[8]; u32x4 pw0,pw1,pw2,pw3;
  #define PKW(P,B) cvtpk_s(P[B],P[B+1])
  #define PAF(k) __builtin_bit_cast(bf16x8,pw##k)
  #define VFR(i) (bf16x8){vlo[i][0],vlo[i][1],vlo[i][2],vlo[i][3],vhi[i][0],vhi[i][1],vhi[i][2],vhi[i][3]}
  #define PIN(x) asm volatile("":"+v"(x))
  #define MX3(a,b,c) __builtin_fmaxf(__builtin_fmaxf((a),(b)),(c))
  #define GAPA(MF,A0,A1,A2,A3,W0,W1,PW) do{ MF; sacc+=A0; sacc+=A1; sacc+=A2; sacc+=A3; PIN(sacc); W0; W1; PIN(PW); SBAR(); }while(0)
  #define EX(v) __builtin_amdgcn_exp2f(v)
  #define GAPB(MF,X,B) do{ MF; X[B]=EX(X[B]); X[B+1]=EX(X[B+1]); X[B+2]=EX(X[B+2]); X[B+3]=EX(X[B+3]); PIN(X); SBAR(); }while(0)
  #define VRD(i) do{ vlo[i]=vtr(vp_+(((i)>>2)*4096+((i)&3)*1024)); vhi[i]=vtr(vp_+(((i)>>2)*4096+((i)&3)*1024+512)); }while(0)
  #define KRD(G,j) do{ if(G){ kload2(kf,kp0+sl_next,j); SBAR(); } }while(0)
  #define STEP(C0,C1,P0,P1,t,GK,GV,GL) do{ SBAR(); \
    const lds_cptr vp_=vp0+sl_prev; \
    VRD(0); SBAR(); float sacc=(P0[0]+P0[1]); \
    GAPA(C0=__builtin_amdgcn_mfma_f32_32x32x16_bf16(kf[0],qr[0],negm,0,0,0), P0[2],P0[3],P0[4],P0[5],     pw0[0]=PKW(P0,0), pw0[1]=PKW(P0,2), pw0); \
    VRD(4); SBAR(); GAPA(C1=__builtin_amdgcn_mfma_f32_32x32x16_bf16(kf[1],qr[0],negm,0,0,0), P0[6],P0[7],P0[8],P0[9],     pw0[2]=PKW(P0,4), pw0[3]=PKW(P0,6), pw0); \
    VRD(1); SBAR(); GAPA(C0=__builtin_amdgcn_mfma_f32_32x32x16_bf16(kf[2],qr[1],C0,0,0,0),   P0[10],P0[11],P0[12],P0[13], pw1[0]=PKW(P0,8), pw1[1]=PKW(P0,10), pw1); \
    VRD(5); SBAR(); GAPA(C1=__builtin_amdgcn_mfma_f32_32x32x16_bf16(kf[3],qr[1],C1,0,0,0),   P0[14],P0[15],P1[0],P1[1],   pw1[2]=PKW(P0,12),pw1[3]=PKW(P0,14), pw1); \
    VRD(2); SBAR(); GAPA(C0=__builtin_amdgcn_mfma_f32_32x32x16_bf16(kf[4],qr[2],C0,0,0,0),   P1[2],P1[3],P1[4],P1[5],     pw2[0]=PKW(P1,0), pw2[1]=PKW(P1,2), pw2); \
    VRD(6); SBAR(); GAPA(C1=__builtin_amdgcn_mfma_f32_32x32x16_bf16(kf[5],qr[2],C1,0,0,0),   P1[6],P1[7],P1[8],P1[9],     pw2[2]=PKW(P1,4), pw2[3]=PKW(P1,6), pw2); \
    VRD(3); SBAR(); GAPA(C0=__builtin_amdgcn_mfma_f32_32x32x16_bf16(kf[6],qr[3],C0,0,0,0),   P1[10],P1[11],P1[12],P1[13], pw3[0]=PKW(P1,8), pw3[1]=PKW(P1,10), pw3); \
    VRD(7); SBAR(); GAPA(C1=__builtin_amdgcn_mfma_f32_32x32x16_bf16(kf[7],qr[3],C1,0,0,0),   P1[14],P1[15],0.f,0.f,       pw3[2]=PKW(P1,12),pw3[3]=PKW(P1,14), pw3); \
    l_reg+=sacc; \
    if(GK){DMA_K((t)+3,sl_cur);} if(GV){DMA_V((t)+1,sl_next);} \
    _Pragma("unroll") for(int r=0;r<16;++r){C0[r]-=mhat;C1[r]-=mhat;} \
    CMASK(C0,C1,t); \
    { float a=MX3(C0[0],C0[1],C1[0]),b=MX3(C0[2],C0[3],C1[1]); a=MX3(a,C1[2],C1[3]); \
      _Pragma("unroll") for(int r=4;r<16;r+=4){a=MX3(a,C0[r],C0[r+1]);b=MX3(b,C0[r+2],C0[r+3]);a=MX3(a,C1[r],C1[r+1]);b=MX3(b,C1[r+2],C1[r+3]);} \
      float rm=__builtin_fmaxf(a,b); { auto rr=__builtin_amdgcn_permlane32_swap(__float_as_uint(rm),__float_as_uint(rm),false,false); rm=__builtin_fmaxf(__uint_as_float(rr[0]),__uint_as_float(rr[1])); } \
      resc=false; \
      if(__builtin_expect(__any(rm>(float)THRL),0)){ const float dl=__builtin_fmaxf(rm,0.f); mhat+=dl; \
        _Pragma("unroll") for(int r=0;r<16;++r){C0[r]-=dl;C1[r]-=dl;} \
        const float f=__builtin_amdgcn_exp2f(-dl); l_reg*=f; if(hi==0)wsf[r32]=f; resc=true; } } \
    SBAR(); \
    GAPB(o[0]=__builtin_amdgcn_mfma_f32_32x32x16_bf16(PAF(0),VFR(0),o[0],0,0,0), C0,0); \
    GAPB(o[1]=__builtin_amdgcn_mfma_f32_32x32x16_bf16(PAF(0),VFR(4),o[1],0,0,0), C0,4); \
    KRD(GL,0); GAPB(o[0]=__builtin_amdgcn_mfma_f32_32x32x16_bf16(PAF(1),VFR(1),o[0],0,0,0), C0,8); \
    KRD(GL,1); GAPB(o[1]=__builtin_amdgcn_mfma_f32_32x32x16_bf16(PAF(1),VFR(5),o[1],0,0,0), C0,12); \
    KRD(GL,2); GAPB(o[0]=__builtin_amdgcn_mfma_f32_32x32x16_bf16(PAF(2),VFR(2),o[0],0,0,0), C1,0); \
    KRD(GL,3); GAPB(o[1]=__builtin_amdgcn_mfma_f32_32x32x16_bf16(PAF(2),VFR(6),o[1],0,0,0), C1,4); \
    GAPB(o[0]=__builtin_amdgcn_mfma_f32_32x32x16_bf16(PAF(3),VFR(3),o[0],0,0,0), C1,8); \
    GAPB(o[1]=__builtin_amdgcn_mfma_f32_32x32x16_bf16(PAF(3),VFR(7),o[1],0,0,0), C1,12); \
    }while(0)
  int t=1;
  #undef CMASK
  #define CMASK(P0,P1,t) do{ if(!((selmask>>((t)>>2))&1u)){ _Pragma("unroll") for(int r_=0;r_<16;++r_){P0[r_]=-INFINITY;P1[r_]=-INFINITY;} } }while(0)
  for(;t+5<NT;t+=2){
    STEP(pB0,pB1,pA0,pA1,t,true,true,true);     WAIT_BAR(2); RESC(); ROT();
    STEP(pA0,pA1,pB0,pB1,t+1,true,true,true);   WAIT_BAR(2); RESC(); ROT();
  }
  #undef CMASK
  #define CMASK(P0,P1,t) do{const int t_=(t); const int jb_=t_-(NT-4); if(jb_>=0)cmask(P0,P1,jb_,qrel,hi); else if(!((selmask>>(t_>>2))&1u)){ _Pragma("unroll") for(int r_=0;r_<16;++r_){P0[r_]=-INFINITY;P1[r_]=-INFINITY;} } }while(0)
  #define ENDW(tt) do{ if((tt)+3<NT){WAIT_BAR(2);} else if((tt)+2<NT){WAIT_BAR(1);} else {WAIT_BAR(0);} }while(0)
  for(;t+1<NT;t+=2){
    STEP(pB0,pB1,pA0,pA1,t,(t+3<NT),(t+1<NT),(t+1<NT));       ENDW(t);   RESC(); ROT();
    STEP(pA0,pA1,pB0,pB1,t+1,(t+4<NT),(t+2<NT),(t+2<NT));     ENDW(t+1); RESC(); ROT();
  }
  STEP(pB0,pB1,pA0,pA1,NT-1,false,false,false); RESC();
  { float sacc=pB0[0]+pB0[1]; _Pragma("unroll") for(int r=2;r<16;++r)sacc+=pB0[r]; _Pragma("unroll") for(int r=0;r<16;++r)sacc+=pB1[r]; l_reg+=sacc;
    pw0=(u32x4){PKW(pB0,0),PKW(pB0,2),PKW(pB0,4),PKW(pB0,6)};pw1=(u32x4){PKW(pB0,8),PKW(pB0,10),PKW(pB0,12),PKW(pB0,14)};pw2=(u32x4){PKW(pB1,0),PKW(pB1,2),PKW(pB1,4),PKW(pB1,6)};pw3=(u32x4){PKW(pB1,8),PKW(pB1,10),PKW(pB1,12),PKW(pB1,14)};
    SBAR(); pv(o,vb0+sl_cur,PAF(0),PAF(1),PAF(2),PAF(3)); }
  #undef PKW
  #undef PAF
  #undef VFR
  #undef PIN
  #undef MX3
  #undef GAPA
  #undef GAPB
  #undef EX
  #undef VRD
  #undef KRD
  #undef STEP
  #undef ENDW
  {auto rr=__builtin_amdgcn_permlane32_swap(__float_as_uint(l_reg),__float_as_uint(l_reg),false,false);l_reg=__uint_as_float(rr[0])+__uint_as_float(rr[1]);}
  if(hi==0)wsf[32+r32]=l_reg;asm volatile("s_waitcnt lgkmcnt(0)":::"memory");
  float rli[16];
  #pragma unroll
  for(int r=0;r<16;++r)rli[r]=__builtin_amdgcn_rcpf(wsf[32+crow(r,hi)]);
  bf16*Ow=O+(rowbase+q0+wid*QBLK)*(long)opitch+h*D;
  { bf16*stg=(bf16*)(shm+LDS_OST)+wid*2048;
    #pragma unroll
    for(int r=0;r<16;++r){const int orow=crow(r,hi);
      #pragma unroll
      for(int d0=0;d0<2;++d0)stg[orow*64+d0*32+r32]=__float2bfloat16(o[d0][r]*rli[r]);}
    asm volatile("s_waitcnt lgkmcnt(0)":::"memory");
    #pragma unroll
    for(int i=0;i<4;++i){const int row=i*8+(lane>>3),ch=lane&7; const u32x4 v=*(const u32x4*)(stg+row*64+ch*8); ATTN_STORE16(Ow+(long)row*opitch+ch*8,v);} }
  asm volatile("s_waitcnt lgkmcnt(0)\n\ts_barrier":::"memory");
  #undef DMA_K
  #undef DMA_V
  #undef CMASK
  #undef START
  #undef RESC
  #undef ROT
}
constexpr int ATTN_LDS_BYTES=LDS_BYTES;
struct AttnTensors { const bf16* Q; const bf16* K; const bf16* V; bf16* O; int opitch; const float* KS; };
#undef SBAR
#undef WAIT_BAR
}
constexpr int NWAVES = 8;
#ifndef MK_N_LAUNCHES
#define MK_N_LAUNCHES 1
#endif
constexpr int N_LAUNCHES = MK_N_LAUNCHES;
constexpr int PER_PHASE = 10;

constexpr int D = 1024, NBATCH = 8, SEQ = 2048, MP = NBATCH * SEQ, NS = 128, MALL = MP + 256, NPAN = MALL / 256;
constexpr int MEMR = 2048, XNROWS = MALL + MEMR;
constexpr int FF = 4096, PW = 512, AW = 512, NH = 8, HD = 64, PST = 15, NPAGES = 16, PAGE = 128;
constexpr float EPS = 1e-6f;
constexpr float CROSS_C2 = 0.0625f * 1.4426950408889634f;
constexpr size_t O_YP = 0, O_YS = O_YP + (size_t)MP * D, O_KP = O_YS + (size_t)NS * D, O_VP = O_KP + (size_t)MP * AW, O_POOLP = O_VP + (size_t)MP * AW,
                 O_MK = O_POOLP + (size_t)NBATCH * PST * PW, O_MV = O_MK + (size_t)MEMR * D, O_KS = O_MV + (size_t)MEMR * D, O_VS = O_KS + (size_t)NS * AW, O_POOLS = O_VS + (size_t)NS * AW,
                 O_END = O_POOLS + (size_t)NS * PST * PW;
static_assert(O_END == 39055360, "output size");

constexpr size_t MiB = 1u << 20;
constexpr size_t WS_CTL = 0, CTL_ZERO_BYTES = 1 * MiB;
constexpr size_t WS_WIN = 2 * MiB;
constexpr size_t WS_WOUT = 10 * MiB, WS_WCQ = 12 * MiB, WS_WCO = 14 * MiB;
constexpr size_t WS_WUP = 16 * MiB;
constexpr size_t WS_WDN = 24 * MiB;
constexpr size_t WS_WPOOL = 32 * MiB;
constexpr size_t WS_ROPE = 33 * MiB;
constexpr size_t WS_QS = 34 * MiB;
constexpr size_t WS_XN = 36 * MiB;
constexpr size_t WS_U = 74 * MiB, WS_Q = 91 * MiB, WS_K = 108 * MiB, WS_V = 125 * MiB;
constexpr size_t WS_MIX = 142 * MiB;
constexpr size_t WS_X1 = 176 * MiB;
constexpr size_t WS_XG = 242 * MiB;
constexpr size_t WS_QC = 276 * MiB;
constexpr size_t WS_OC = 310 * MiB;
constexpr size_t WS_MKB = 344 * MiB;
constexpr size_t WS_MVT = 348 * MiB;
constexpr size_t WS_PB = 352 * MiB;
constexpr size_t WS_HB = 384 * MiB;
constexpr size_t WS_END = 516 * MiB;
static_assert(WS_XN + (size_t)XNROWS * D * 2 <= WS_U && WS_V + (size_t)MALL * 512 * 2 <= WS_MIX && WS_MIX + (size_t)MALL * D * 2 <= WS_X1 && WS_X1 + (size_t)MALL * D * 4 <= WS_XG &&
              WS_XG + (size_t)MALL * D * 2 <= WS_QC && WS_QC + (size_t)MALL * D * 2 <= WS_OC && WS_OC + (size_t)MALL * D * 2 <= WS_MKB && WS_HB + (size_t)MALL * FF * 2 <= WS_END, "d_ws map");
constexpr int CW_TMO = 0, CW_CODE = 1;
constexpr int CW_BAR = 4096;
constexpr int CW_KSUM = 16384;
constexpr int CW_SS1 = 49152, CW_SS2 = CW_SS1 + 16896, CW_SS3 = CW_SS2 + 16896;
static_assert((CW_SS3 + 16896) * 4 <= (int)CTL_ZERO_BYTES && CW_KSUM + 8 * 8 * 512 <= CW_SS1, "CTL words inside the memset region");

constexpr int RING_OFF = 0, RING_BYTES = 131072;
constexpr int LDSCTL_OFF = RING_BYTES, MISC_OFF = LDSCTL_OFF + 320;
constexpr int LDS_BYTES = 147456;
static_assert(MISC_OFF + 128 <= LDS_BYTES, "LDS map");

#define GAS __attribute__((address_space(1)))
#define LAS __attribute__((address_space(3)))
typedef unsigned short bf16;
typedef unsigned v4u __attribute__((ext_vector_type(4)));
typedef unsigned v2u __attribute__((ext_vector_type(2)));
typedef float f32x4 __attribute__((ext_vector_type(4)));
typedef short bf16x8 __attribute__((ext_vector_type(8)));
typedef GAS unsigned gu32;
typedef GAS unsigned long long gu64;
#define RLX_AGENT __ATOMIC_RELAXED, __HIP_MEMORY_SCOPE_AGENT
#define LDS_WAIT() asm volatile("s_waitcnt lgkmcnt(0)" ::: "memory")
#define VM_WAIT() asm volatile("s_waitcnt vmcnt(0)" ::: "memory")
__device__ __forceinline__ unsigned f2bf(float f) { unsigned u = __builtin_bit_cast(unsigned, f); return (u + 0x7fffu + ((u >> 16) & 1u)) >> 16; }
__device__ __forceinline__ unsigned pk2(float lo, float hi) { return f2bf(lo) | (f2bf(hi) << 16); }
__device__ __forceinline__ float bf2f(unsigned short b) { return __uint_as_float(((unsigned)b) << 16); }

#define XB_TMO      128
#define XB_XCNT(j)  (256  + 64 * (j))
#define XB_XSUB(j)  (1280 + 64 * (j))
#define XB_XGEN(j)  (2304 + 64 * (j))
#define XB_TOP      3328
#define XB_TOPGEN   3392
#define XCD_BAR_WORDS 3456
#define XB_SPIN_CAP (1u << 18)

__device__ __forceinline__ unsigned xb_ld(unsigned* p)              { return __hip_atomic_load(p, __ATOMIC_RELAXED, __HIP_MEMORY_SCOPE_AGENT); }
__device__ __forceinline__ unsigned xb_add(unsigned* p, unsigned v) { return __hip_atomic_fetch_add(p, v, __ATOMIC_RELAXED, __HIP_MEMORY_SCOPE_AGENT); }
__device__ __forceinline__ unsigned xb_xcc_id() { return (unsigned)__builtin_amdgcn_s_getreg((3 << 11) | 20) & 0xFu; }
#define XB_SPIN(cond, bar) do { unsigned _sp = 0; while (cond) { __builtin_amdgcn_s_sleep(1); \
    if ((++_sp & 255u) == 0u) { if (xb_ld(&(bar)[XB_TMO])) break; if (_sp > XB_SPIN_CAP) { atomicAdd(&(bar)[XB_TMO], 1u); break; } } } } while (0)

struct XcdBarrier {
    unsigned* bar; unsigned x;
    volatile LAS unsigned* st;
};

__device__ __forceinline__ XcdBarrier xcd_barrier_post(unsigned* bar, volatile LAS unsigned* st) {
    XcdBarrier b; b.bar = bar; b.x = xb_xcc_id(); b.st = st;
    if (threadIdx.x == 0) (void)xb_add(&bar[XB_XCNT(b.x)], 1u);
    return b;
}
__device__ __forceinline__ void xcd_barrier_complete(unsigned* bar, unsigned x, unsigned& nloc, unsigned& nx) {
    const unsigned G = gridDim.x * gridDim.y * gridDim.z;
    unsigned sum, cnt, mine, sp = 0u;
    for (;;) {
        sum = 0u; cnt = 0u; mine = 0u;
#pragma unroll
        for (unsigned j = 0; j < 16; ++j) { const unsigned c = xb_ld(&bar[XB_XCNT(j)]); sum += c; cnt += (c > 0u) ? 1u : 0u; mine = (j == x) ? c : mine; }
        if (sum == G) break;
        __builtin_amdgcn_s_sleep(1);
        if ((++sp & 255u) == 0u) { if (xb_ld(&bar[XB_TMO])) break; if (sp > XB_SPIN_CAP) { atomicAdd(&bar[XB_TMO], 1u); break; } }
    }
    nloc = mine > 0u ? mine : 1u; nx = cnt > 0u ? cnt : 1u;
}

__device__ __forceinline__ void xcd_barrier(const XcdBarrier& b) {
    asm volatile("s_waitcnt vmcnt(0)" ::: "memory");
    __syncthreads();
    if (threadIdx.x == 0) {
        unsigned* bar = b.bar;
        __builtin_amdgcn_s_waitcnt(0);
        unsigned nloc = b.st[0], nx = b.st[1];
        if (nloc == 0u) { xcd_barrier_complete(bar, b.x, nloc, nx); b.st[0] = nloc; b.st[1] = nx; }
        const unsigned old = xb_add(&bar[XB_XSUB(b.x)], 1u);
        const unsigned gen = old / nloc;
        if (old + 1u == (gen + 1u) * nloc) {
            __builtin_amdgcn_fence(__ATOMIC_RELEASE, "agent");
            asm volatile("s_waitcnt vmcnt(0)" ::: "memory");
            const unsigned og = xb_add(&bar[XB_TOP], 1u);
            const unsigned tg = og / nx;
            if (og + 1u == (tg + 1u) * nx) xb_add(&bar[XB_TOPGEN], 1u);
            else XB_SPIN(xb_ld(&bar[XB_TOPGEN]) == tg, bar);
            __builtin_amdgcn_fence(__ATOMIC_ACQUIRE, "agent");
            xb_add(&bar[XB_XGEN(b.x)], 1u);
            asm volatile("s_waitcnt vmcnt(0)" ::: "memory");
        } else {
            XB_SPIN(xb_ld(&bar[XB_XGEN(b.x)]) == gen, bar);
            __builtin_amdgcn_fence(__ATOMIC_ACQUIRE, "agent");
            asm volatile("s_waitcnt vmcnt(0)" ::: "memory");
        }
    }
    __syncthreads();
}


struct Args { const void* in[24]; float* out; unsigned char* ws; int ph_lo, ph_hi; };
struct Frame {
    LAS unsigned char* lds;
    volatile LAS unsigned* MISC;
    gu32* ctl;
    int tid, lane, wave;
    int vcu, G;
    float* out;
    unsigned char* ws;
};
#define WSP(T, off) ((T*)(F.ws + (off)))

__device__ __forceinline__ float wave_sum(float v) {
#pragma unroll
    for (int o = 1; o < 64; o <<= 1) v += __shfl_xor(v, o);
    return v;
}
__device__ __forceinline__ float wave_max(float v) {
#pragma unroll
    for (int o = 1; o < 64; o <<= 1) v = __builtin_fmaxf(v, __shfl_xor(v, o));
    return v;
}
__device__ __forceinline__ int win_dst_row(int n) { if (n < 512 || n >= 1536) return n; const int t = n & ~255, j = n & 255, hh = j >> 6, p = (j >> 5) & 1, i = j & 31; return t + 128 * p + 32 * hh + i; }
template <bool WINPERM> __device__ __forceinline__ void p0_transpose_item(const float* W, int K, int N, bf16* WT, int row_off, LAS float* scr, int item, int lane) {
    const int nblk = N / 32, kb = item / nblk, nb = item % nblk, k0 = 64 * kb, n0 = 32 * nb;
#pragma unroll 8
    for (int i = 0; i < 32; ++i) { const int kk = 2 * i + (lane >> 5); scr[kk * 33 + (lane & 31)] = W[(size_t)(k0 + kk) * N + n0 + (lane & 31)]; }
    LDS_WAIT(); asm volatile("" ::: "memory");
    const int c = lane & 7;
#pragma unroll
    for (int j = 0; j < 4; ++j) { const int n = (lane >> 3) + 8 * j; const LAS float* s = scr + (8 * c) * 33 + n;
        v4u o; o.x = pk2(s[0 * 33], s[1 * 33]); o.y = pk2(s[2 * 33], s[3 * 33]); o.z = pk2(s[4 * 33], s[5 * 33]); o.w = pk2(s[6 * 33], s[7 * 33]);
        const int drow = WINPERM ? win_dst_row(n0 + n) : (n0 + n);
        *(GAS v4u*)(WT + (size_t)(row_off + drow) * K + k0 + 8 * c) = o; }
    LDS_WAIT(); asm volatile("" ::: "memory");
}
__device__ __forceinline__ void rms_row_to_bf16(int lane, const float* xrow, const float* gain, bf16* orow) {
    const GAS f32x4* xr = (const GAS f32x4*)xrow + lane; const GAS f32x4* gr = (const GAS f32x4*)gain + lane;
    f32x4 v[4]; float s = 0.f;
#pragma unroll
    for (int j = 0; j < 4; ++j) { v[j] = xr[64 * j]; s += (v[j].x * v[j].x + v[j].y * v[j].y) + (v[j].z * v[j].z + v[j].w * v[j].w); }
    const float rstd = 1.f / sqrtf(wave_sum(s) * (1.f / D) + EPS);
    GAS unsigned long long* o8 = (GAS unsigned long long*)orow + lane;
#pragma unroll
    for (int j = 0; j < 4; ++j) { const f32x4 g = gr[64 * j]; o8[64 * j] = (unsigned long long)pk2(v[j].x * rstd * g.x, v[j].y * rstd * g.y) | ((unsigned long long)pk2(v[j].z * rstd * g.z, v[j].w * rstd * g.w) << 32); }
}
__device__ __forceinline__ void p0_prologue(Frame& F, const Args& A) {
    LAS float* scr = (LAS float*)(F.lds + RING_OFF + F.wave * 16384);
    const int gw = F.vcu * NWAVES + F.wave, NGW = F.G * NWAVES;
    bf16* WIN = WSP(bf16, WS_WIN);
    constexpr int I_IN = (D / 64) * (2048 / 32), I_SQ = (D / 64) * (D / 32), I_UP = (D / 64) * (FF / 32), I_DN = (FF / 64) * (D / 32), I_PL = (128 / 64) * (128 / 32);
    constexpr int NITEMS = I_IN + 5 * I_SQ + I_UP + I_DN + 4 * I_PL;
    for (int it = gw; it < NITEMS; it += NGW) {
        int r = it;
        if (r < I_IN) { p0_transpose_item<true>(((const float*)A.in[10]), D, 2048, WIN, 0, scr, r, F.lane); continue; } r -= I_IN;
        if (r < I_SQ) { p0_transpose_item<false>(((const float*)A.in[17]), D, D, WIN, 2048, scr, r, F.lane); continue; } r -= I_SQ;
        if (r < I_SQ) { p0_transpose_item<false>(((const float*)A.in[18]), D, D, WIN, 3072, scr, r, F.lane); continue; } r -= I_SQ;
        if (r < I_SQ) { p0_transpose_item<false>(((const float*)A.in[13]), D, D, WSP(bf16, WS_WOUT), 0, scr, r, F.lane); continue; } r -= I_SQ;
        if (r < I_SQ) { p0_transpose_item<false>(((const float*)A.in[16]), D, D, WSP(bf16, WS_WCQ), 0, scr, r, F.lane); continue; } r -= I_SQ;
        if (r < I_SQ) { p0_transpose_item<false>(((const float*)A.in[19]), D, D, WSP(bf16, WS_WCO), 0, scr, r, F.lane); continue; } r -= I_SQ;
        if (r < I_UP) { p0_transpose_item<false>(((const float*)A.in[21]), D, FF, WSP(bf16, WS_WUP), 0, scr, r, F.lane); continue; } r -= I_UP;
        if (r < I_DN) { p0_transpose_item<false>(((const float*)A.in[22]), FF, D, WSP(bf16, WS_WDN), 0, scr, r, F.lane); continue; } r -= I_DN;
        { const int g = r / I_PL; p0_transpose_item<false>(((const float*)A.in[11]) + (size_t)g * 128 * 128, 128, 128, WSP(bf16, WS_WPOOL) + (size_t)g * 128 * 128, 0, scr, r % I_PL, F.lane); }
    }
    bf16* XN = WSP(bf16, WS_XN);
    for (int m = gw; m < XNROWS; m += NGW) {
        if (m < MP) rms_row_to_bf16(F.lane, ((const float*)A.in[0]) + (size_t)m * D, ((const float*)A.in[9]), XN + (size_t)m * D);
        else if (m < MP + NS) rms_row_to_bf16(F.lane, ((const float*)A.in[1]) + (size_t)(m - MP) * D, ((const float*)A.in[9]), XN + (size_t)m * D);
        else if (m < MALL) { GAS unsigned long long* o8 = (GAS unsigned long long*)(XN + (size_t)m * D) + F.lane; o8[0] = 0ull; o8[64] = 0ull; o8[128] = 0ull; o8[192] = 0ull; }
        else rms_row_to_bf16(F.lane, ((const float*)A.in[8]) + (size_t)(m - MALL) * D, ((const float*)A.in[15]), XN + (size_t)m * D);
    }
    { float* rc = WSP(float, WS_ROPE); float* rs = rc + 2049 * 32; const int gt = F.vcu * (NWAVES * 64) + F.tid, NT = F.G * NWAVES * 64;
      for (int e = gt; e < 2049 * 32; e += NT) { const int pos = e >> 5, i = e & 31; const float invf = exp2f(-(float)i * (13.287712379549449f / 32.0f)); const double a = (double)pos * (double)invf; const double kq = __builtin_rint(a * 0.15915494309189535); const float rr = (float)(a - kq * 6.283185307179586); rc[e] = cosf(rr); rs[e] = sinf(rr); }
      const GAS f32x4* sp = (const GAS f32x4*)((const float*)A.in[6]); GAS f32x4* po = (GAS f32x4*)(F.out + O_POOLS);
      for (int e = gt; e < NS * 14 * (PW / 4); e += NT) { const int s = e / (14 * 128), r = (e / 128) % 14, c = e & 127; po[(s * 15 + r) * 128 + c] = sp[(s * 15 + r + 1) * 128 + c]; } }
}
constexpr int POOL_LD = 136;
__device__ __forceinline__ void pool_mma_store(Frame& F, const Args& A, int row0, int g) {
    const LAS unsigned char* DB = F.lds + RING_OFF + 40960;
    const int fr = F.lane & 15, fq = F.lane >> 4, w = F.wave;
    const bf16* WP = WSP(bf16, WS_WPOOL) + (size_t)g * 128 * 128;
    f32x4 acc[8];
#pragma unroll
    for (int nb = 0; nb < 8; ++nb) acc[nb] = (f32x4){0.f, 0.f, 0.f, 0.f};
#pragma unroll
    for (int ks = 0; ks < 4; ++ks) {
        const bf16x8 a = *(const LAS bf16x8*)(DB + ((16 * w + fr) * POOL_LD + ks * 32 + 8 * fq) * 2);
#pragma unroll
        for (int nb = 0; nb < 8; ++nb) { const bf16x8 b = *(const GAS bf16x8*)(WP + (size_t)(nb * 16 + fr) * 128 + ks * 32 + 8 * fq); acc[nb] = __builtin_amdgcn_mfma_f32_16x16x32_bf16(b, a, acc[nb], 0, 0, 0); }
    }
    bf16* MIX = WSP(bf16, WS_MIX);
#pragma unroll
    for (int nb = 0; nb < 8; ++nb) { const int col = g * 128 + nb * 16 + 4 * fq; const f32x4 sp = *(const GAS f32x4*)(((const float*)A.in[12]) + col); const f32x4 v = acc[nb] * sp;
        v2u o; o.x = pk2(v[0], v[1]); o.y = pk2(v[2], v[3]); *(GAS v2u*)(MIX + (size_t)(row0 + 16 * w + fr) * D + col) = o; }
}
__device__ __forceinline__ void pool_unit(Frame& F, const Args& A, int L) {
    LAS unsigned short* UB = (LAS unsigned short*)(F.lds + RING_OFF);
    LAS unsigned short* DB = (LAS unsigned short*)(F.lds + RING_OFF + 40960);
    const int c = F.tid & 127, strip = F.tid >> 7;
    if (L < 512) {
        const int pnl = L >> 2, g = L & 3, r0 = pnl * 128, w = 2 << g; const bool first = (r0 & (SEQ - 1)) == 0;
        const bf16* U = WSP(bf16, WS_U);
        for (int e = F.tid; e < 144 * 16; e += NWAVES * 64) { const int rr = e >> 4, ch = e & 15; v4u v = {0u, 0u, 0u, 0u};
            if (!(first && rr < 16)) v = *(const GAS v4u*)(U + (size_t)(r0 - 16 + rr) * PW + g * 128 + ch * 8);
            *(LAS v4u*)(UB + rr * POOL_LD + ch * 8) = v; }
        LDS_WAIT(); __syncthreads();
        const int rs = strip * 32; float s = 0.f;
        for (int j = 1; j < w; ++j) s += bf2f(UB[(16 + rs - j) * POOL_LD + c]);
        const int pos0 = (r0 & (SEQ - 1)) + rs; const float invw = 1.0f / (float)w;
        for (int r = 0; r < 32; ++r) { const float uv = bf2f(UB[(16 + rs + r) * POOL_LD + c]); s += uv; const int pos = pos0 + r;
            const float inv = (pos + 1 >= w) ? invw : 1.0f / (float)(pos + 1);
            DB[(rs + r) * POOL_LD + c] = (unsigned short)f2bf(s * inv - uv); s -= bf2f(UB[(16 + rs + r - w + 1) * POOL_LD + c]); }
        LDS_WAIT(); __syncthreads();
        pool_mma_store(F, A, r0, g);
    } else {
        const int g = L - 512, w = 2 << g; const float invw = 1.0f / (float)w;
        const float* us = F.out + O_POOLS;
        for (int r = 0; r < 32; ++r) { const int smp = strip * 32 + r; const float uv = us[(size_t)(smp * 15 + 14) * PW + g * 128 + c]; float s = uv;
            for (int j = 1; j < w; ++j) s += ((const float*)A.in[6])[(size_t)(smp * 15 + 15 - j) * PW + g * 128 + c];
            DB[smp * POOL_LD + c] = (unsigned short)f2bf(s * invw - uv); }
        LDS_WAIT(); __syncthreads();
        pool_mma_store(F, A, MP, g);
    }
    LDS_WAIT(); __syncthreads();
}
__device__ __forceinline__ void sample_moba(Frame& F, const Args& A, int b) {
    const int h = F.wave, lane = F.lane, sub = lane & 15, rw = lane >> 4;
    LAS float* LG = (LAS float*)(F.lds + RING_OFF + h * 8192);
    const int* pt = ((const int*)A.in[7]) + b * NPAGES;
    const float* QS = WSP(float, WS_QS);
    f32x4 qv = *(const GAS f32x4*)(QS + (size_t)b * 512 + h * 64 + 4 * sub); qv = qv * 0.125f;
    LAS float* BS = (LAS float*)(F.lds + RING_OFF + 65536 + h * 64);
#pragma unroll 1
    for (int n = 0; n < 8; ++n) {
        float sacc = 0.f;
#pragma unroll 1
        for (int pg = 0; pg < 2; ++pg) { const int page = __builtin_amdgcn_readfirstlane(pt[2 * n + pg]);
            const float* base = ((const float*)A.in[2]) + ((size_t)page * PAGE * NH + h) * HD + 4 * sub;
#pragma unroll 1
            for (int g8 = 0; g8 < 4; ++g8) { f32x4 kv[8];
#pragma unroll
                for (int u = 0; u < 8; ++u) kv[u] = __builtin_nontemporal_load((const GAS f32x4*)(base + (size_t)(4 * (g8 * 8 + u) + rw) * (NH * HD)));
#pragma unroll
                for (int u = 0; u < 8; ++u) { float p = (kv[u][0] * qv[0] + kv[u][1] * qv[1]) + (kv[u][2] * qv[2] + kv[u][3] * qv[3]);
                    p += __shfl_xor(p, 1); p += __shfl_xor(p, 2); p += __shfl_xor(p, 4); p += __shfl_xor(p, 8);
                    if (sub == 0) LG[n * 256 + pg * 128 + 4 * (g8 * 8 + u) + rw] = p; sacc += p; } } }
        sacc += __shfl_xor(sacc, 16); sacc += __shfl_xor(sacc, 32); if (lane == 0) BS[n] = sacc;
    }
    LDS_WAIT();
    float bsum[8];
#pragma unroll
    for (int n = 0; n < 8; ++n) bsum[n] = BS[n];
    unsigned sel = 0u;
#pragma unroll
    for (int n = 0; n < 8; ++n) { int rk = 0;
#pragma unroll
        for (int m2 = 0; m2 < 8; ++m2) if (m2 != n) rk += (bsum[m2] > bsum[n] || (bsum[m2] == bsum[n] && m2 < n)) ? 1 : 0;
        if (rk < 3) sel |= 1u << n; }
    sel = __builtin_amdgcn_readfirstlane(sel);
    const f32x4 kn = *(const GAS f32x4*)(F.out + O_KS + (size_t)b * 512 + h * 64 + 4 * sub); const f32x4 vn = *(const GAS f32x4*)(F.out + O_VS + (size_t)b * 512 + h * 64 + 4 * sub);
    float pown = (kn[0] * qv[0] + kn[1] * qv[1]) + (kn[2] * qv[2] + kn[3] * qv[3]);
    pown += __shfl_xor(pown, 1); pown += __shfl_xor(pown, 2); pown += __shfl_xor(pown, 4); pown += __shfl_xor(pown, 8);
    LDS_WAIT();
    float mx = pown;
#pragma unroll
    for (int n = 0; n < 8; ++n) if ((sel >> n) & 1u) { const f32x4 l4 = *(const LAS f32x4*)(LG + n * 256 + 4 * lane); mx = __builtin_fmaxf(mx, __builtin_fmaxf(__builtin_fmaxf(l4[0], l4[1]), __builtin_fmaxf(l4[2], l4[3]))); }
    mx = wave_max(mx);
    f32x4 oacc = {0.f, 0.f, 0.f, 0.f}; float lsum = 0.f;
#pragma unroll 1
    for (int n = 0; n < 8; ++n) if ((sel >> n) & 1u) {
#pragma unroll 1
        for (int pg = 0; pg < 2; ++pg) { const int page = __builtin_amdgcn_readfirstlane(pt[2 * n + pg]);
            const float* base = ((const float*)A.in[3]) + ((size_t)page * PAGE * NH + h) * HD + 4 * sub;
            for (int g8 = 0; g8 < 4; ++g8) { f32x4 vv[8];
#pragma unroll
                for (int u = 0; u < 8; ++u) vv[u] = __builtin_nontemporal_load((const GAS f32x4*)(base + (size_t)(4 * (g8 * 8 + u) + rw) * (NH * HD)));
#pragma unroll
                for (int u = 0; u < 8; ++u) { const float e = __expf(LG[n * 256 + pg * 128 + 4 * (g8 * 8 + u) + rw] - mx); lsum += e; oacc += vv[u] * e; } } } }
    { const float e = __expf(pown - mx); if (rw == 0) { lsum += e; oacc += vn * e; } }
    lsum += __shfl_xor(lsum, 16); lsum += __shfl_xor(lsum, 32);
#pragma unroll
    for (int j = 0; j < 4; ++j) { float v = oacc[j]; v += __shfl_xor(v, 16); v += __shfl_xor(v, 32); oacc[j] = v; }
    if (lane < 16) { const float inv = 1.0f / lsum; v2u o; o.x = pk2(oacc[0] * inv, oacc[1] * inv); o.y = pk2(oacc[2] * inv, oacc[3] * inv);
        *(GAS v2u*)(WSP(bf16, WS_MIX) + (size_t)(MP + b) * D + PW + h * 64 + 4 * sub) = o; }
    LDS_WAIT();
}
__device__ __forceinline__ void sample_cross(Frame& F, const Args& A, int b) {
    const int lane = F.lane, w = F.wave;
    LAS float* LG = (LAS float*)(F.lds + RING_OFF);
    LAS float* PO = (LAS float*)(F.lds + RING_OFF + 4096);
    const bf16* qrow = WSP(bf16, WS_QC) + (size_t)(MP + b) * D;
    f32x4 q[4];
#pragma unroll
    for (int hh = 0; hh < 4; ++hh) { const v2u t = *(const GAS v2u*)(qrow + hh * 256 + 4 * lane); q[hh] = (f32x4){__uint_as_float(t.x << 16), __uint_as_float(t.x & 0xffff0000u), __uint_as_float(t.y << 16), __uint_as_float(t.y & 0xffff0000u)}; }
    const float* kb = ((const float*)A.in[4]) + (size_t)b * 256 * D;
    for (int k0 = 0; k0 < 32; k0 += 2) { f32x4 kv[2][4];
#pragma unroll
        for (int u = 0; u < 2; ++u)
#pragma unroll
            for (int hh = 0; hh < 4; ++hh) kv[u][hh] = __builtin_nontemporal_load((const GAS f32x4*)(kb + (size_t)(w + 8 * (k0 + u)) * D + hh * 256 + 4 * lane));
#pragma unroll
        for (int u = 0; u < 2; ++u)
#pragma unroll
            for (int hh = 0; hh < 4; ++hh) { float p = (kv[u][hh][0] * q[hh][0] + kv[u][hh][1] * q[hh][1]) + (kv[u][hh][2] * q[hh][2] + kv[u][hh][3] * q[hh][3]); p = wave_sum(p); if (lane == 0) LG[hh * 256 + w + 8 * (k0 + u)] = p; } }
    LDS_WAIT(); __syncthreads();
    if (w < 4) { const f32x4 l4 = *(const LAS f32x4*)(LG + w * 256 + 4 * lane); const float mx = wave_max(__builtin_fmaxf(__builtin_fmaxf(l4[0], l4[1]), __builtin_fmaxf(l4[2], l4[3])));
        f32x4 e; e[0] = __builtin_amdgcn_exp2f(l4[0] - mx); e[1] = __builtin_amdgcn_exp2f(l4[1] - mx); e[2] = __builtin_amdgcn_exp2f(l4[2] - mx); e[3] = __builtin_amdgcn_exp2f(l4[3] - mx);
        const float inv = 1.0f / wave_sum((e[0] + e[1]) + (e[2] + e[3])); *(LAS f32x4*)(LG + w * 256 + 4 * lane) = e * inv; }
    LDS_WAIT(); __syncthreads();
    const float* vb = ((const float*)A.in[5]) + (size_t)b * 256 * D;
    f32x4 oacc[4];
#pragma unroll
    for (int hh = 0; hh < 4; ++hh) oacc[hh] = (f32x4){0.f, 0.f, 0.f, 0.f};
    for (int k0 = 0; k0 < 32; k0 += 2) { f32x4 vv[2][4];
#pragma unroll
        for (int u = 0; u < 2; ++u)
#pragma unroll
            for (int hh = 0; hh < 4; ++hh) vv[u][hh] = __builtin_nontemporal_load((const GAS f32x4*)(vb + (size_t)(w + 8 * (k0 + u)) * D + hh * 256 + 4 * lane));
#pragma unroll
        for (int u = 0; u < 2; ++u)
#pragma unroll
            for (int hh = 0; hh < 4; ++hh) oacc[hh] += vv[u][hh] * LG[hh * 256 + w + 8 * (k0 + u)]; }
#pragma unroll
    for (int hh = 0; hh < 4; ++hh) *(LAS f32x4*)(PO + w * 1024 + hh * 256 + 4 * lane) = oacc[hh];
    LDS_WAIT(); __syncthreads();
    { const int c = 2 * F.tid; float a0 = 0.f, a1 = 0.f;
#pragma unroll
      for (int ww = 0; ww < 8; ++ww) { a0 += PO[ww * 1024 + c]; a1 += PO[ww * 1024 + c + 1]; }
      *(GAS unsigned*)(WSP(bf16, WS_OC) + (size_t)(MP + b) * D + c) = pk2(a0, a1); }
    LDS_WAIT(); __syncthreads();
}
__device__ __forceinline__ void cross_unit(Frame& F, int pm, int h) {
    const int b = pm >> 3;
    bf16* PB = WSP(bf16, WS_PB) + (size_t)blockIdx.x * 65536;
    { pg8::Gemm g{WSP(bf16, WS_QC) + (size_t)pm * 256 * D + h * 256, WSP(bf16, WS_MKB) + (size_t)b * 256 * D + h * 256, 256, D, D};
      pg8::EpiSoftmaxP E{PB}; pg8::OneUnit S;
      pg8::gemm_phase<pg8::EpiSoftmaxP, pg8::OneUnit, false, true>(F.lds + RING_OFF, g, S, E); }
    VM_WAIT(); __syncthreads(); __builtin_amdgcn_fence(__ATOMIC_ACQUIRE, "agent"); VM_WAIT(); __syncthreads();
    { pg8::Gemm g{PB, WSP(bf16, WS_MVT) + (size_t)(b * 4 + h) * 65536, 256, 256, 256};
      pg8::EpiTile E{WSP(bf16, WS_OC) + (size_t)pm * 256 * D + h * 256, D}; pg8::OneUnit S;
      pg8::gemm_phase<pg8::EpiTile, pg8::OneUnit, false, true>(F.lds + RING_OFF, g, S, E); }
    VM_WAIT(); __syncthreads();
}
__device__ __forceinline__ void final_norm(Frame& F, const Args& A) {
    const int gw = F.vcu * NWAVES + F.wave, NGW = F.G * NWAVES; const float* ss3 = (const float*)(F.ctl + CW_SS3);
    for (int m = gw; m < MP + NS; m += NGW) { float* row = m < MP ? F.out + O_YP + (size_t)m * D : F.out + O_YS + (size_t)(m - MP) * D;
        const float r = 1.0f / sqrtf(ss3[m] * (1.0f / D) + EPS); GAS f32x4* xr = (GAS f32x4*)row + F.lane; const GAS f32x4* gr = (const GAS f32x4*)((const float*)A.in[23]) + F.lane;
#pragma unroll
        for (int j = 0; j < 4; ++j) { const f32x4 v = xr[64 * j], g = gr[64 * j]; xr[64 * j] = v * r * g; } }
}
#ifndef SKIPMASK
#define SKIPMASK 0
#endif
__global__ void __launch_bounds__(NWAVES * 64, 2) mk_fwd(Args args) {
    const Args& A = args;
    extern __shared__ __attribute__((aligned(16))) unsigned char lds[];
    Frame F;
    F.lds = (LAS unsigned char*)lds;
    F.MISC = (volatile LAS unsigned*)(F.lds + MISC_OFF);
    F.tid = threadIdx.x; F.lane = F.tid & 63; F.wave = __builtin_amdgcn_readfirstlane(F.tid >> 6);
    F.G = gridDim.x; { const int bx = blockIdx.x; F.vcu = (F.G % 8 == 0) ? (bx % 8) * (F.G / 8) + bx / 8 : bx; }
    F.ws = args.ws; F.out = args.out; F.ctl = (gu32*)(args.ws + WS_CTL);
    for (int u = F.tid; u < (LDS_BYTES - LDSCTL_OFF) / 4; u += NWAVES * 64) ((LAS unsigned*)(F.lds + LDSCTL_OFF))[u] = 0u;
    __syncthreads();
    XcdBarrier bar; bar.bar = (unsigned*)(F.ctl + CW_BAR); bar.x = 0; bar.st = nullptr;
    if (N_LAUNCHES != PER_PHASE) bar = xcd_barrier_post((unsigned*)(F.ctl + CW_BAR), F.MISC + 8);
#define GRID_BAR(seam) do { if (N_LAUNCHES == PER_PHASE) { if (F.tid == 0) __hip_atomic_store(F.ctl + CW_TMO, 0xBADBA0u | (unsigned)(seam), RLX_AGENT); } else { xcd_barrier(bar); } } while (0)
    const int lo = args.ph_lo, hi = args.ph_hi;
#define IN(k) (lo <= (k) && (k) < hi)
#define BOTH(k) (IN(k) && IN((k) + 1))
    float* const ss1 = (float*)(F.ctl + CW_SS1); float* const ss2 = (float*)(F.ctl + CW_SS2); float* const ss3 = (float*)(F.ctl + CW_SS3);
    float* const X1 = WSP(float, WS_X1);

    if (IN(0) && !(SKIPMASK & (1 << 0))) { p0_prologue(F, A); if (BOTH(0)) GRID_BAR(0); }

    if (IN(1) && !(SKIPMASK & (1 << 1))) {
        pg8::Gemm g{WSP(bf16, WS_XN), WSP(bf16, WS_WIN), D, D, D}; pg8::SchedP1 S; S.init(F.G, (int)blockIdx.x);
        float* rc = WSP(float, WS_ROPE);
        pg8::EpiQKV E{WSP(bf16, WS_U), WSP(bf16, WS_Q), WSP(bf16, WS_K), WSP(bf16, WS_V), WSP(bf16, WS_MKB), WSP(bf16, WS_MVT), WSP(float, WS_QS), (float*)(F.ctl + CW_KSUM), rc, rc + 2049 * 32,
                      F.out + O_KP, F.out + O_VP, F.out + O_POOLP, F.out + O_MK, F.out + O_MV, F.out + O_KS, F.out + O_VS, F.out + O_POOLS, attn_body::C2};
        pg8::gemm_phase<pg8::EpiQKV, pg8::SchedP1, true, true>(F.lds + RING_OFF, g, S, E);
        if (BOTH(1)) GRID_BAR(1);
    }

    if (IN(2) && !(SKIPMASK & (1 << 2))) {
        const attn_body::AttnTensors AT{(const attn_body::bf16*)WSP(bf16, WS_Q), (const attn_body::bf16*)WSP(bf16, WS_K), (const attn_body::bf16*)WSP(bf16, WS_V), (attn_body::bf16*)(WSP(bf16, WS_MIX) + PW), D, (const float*)(F.ctl + CW_KSUM)};
#if !defined(P2VAR) || P2VAR == 1
        for (int L = F.vcu; L < 512; L += F.G) { const int j = L & 255, bh = j >> 2, s = j & 3, qb = (L < 256) ? s : 7 - s;
            attn_body::attn_unit<8>(bh >> 3, bh & 7, qb, AT.Q, AT.K, AT.V, AT.O, AT.opitch, AT.KS, (char*)lds + RING_OFF); }
        __syncthreads();
#endif
#if !defined(P2VAR) || P2VAR == 2
        for (int L = F.vcu; L < 516; L += F.G) pool_unit(F, A, L);
#endif
#if !defined(P2VAR) || P2VAR == 3
        for (int b = F.vcu; b < NS; b += F.G) sample_moba(F, A, b);
#endif
        if (BOTH(2)) GRID_BAR(2);
    }

    if (IN(3) && !(SKIPMASK & (1 << 3))) {
        pg8::Gemm g{WSP(bf16, WS_MIX), WSP(bf16, WS_WOUT), D, D, D}; pg8::StaticOrder S; S.init(MALL, D, F.G, (int)blockIdx.x);
        pg8::EpiRes E{((const float*)A.in[0]), ((const float*)A.in[1]), X1, X1 + (size_t)MP * D, WSP(bf16, WS_XG), ((const float*)A.in[14]), ss1};
        pg8::gemm_phase<pg8::EpiRes, pg8::StaticOrder, true, true>(F.lds + RING_OFF, g, S, E);
        if (BOTH(3)) GRID_BAR(3);
    }
    if (IN(4) && !(SKIPMASK & (1 << 4))) {
        pg8::Gemm g{WSP(bf16, WS_XG), WSP(bf16, WS_WCQ), D, D, D}; pg8::StaticOrder S; S.init(MALL, D, F.G, (int)blockIdx.x);
        pg8::EpiScale<0> E{WSP(bf16, WS_QC), D, ss1, CROSS_C2};
        pg8::gemm_phase<pg8::EpiScale<0>, pg8::StaticOrder, true, true>(F.lds + RING_OFF, g, S, E);
        if (BOTH(4)) GRID_BAR(4);
    }
    if (IN(5) && !(SKIPMASK & (1 << 5))) {
#if !defined(P5VAR) || P5VAR == 1
        for (int L = F.vcu; L < 256; L += F.G) cross_unit(F, L >> 2, L & 3);
#endif
#if !defined(P5VAR) || P5VAR == 2
        for (int b = F.vcu; b < NS; b += F.G) sample_cross(F, A, b);
#endif
        if (BOTH(5)) GRID_BAR(5);
    }
    if (IN(6) && !(SKIPMASK & (1 << 6))) {
        pg8::Gemm g{WSP(bf16, WS_OC), WSP(bf16, WS_WCO), D, D, D}; pg8::StaticOrder S; S.init(MALL, D, F.G, (int)blockIdx.x);
        pg8::EpiRes E{X1, X1 + (size_t)MP * D, X1, X1 + (size_t)MP * D, WSP(bf16, WS_XG), ((const float*)A.in[20]), ss2};
        pg8::gemm_phase<pg8::EpiRes, pg8::StaticOrder, true, true>(F.lds + RING_OFF, g, S, E);
        if (BOTH(6)) GRID_BAR(6);
    }
    if (IN(7) && !(SKIPMASK & (1 << 7))) {
        pg8::Gemm g{WSP(bf16, WS_XG), WSP(bf16, WS_WUP), D, D, D}; pg8::StaticOrder S; S.init(MALL, FF, F.G, (int)blockIdx.x);
        pg8::EpiScale<1> E{WSP(bf16, WS_HB), FF, ss2, 1.0f};
        pg8::gemm_phase<pg8::EpiScale<1>, pg8::StaticOrder, true, true>(F.lds + RING_OFF, g, S, E);
        if (BOTH(7)) GRID_BAR(7);
    }
    if (IN(8) && !(SKIPMASK & (1 << 8))) {
        pg8::Gemm g{WSP(bf16, WS_HB), WSP(bf16, WS_WDN), FF, FF, FF}; pg8::StaticOrder S; S.init(MALL, D, F.G, (int)blockIdx.x);
        pg8::EpiRes E{X1, X1 + (size_t)MP * D, F.out + O_YP, F.out + O_YS, nullptr, nullptr, ss3};
        pg8::gemm_phase<pg8::EpiRes, pg8::StaticOrder, true, true>(F.lds + RING_OFF, g, S, E);
        if (BOTH(8)) GRID_BAR(8);
    }
    if (IN(9) && !(SKIPMASK & (1 << 9))) { final_norm(F, A); }
#undef IN
#undef BOTH
}

extern "C" void kernel_launch(void* const* d_in, const int* in_sizes, int n_in, void* d_out, int out_size, void* d_ws, size_t ws_size, hipStream_t stream) {
    static int grid = 0;
    if (grid == 0) {
        if (n_in != 24 || in_sizes[0] != MP * D || (size_t)out_size != O_END || ws_size < WS_END) { fprintf(stderr, "kernel_launch: unexpected shapes: n_in %d in0 %d out %d ws %zu; nothing launched\n", n_in, n_in > 0 ? in_sizes[0] : -1, out_size, ws_size); grid = -1; return; }
        int dev = 0, cus = 0, per_cu = 0;
        if (hipGetDevice(&dev) != hipSuccess || hipDeviceGetAttribute(&cus, hipDeviceAttributeMultiprocessorCount, dev) != hipSuccess) { fprintf(stderr, "kernel_launch: hipGetDevice / hipDeviceGetAttribute failed\n"); grid = -1; return; }
        if (hipFuncSetAttribute((const void*)mk_fwd, hipFuncAttributeMaxDynamicSharedMemorySize, LDS_BYTES) != hipSuccess) { fprintf(stderr, "kernel_launch: hipFuncSetAttribute failed\n"); grid = -1; return; }
        if (hipOccupancyMaxActiveBlocksPerMultiprocessor(&per_cu, (const void*)mk_fwd, NWAVES * 64, LDS_BYTES) != hipSuccess || per_cu < 1) { fprintf(stderr, "kernel_launch: occupancy query reports %d workgroups per CU\n", per_cu); }
        (void)hipGetLastError();
        grid = cus;
        if (grid > 256) grid = 256;
    }
    if (grid < 0) return;
    if (hipMemsetAsync((char*)d_ws + WS_CTL, 0, CTL_ZERO_BYTES, stream) != hipSuccess) { fprintf(stderr, "kernel_launch: hipMemsetAsync failed\n"); return; }
    Args a{};
    for (int i = 0; i < 24; ++i) a.in[i] = d_in[i];
    a.out = (float*)d_out; a.ws = (unsigned char*)d_ws;
    for (int li = 0; li < N_LAUNCHES; ++li) {
        a.ph_lo = (N_LAUNCHES == PER_PHASE) ? li : 0; a.ph_hi = (N_LAUNCHES == PER_PHASE) ? li + 1 : PER_PHASE;
        hipLaunchKernelGGL(mk_fwd, dim3(grid), dim3(NWAVES * 64), LDS_BYTES, stream, a);
        const hipError_t le = hipPeekAtLastError();
        if (le != hipSuccess) { fprintf(stderr, "kernel_launch: launch %d failed: %s\n", li, hipGetErrorName(le)); break; }
    }
}
```

```cpp
#include <hip/hip_runtime.h>
#include <cstdio>
#include <cstdint>
#include <cmath>
namespace pg8 {
#define PG8_LAS __attribute__((address_space(3)))
typedef unsigned short bf16_t;
typedef short bf16x8 __attribute__((ext_vector_type(8)));
typedef float f32x4 __attribute__((ext_vector_type(4)));
typedef unsigned u32x4 __attribute__((ext_vector_type(4)));
constexpr int BM = 256, BK = 64, HALF = 128, HTB = HALF * BK * 2  , STAGE_BYTES = 8 * HTB, NXCD = 8, WGM = 8;

__host__ __device__ __forceinline__ int lds_byte(int r, int c) { const int st = (r >> 4) * 2 + (c >> 5), rr = r & 15, cc = c & 31, ob = rr * 64 + cc * 2; return st * 1024 + (ob ^ (((ob >> 9) & 1) << 5)); }
__host__ __device__ __forceinline__ void stage_rc(int b, int& R, int& C) { const int st = b / 1024, sb = b % 1024, swz = sb ^ (((sb >> 9) & 1) << 5); R = (st >> 1) * 16 + swz / 64; C = (st & 1) * 32 + (swz % 64) / 2; }
__host__ __device__ __forceinline__ int perm32(int rho) { const int n = rho >> 4, i = rho & 15; return 8 * (i >> 2) + 4 * n + (i & 3); }

struct Unit { int pm, pn; };
struct Gemm { const bf16_t* A; const bf16_t* Bt; int K, lda, ldb; };

struct StaticOrder {
    int nM, nN, nwg, G, c;
    __host__ __device__ void init(int M, int N, int G_, int c_) { nM = M / BM; nN = N / BM; nwg = nM * nN; G = G_; c = c_; }
    __host__ __device__ bool next(int i, Unit& u) const {
        const long L = (long)i * G + c; if (L >= nwg) return false;
        int wgid = (int)L; { const int q = nwg / NXCD, r = nwg % NXCD, xcd = wgid % NXCD, off = wgid / NXCD; wgid = (xcd < r ? xcd * (q + 1) : r * (q + 1) + (xcd - r) * q) + off; }
        const int nig = WGM * nN, gid = wgid / nig, fm = gid * WGM, gsz = (nM - fm) < WGM ? (nM - fm) : WGM;
        u.pm = fm + ((wgid % nig) % gsz); u.pn = (wgid % nig) / gsz; return true;
    }
    __device__ __forceinline__ void a_ready(const Unit&) const {}
    __device__ __forceinline__ void done(const Unit&) const {}
};

__device__ __forceinline__ unsigned cvt_pk_bf16(float lo, float hi) { unsigned r; asm volatile("v_cvt_pk_bf16_f32 %0, %1, %2" : "=v"(r) : "v"(lo), "v"(hi)); return r; }
typedef float f32x2 __attribute__((ext_vector_type(2)));
__device__ __forceinline__ float xshfl(float v, int m, int lane) { return __builtin_bit_cast(float, __builtin_amdgcn_ds_bpermute((lane ^ m) << 2, __builtin_bit_cast(int, v))); }
__device__ __forceinline__ u32x4 pack8(const f32x4 a, const f32x4 b) { u32x4 w; w.x = cvt_pk_bf16(a[0], a[1]); w.y = cvt_pk_bf16(a[2], a[3]); w.z = cvt_pk_bf16(b[0], b[1]); w.w = cvt_pk_bf16(b[2], b[3]); return w; }
__device__ __forceinline__ unsigned short bf16_1(float v) { return (unsigned short)(cvt_pk_bf16(v, 0.f) & 0xffffu); }


struct EpiQKV {
    static constexpr bool PERM = true, AFTER_DRAIN = false;
    bf16_t *U, *Q, *Kb, *V, *MKB, *MVT; float *ksum; const float *ropeC, *ropeS;
    float *o_kp, *o_vp, *o_poolp, *o_mk, *o_mv; float qscale;
    __device__ __forceinline__ void operator()(const f32x4 (&acc)[2][2][4][2], const Unit& u, int wr, int wc, int fr, int fq) const {
        const int pm = u.pm, pn = u.pn;
        if (pm >= 65) {
            const int isv = (pn - 8) >> 2, ct = (pn - 8) & 3;
#pragma unroll
            for (int ai = 0; ai < 2; ++ai)
#pragma unroll
                for (int m = 0; m < 4; ++m) { const int mrow = (pm - 65) * 256 + ai * 128 + wr * 64 + m * 16 + fr;
#pragma unroll
                    for (int bj = 0; bj < 2; ++bj) { const int cl = bj * 128 + wc * 32 + 8 * fq, col = ct * 256 + cl; const f32x4 v0 = acc[ai][bj][m][0], v1 = acc[ai][bj][m][1];
                        float* o = (isv ? o_mv : o_mk) + (size_t)mrow * 1024 + col; *(f32x4*)o = v0; *(f32x4*)(o + 4) = v1;
                        if (!isv) { *(u32x4*)(MKB + (size_t)mrow * 1024 + col) = pack8(v0, v1); }
                        else { const int b = mrow >> 8, key = mrow & 255; bf16_t* t = MVT + ((size_t)(b * 4 + ct) * 256 + cl) * 256 + key;
                            t[0 * 256] = bf16_1(v0[0]); t[1 * 256] = bf16_1(v0[1]); t[2 * 256] = bf16_1(v0[2]); t[3 * 256] = bf16_1(v0[3]);
                            t[4 * 256] = bf16_1(v1[0]); t[5 * 256] = bf16_1(v1[1]); t[6 * 256] = bf16_1(v1[2]); t[7 * 256] = bf16_1(v1[3]); } } }
            return;
        }
        const int kind = pn >> 1, half = pn & 1;
        if (kind == 0) {
#pragma unroll
            for (int ai = 0; ai < 2; ++ai)
#pragma unroll
                for (int m = 0; m < 4; ++m) { const int row = pm * 256 + ai * 128 + wr * 64 + m * 16 + fr;
#pragma unroll
                    for (int bj = 0; bj < 2; ++bj) { const int col = half * 256 + bj * 128 + wc * 32 + 8 * fq; const f32x4 v0 = acc[ai][bj][m][0], v1 = acc[ai][bj][m][1];
                        *(u32x4*)(U + (size_t)row * 512 + col) = pack8(v0, v1);
                        { const int pos = row & 2047; if (pos >= 2033) { float* o = o_poolp + ((size_t)((row >> 11) * 15 + pos - 2033) * 512 + col); *(f32x4*)o = v0; *(f32x4*)(o + 4) = v1; } } } }
        } else if (kind == 3) {
#pragma unroll
            for (int ai = 0; ai < 2; ++ai)
#pragma unroll
                for (int m = 0; m < 4; ++m) { const int row = pm * 256 + ai * 128 + wr * 64 + m * 16 + fr;
#pragma unroll
                    for (int bj = 0; bj < 2; ++bj) { const int col = half * 256 + bj * 128 + wc * 32 + 8 * fq; const f32x4 v0 = acc[ai][bj][m][0], v1 = acc[ai][bj][m][1];
                        *(u32x4*)(V + (size_t)row * 512 + col) = pack8(v0, v1);
                        { float* o = o_vp + (size_t)row * 512 + col; *(f32x4*)o = v0; *(f32x4*)(o + 4) = v1; } } }
        } else {
            const int head = half * 4 + wc, i0 = 8 * fq, col1 = head * 64 + i0, col2 = col1 + 32;
            f32x4 cs1a = {0.f, 0.f, 0.f, 0.f}, cs1b = cs1a, cs2a = cs1a, cs2b = cs1a;
#pragma unroll
            for (int ai = 0; ai < 2; ++ai)
#pragma unroll
                for (int m = 0; m < 4; ++m) { const int row = pm * 256 + ai * 128 + wr * 64 + m * 16 + fr; const int pos = row & 2047;
                    const f32x4 c0 = *(const f32x4*)(ropeC + pos * 32 + i0), c1 = *(const f32x4*)(ropeC + pos * 32 + i0 + 4), s0 = *(const f32x4*)(ropeS + pos * 32 + i0), s1 = *(const f32x4*)(ropeS + pos * 32 + i0 + 4);
                    const f32x4 x1a = acc[ai][0][m][0], x1b = acc[ai][0][m][1], x2a = acc[ai][1][m][0], x2b = acc[ai][1][m][1];
                    const f32x4 o1a = x1a * c0 - x2a * s0, o1b = x1b * c1 - x2b * s1, o2a = x2a * c0 + x1a * s0, o2b = x2b * c1 + x1b * s1;
                    if (kind == 1) {
                        *(u32x4*)(Q + (size_t)row * 512 + col1) = pack8(o1a * qscale, o1b * qscale); *(u32x4*)(Q + (size_t)row * 512 + col2) = pack8(o2a * qscale, o2b * qscale);
                    } else {
                        *(u32x4*)(Kb + (size_t)row * 512 + col1) = pack8(o1a, o1b); *(u32x4*)(Kb + (size_t)row * 512 + col2) = pack8(o2a, o2b);
                        { float* o = o_kp + (size_t)row * 512; *(f32x4*)(o + col1) = o1a; *(f32x4*)(o + col1 + 4) = o1b; *(f32x4*)(o + col2) = o2a; *(f32x4*)(o + col2 + 4) = o2b;
                            cs1a += o1a; cs1b += o1b; cs2a += o2a; cs2b += o2b; }
                    } }
            if (kind == 2) {
                float cs[16] = {cs1a[0], cs1a[1], cs1a[2], cs1a[3], cs1b[0], cs1b[1], cs1b[2], cs1b[3], cs2a[0], cs2a[1], cs2a[2], cs2a[3], cs2b[0], cs2b[1], cs2b[2], cs2b[3]};
#pragma unroll
                for (int j = 0; j < 16; ++j) { float v = cs[j]; v += xshfl(v, 1, fr + 16 * fq); v += xshfl(v, 2, fr + 16 * fq); v += xshfl(v, 4, fr + 16 * fq); v += xshfl(v, 8, fr + 16 * fq); cs[j] = v; }
                if (fr == 0) { float* kp = ksum + (size_t)pm * 512;
#pragma unroll
                    for (int j = 0; j < 8; ++j) { unsafeAtomicAdd(kp + col1 + j, cs[j]); unsafeAtomicAdd(kp + col2 + j, cs[8 + j]); } }
            }
        }
    }
};

struct EpiRes {
    static constexpr bool PERM = true, AFTER_DRAIN = false;
    const float* base; float* out; bf16_t* XG; const float* gain; float* rowss;
    __device__ __forceinline__ void operator()(const f32x4 (&acc)[2][2][4][2], const Unit& u, int wr, int wc, int fr, int fq) const {
#pragma unroll
        for (int ai = 0; ai < 2; ++ai)
#pragma unroll
            for (int m = 0; m < 4; ++m) { const int row = u.pm * 256 + ai * 128 + wr * 64 + m * 16 + fr;
                const float* bp = base + (size_t)row * 1024; float* op = out + (size_t)row * 1024;
                float ss = 0.f;
#pragma unroll
                for (int bj = 0; bj < 2; ++bj) { const int col = u.pn * 256 + bj * 128 + wc * 32 + 8 * fq;
                    const f32x4 x0 = *(const f32x4*)(bp + col) + acc[ai][bj][m][0], x1 = *(const f32x4*)(bp + col + 4) + acc[ai][bj][m][1];
                    *(f32x4*)(op + col) = x0; *(f32x4*)(op + col + 4) = x1;
                    ss += (x0[0] * x0[0] + x0[1] * x0[1]) + (x0[2] * x0[2] + x0[3] * x0[3]) + (x1[0] * x1[0] + x1[1] * x1[1]) + (x1[2] * x1[2] + x1[3] * x1[3]);
                    if (XG) { const f32x4 g0 = *(const f32x4*)(gain + col), g1 = *(const f32x4*)(gain + col + 4); *(u32x4*)(XG + (size_t)row * 1024 + col) = pack8(x0 * g0, x1 * g1); } }
                ss += xshfl(ss, 16, fr + 16 * fq); ss += xshfl(ss, 32, fr + 16 * fq);
                if (fq == 0) unsafeAtomicAdd(rowss + row, ss);
            }
    }
};
template <int ACT> struct EpiScale {
    static constexpr bool PERM = true, AFTER_DRAIN = false;
    bf16_t* O; int ldc; const float* rowss; float sc;
    __device__ __forceinline__ void operator()(const f32x4 (&acc)[2][2][4][2], const Unit& u, int wr, int wc, int fr, int fq) const {
#pragma unroll
        for (int ai = 0; ai < 2; ++ai)
#pragma unroll
            for (int m = 0; m < 4; ++m) { const int row = u.pm * 256 + ai * 128 + wr * 64 + m * 16 + fr;
                const float r = __builtin_amdgcn_rsqf(rowss[row] * (1.0f / 1024.0f) + 1e-6f) * sc;
#pragma unroll
                for (int bj = 0; bj < 2; ++bj) { const int col = u.pn * 256 + bj * 128 + wc * 32 + 8 * fq; f32x4 v0 = acc[ai][bj][m][0] * r, v1 = acc[ai][bj][m][1] * r;
                    if (ACT == 1) { v0 = __builtin_elementwise_max(v0, (f32x4){0.f, 0.f, 0.f, 0.f}); v1 = __builtin_elementwise_max(v1, (f32x4){0.f, 0.f, 0.f, 0.f}); v0 = v0 * v0; v1 = v1 * v1; }
                    *(u32x4*)(O + (size_t)row * ldc + col) = pack8(v0, v1); } }
    }
};
struct EpiTile {
    static constexpr bool PERM = true, AFTER_DRAIN = false;
    bf16_t* O; int ldc;
    __device__ __forceinline__ void operator()(const f32x4 (&acc)[2][2][4][2], const Unit&, int wr, int wc, int fr, int fq) const {
#pragma unroll
        for (int ai = 0; ai < 2; ++ai)
#pragma unroll
            for (int m = 0; m < 4; ++m) { const int row = ai * 128 + wr * 64 + m * 16 + fr;
#pragma unroll
                for (int bj = 0; bj < 2; ++bj) { const int col = bj * 128 + wc * 32 + 8 * fq; *(u32x4*)(O + (size_t)row * ldc + col) = pack8(acc[ai][bj][m][0], acc[ai][bj][m][1]); } }
    }
};
struct EpiSoftmaxP {
    static constexpr bool PERM = true, AFTER_DRAIN = true;
    bf16_t* P;
    __device__ __forceinline__ void fused(f32x4 (&acc)[2][2][4][2], const Unit&, int wr, int wc, int fr, int fq, PG8_LAS unsigned char* lds, int, int) const {
        PG8_LAS float* MX = (PG8_LAS float*)lds; PG8_LAS float* SM = (PG8_LAS float*)(lds + 4096);
#ifdef SOFTMAX_TRIVIAL
        if (fq == 0) MX[fr] = acc[0][0][0][0][0]; return;
#endif
#pragma unroll
        for (int ai = 0; ai < 2; ++ai)
#pragma unroll
            for (int m = 0; m < 4; ++m) { float mx = -INFINITY;
#pragma unroll
                for (int bj = 0; bj < 2; ++bj)
#pragma unroll
                    for (int n = 0; n < 2; ++n) { const f32x4 x = acc[ai][bj][m][n]; mx = __builtin_fmaxf(mx, __builtin_fmaxf(__builtin_fmaxf(x[0], x[1]), __builtin_fmaxf(x[2], x[3]))); }
                mx = __builtin_fmaxf(mx, xshfl(mx, 16, fr + 16 * fq)); mx = __builtin_fmaxf(mx, xshfl(mx, 32, fr + 16 * fq));
                if (fq == 0) MX[(ai * 128 + wr * 64 + m * 16 + fr) * 4 + wc] = mx; }
        asm volatile("s_waitcnt lgkmcnt(0)" ::: "memory"); __builtin_amdgcn_s_barrier(); asm volatile("" ::: "memory");
#pragma unroll
        for (int ai = 0; ai < 2; ++ai)
#pragma unroll
            for (int m = 0; m < 4; ++m) { const int r = ai * 128 + wr * 64 + m * 16 + fr; const f32x4 mv = *(const PG8_LAS f32x4*)(MX + r * 4);
                const float rm = __builtin_fmaxf(__builtin_fmaxf(mv[0], mv[1]), __builtin_fmaxf(mv[2], mv[3])); float s = 0.f;
#pragma unroll
                for (int bj = 0; bj < 2; ++bj)
#pragma unroll
                    for (int n = 0; n < 2; ++n) { f32x4 x = acc[ai][bj][m][n]; x[0] = __builtin_amdgcn_exp2f(x[0] - rm); x[1] = __builtin_amdgcn_exp2f(x[1] - rm); x[2] = __builtin_amdgcn_exp2f(x[2] - rm); x[3] = __builtin_amdgcn_exp2f(x[3] - rm);
                        s += (x[0] + x[1]) + (x[2] + x[3]); acc[ai][bj][m][n] = x; }
                s += xshfl(s, 16, fr + 16 * fq); s += xshfl(s, 32, fr + 16 * fq);
                if (fq == 0) SM[r * 4 + wc] = s; }
        asm volatile("s_waitcnt lgkmcnt(0)" ::: "memory"); __builtin_amdgcn_s_barrier(); asm volatile("" ::: "memory");
#pragma unroll
        for (int ai = 0; ai < 2; ++ai)
#pragma unroll
            for (int m = 0; m < 4; ++m) { const int r = ai * 128 + wr * 64 + m * 16 + fr; const f32x4 sv = *(const PG8_LAS f32x4*)(SM + r * 4);
                const float inv = 1.0f / ((sv[0] + sv[1]) + (sv[2] + sv[3]));
#pragma unroll
                for (int bj = 0; bj < 2; ++bj) { const int col = bj * 128 + wc * 32 + 8 * fq; *(u32x4*)(P + (size_t)r * 256 + col) = pack8(acc[ai][bj][m][0] * inv, acc[ai][bj][m][1] * inv); } }
    }
};
struct OneUnitAt {
    int pm, pn;
    __device__ __forceinline__ bool next(int i, Unit& u) const { if (i) return false; u.pm = pm; u.pn = pn; return true; }
    __device__ __forceinline__ void a_ready(const Unit&) const {}
    __device__ __forceinline__ void done(const Unit&) const {}
};
struct OneUnit {
    __device__ __forceinline__ bool next(int i, Unit& u) const { if (i) return false; u.pm = 0; u.pn = 0; return true; }
    __device__ __forceinline__ void a_ready(const Unit&) const {}
    __device__ __forceinline__ void done(const Unit&) const {}
};
struct SchedP1 {
    StaticOrder S1; int G, c;
    __device__ __forceinline__ void init(int G_, int c_) { S1.init(65 * 256, 2048, G_, c_); G = G_; c = c_; }
    __device__ __forceinline__ bool next(int i, Unit& u) const { if (S1.next(i, u)) return true; const long L = (long)i * G + c - 520; if (L < 0 || L >= 64) return false; u.pm = 65 + (int)(L & 7); u.pn = 8 + (int)(L >> 3); return true; }
    __device__ __forceinline__ void a_ready(const Unit&) const {}
    __device__ __forceinline__ void done(const Unit&) const {}
};

template <class Epi, class Sched, bool ALIGN_EPI = false, bool SP2 = false>
__device__ __forceinline__ void gemm_phase(PG8_LAS unsigned char* lds, const Gemm g, const Sched& S, const Epi& E, const int wid_in) {
    int lane_ = __builtin_amdgcn_mbcnt_hi(~0u, __builtin_amdgcn_mbcnt_lo(~0u, 0u)); asm volatile("" : "+v"(lane_));
    int wid_ = wid_in; asm volatile("" : "+s"(wid_));
    const int wid = wid_, lane = lane_, tid = wid * 64 + lane, wr = wid >> 2, wc = wid & 3, fr = lane & 15, fq = lane >> 4;
    const int K = g.K, nt = K / BK;
    unsigned voffA[2], voffB[2];
#pragma unroll
    for (int i = 0; i < 2; ++i) { int R, C; stage_rc(tid * 16 + i * 8192, R, C); const int Rb = Epi::PERM ? ((R & ~31) + perm32(R & 31)) : R;
        voffA[i] = (unsigned)(R * g.lda + C) * 2u; voffB[i] = (unsigned)(Rb * g.ldb + C) * 2u; }
    const size_t kstep = (size_t)(BK * 2);
    const size_t hstepA = (size_t)HALF * g.lda * 2, hstepB = (size_t)HALF * g.ldb * 2;
    const size_t tstepA = 2 * hstepA, tstepB = 2 * hstepB;
    const unsigned ldsw = (unsigned)wid * 1024u;
    const int aoff = lds_byte(wr * 64 + fr, fq * 8), boff = lds_byte(wc * 32 + fr, fq * 8);
#define PG8_SA(b, h) (((b) * 2 + (h)) * HTB)
#define PG8_SB(b, h) ((4 + (b) * 2 + (h)) * HTB)
#define PG8_STAGE(bufoff, gbase, voff) do { _Pragma("unroll") for (int _i = 0; _i < 2; ++_i) \
        __builtin_amdgcn_global_load_lds((const unsigned*)((const char*)(gbase) + (voff)[_i]), (PG8_LAS unsigned*)(lds + (bufoff) + ldsw + _i * 8192), 16, 0, 0); } while (0)
#define PG8_LDA(dst, b, h) do { _Pragma("unroll") for (int m = 0; m < 4; ++m) _Pragma("unroll") for (int k = 0; k < 2; ++k) dst[m][k] = *(const PG8_LAS bf16x8*)(lds + PG8_SA(b, h) + aoff + m * 2048 + k * 1024); } while (0)
#define PG8_LDB(dst, b, h) do { _Pragma("unroll") for (int n = 0; n < 2; ++n) _Pragma("unroll") for (int k = 0; k < 2; ++k) dst[n][k] = *(const PG8_LAS bf16x8*)(lds + PG8_SB(b, h) + boff + n * 2048 + k * 1024); } while (0)
#define PG8_MMA(ai, bj, At, Bt) do { __builtin_amdgcn_s_setprio(1); _Pragma("unroll") for (int m = 0; m < 4; ++m) _Pragma("unroll") for (int n = 0; n < 2; ++n) _Pragma("unroll") for (int k = 0; k < 2; ++k) \
        acc[ai][bj][m][n] = __builtin_amdgcn_mfma_f32_16x16x32_bf16(Bt[n][k], At[m][k], acc[ai][bj][m][n], 0, 0, 0); __builtin_amdgcn_s_setprio(0); } while (0)
#define PG8_WAIT_V(n) asm volatile("s_waitcnt vmcnt(" #n ")" ::: "memory")
#define PG8_WAIT_L(n) asm volatile("s_waitcnt lgkmcnt(" #n ")" ::: "memory")
#define PG8_BAR __builtin_amdgcn_s_barrier()
#define PG8_SCHED __builtin_amdgcn_sched_barrier(0)
    Unit cur, nxt; int ui = 0;
    if (!S.next(0, cur)) return;
    f32x4 acc[2][2][4][2];
#pragma unroll
    for (int a = 0; a < 2; ++a)
#pragma unroll
        for (int b = 0; b < 2; ++b)
#pragma unroll
            for (int m = 0; m < 4; ++m)
#pragma unroll
                for (int n = 0; n < 2; ++n) acc[a][b][m][n] = (f32x4){0.f, 0.f, 0.f, 0.f};
    bf16x8 At[4][2], B0[2][2], B1[2][2];
    const char* cA = (const char*)g.A + (size_t)cur.pm * tstepA; const char* cB = (const char*)g.Bt + (size_t)cur.pn * tstepB;
    S.a_ready(cur);
    if constexpr (SP2) {
        PG8_STAGE(PG8_SB(0, 0), cB, voffB); PG8_STAGE(PG8_SB(0, 1), cB + hstepB, voffB); PG8_STAGE(PG8_SA(0, 0), cA, voffA); PG8_STAGE(PG8_SA(0, 1), cA + hstepA, voffA);
        if (wr == 1) PG8_BAR;
        PG8_WAIT_V(2); PG8_BAR;
        PG8_STAGE(PG8_SB(1, 0), cB + kstep, voffB); PG8_STAGE(PG8_SA(1, 0), cA + kstep, voffA); PG8_STAGE(PG8_SB(1, 1), cB + hstepB + kstep, voffB);
        PG8_WAIT_V(6); PG8_BAR;
    } else {
        PG8_STAGE(PG8_SB(0, 0), cB, voffB); PG8_STAGE(PG8_SA(0, 0), cA, voffA); PG8_STAGE(PG8_SB(0, 1), cB + hstepB, voffB); PG8_STAGE(PG8_SA(0, 1), cA + hstepA, voffA);
        if (wr == 1) PG8_BAR;
        PG8_WAIT_V(4); PG8_BAR;
        PG8_STAGE(PG8_SB(1, 0), cB + kstep, voffB); PG8_STAGE(PG8_SA(1, 0), cA + kstep, voffA); PG8_STAGE(PG8_SB(1, 1), cB + hstepB + kstep, voffB);
        PG8_WAIT_V(6); PG8_BAR;
    }
    for (;;) {
        const bool has_next = S.next(ui + 1, nxt);
        const char* nA = has_next ? (const char*)g.A + (size_t)nxt.pm * tstepA : cA; const char* nB = has_next ? (const char*)g.Bt + (size_t)nxt.pn * tstepB : cB;
        for (int t = 0; t < nt; t += 2) {
            const bool last = (t == nt - 2);
            const char* a1 = cA + (size_t)(t + 1) * kstep;
            const char* a2 = last ? nA : cA + (size_t)(t + 2) * kstep; const char* b2 = last ? nB : cB + (size_t)(t + 2) * kstep;
            const char* a3 = a2 + kstep; const char* b3 = b2 + kstep;
            if (last && has_next) S.a_ready(nxt);
            if constexpr (SP2) {
            PG8_LDB(B0, 0, 0); PG8_LDB(B1, 0, 1); PG8_SCHED; PG8_LDA(At, 0, 0); PG8_STAGE(PG8_SA(1, 1), a1 + hstepA, voffA);
            PG8_WAIT_V(8); PG8_WAIT_L(0); PG8_BAR; PG8_MMA(0, 0, At, B0); PG8_MMA(0, 1, At, B1); PG8_BAR; PG8_SCHED;
            PG8_LDA(At, 0, 1); PG8_STAGE(PG8_SB(0, 0), b2, voffB); PG8_STAGE(PG8_SB(0, 1), b2 + hstepB, voffB); PG8_STAGE(PG8_SA(0, 0), a2, voffA);
            PG8_WAIT_V(8); PG8_WAIT_L(0); PG8_BAR; PG8_MMA(1, 0, At, B0); PG8_MMA(1, 1, At, B1); PG8_BAR; PG8_SCHED;
            PG8_LDB(B0, 1, 0); PG8_LDB(B1, 1, 1); PG8_SCHED; PG8_LDA(At, 1, 0); PG8_STAGE(PG8_SA(0, 1), a2 + hstepA, voffA);
            PG8_WAIT_V(8); PG8_WAIT_L(0); PG8_BAR; PG8_MMA(0, 0, At, B0); PG8_MMA(0, 1, At, B1); PG8_BAR; PG8_SCHED;
            PG8_LDA(At, 1, 1); PG8_STAGE(PG8_SB(1, 0), b3, voffB); PG8_STAGE(PG8_SB(1, 1), b3 + hstepB, voffB); PG8_STAGE(PG8_SA(1, 0), a3, voffA);
            PG8_WAIT_V(8); PG8_WAIT_L(0); PG8_BAR; PG8_MMA(1, 0, At, B0); PG8_MMA(1, 1, At, B1); PG8_BAR; PG8_SCHED;
            } else {
            PG8_LDB(B0, 0, 0); PG8_SCHED; PG8_LDA(At, 0, 0); PG8_STAGE(PG8_SA(1, 1), a1 + hstepA, voffA);
            PG8_WAIT_L(8); PG8_BAR; PG8_WAIT_L(0); PG8_MMA(0, 0, At, B0); PG8_BAR; PG8_SCHED;
            PG8_LDB(B1, 0, 1); PG8_STAGE(PG8_SB(0, 0), b2, voffB);
            PG8_BAR; PG8_WAIT_L(0); PG8_MMA(0, 1, At, B1); PG8_BAR;
            PG8_LDA(At, 0, 1); PG8_STAGE(PG8_SA(0, 0), a2, voffA);
            PG8_BAR; PG8_WAIT_L(0); PG8_MMA(1, 0, At, B0); PG8_BAR; PG8_SCHED;
            PG8_STAGE(PG8_SB(0, 1), b2 + hstepB, voffB);
            PG8_WAIT_V(6); PG8_BAR; PG8_MMA(1, 1, At, B1); PG8_BAR;
            PG8_LDB(B0, 1, 0); PG8_SCHED; PG8_LDA(At, 1, 0); PG8_STAGE(PG8_SA(0, 1), a2 + hstepA, voffA);
            PG8_WAIT_L(8); PG8_BAR; PG8_WAIT_L(0); PG8_MMA(0, 0, At, B0); PG8_BAR; PG8_SCHED;
            PG8_LDB(B1, 1, 1); PG8_STAGE(PG8_SB(1, 0), b3, voffB);
            PG8_BAR; PG8_WAIT_L(0); PG8_MMA(0, 1, At, B1); PG8_BAR;
            PG8_LDA(At, 1, 1); PG8_STAGE(PG8_SA(1, 0), a3, voffA);
            PG8_BAR; PG8_WAIT_L(0); PG8_MMA(1, 0, At, B0); PG8_BAR; PG8_SCHED;
            PG8_STAGE(PG8_SB(1, 1), b3 + hstepB, voffB);
            PG8_WAIT_V(6); PG8_BAR; PG8_MMA(1, 1, At, B1); PG8_BAR;
            }
        }
        if constexpr (ALIGN_EPI) { if (wr == 0) PG8_BAR; }
        if constexpr (!Epi::AFTER_DRAIN) { E(acc, cur, wr, wc, fr, fq); S.done(cur); }
        if (!has_next) break;
#pragma unroll
        for (int a = 0; a < 2; ++a)
#pragma unroll
            for (int b = 0; b < 2; ++b)
#pragma unroll
                for (int m = 0; m < 4; ++m)
#pragma unroll
                    for (int n = 0; n < 2; ++n) acc[a][b][m][n] = (f32x4){0.f, 0.f, 0.f, 0.f};
        cur = nxt; cA = nA; cB = nB; ++ui;
        if constexpr (ALIGN_EPI) { if (wr == 1) PG8_BAR; }
    }
    PG8_WAIT_V(0);
    if constexpr (!ALIGN_EPI) { if (wr == 0) PG8_BAR; }
    PG8_BAR;
    if constexpr (Epi::AFTER_DRAIN) { E.fused(acc, cur, wr, wc, fr, fq, lds, wid, lane); S.done(cur); }
#undef PG8_SA
#undef PG8_SB
#undef PG8_STAGE
#undef PG8_LDA
#undef PG8_LDB
#undef PG8_MMA
#undef PG8_WAIT_V
#undef PG8_WAIT_L
#undef PG8_BAR
#undef PG8_SCHED
}
}

#include <hip/hip_bf16.h>
namespace attn_body {
using bf16=__hip_bfloat16;
using bf16x8=__attribute__((ext_vector_type(8)))short;
using s16x4=__attribute__((ext_vector_type(4)))short;
using f32x16=__attribute__((ext_vector_type(16)))float;
using u32x4=__attribute__((ext_vector_type(4)))unsigned;
constexpr int BATCH=8,NHEAD=8,SEQ=2048,D=64,DM=NHEAD*D;
constexpr int NW=8,QBLK=32,QB=QBLK*NW,KVBLK=64,NQB=SEQ/QB;
constexpr int ATTN_PITCH=DM, ATTN_UNIT_ROWS=QB;
__device__ __forceinline__ int crow(int r,int hi){return (r&3)+8*(r>>2)+4*hi;}
#define SBAR() __builtin_amdgcn_sched_barrier(0)
__device__ __forceinline__ void cmask(f32x16&p0,f32x16&p1,int jb,int qrel,int hi){
  const float NEG=-INFINITY; int kb=64*jb+4*hi;
  #pragma unroll
  for(int r=0;r<16;++r){int kv=kb+(r&3)+8*(r>>2); if(kv>qrel)p0[r]=NEG; if(kv+32>qrel)p1[r]=NEG;}
}

constexpr int NSLOT=3, SLOTB=8192;
constexpr int LDS_K=0, LDS_V=NSLOT*SLOTB, LDS_WS=2*NSLOT*SLOTB, LDS_OST=LDS_WS+NW*64*4, LDS_BYTES=LDS_OST+NW*4096;
constexpr float C2=0.125f*1.4426950408889634f;
__device__ __forceinline__ void glds16(const void*gsrc,unsigned lds_dst){unsigned keep;
  asm volatile("s_mov_b32 %0, m0\n\ts_mov_b32 m0, %2\n\ts_nop 0\n\tglobal_load_lds_dwordx4 %1, off\n\ts_mov_b32 m0, %0":"=&s"(keep):"v"(gsrc),"s"(lds_dst):"memory");}
__device__ __forceinline__ float max3f(float a,float b,float c){float r;asm("v_max3_f32 %0, %1, %2, %3":"=v"(r):"v"(a),"v"(b),"v"(c));return r;}
__device__ __forceinline__ float max2f(float a,float b){float r;asm("v_max_f32_e32 %0, %1, %2":"=v"(r):"v"(a),"v"(b));return r;}
__device__ __forceinline__ float fadd_s(float a,float b){float r;asm("v_add_f32_e32 %0, %1, %2":"=v"(r):"v"(a),"v"(b));return r;}
__device__ __forceinline__ float fsub_s(float a,float b){float r;asm("v_sub_f32_e32 %0, %1, %2":"=v"(r):"v"(a),"v"(b));return r;}
typedef float f32x2_t __attribute__((ext_vector_type(2))); typedef __bf16 bf16x2_t __attribute__((ext_vector_type(2)));
__device__ __forceinline__ unsigned cvtpk_s(float lo,float hi){f32x2_t v={lo,hi};bf16x2_t b=__builtin_convertvector(v,bf16x2_t);return __builtin_bit_cast(unsigned,b);}
#define WAIT_BAR(N) asm volatile("s_waitcnt vmcnt(" #N ") lgkmcnt(0)\n\ts_barrier":::"memory")

__device__ __forceinline__ void qkt(f32x16&p0,f32x16&p1,const char*Kslot,const bf16x8*qr,const f32x16&negm,int r32,int hi){
  const char*kb=Kslot+hi*1024+r32*16;
  #pragma unroll
  for(int d0=0;d0<4;++d0){
    const bf16x8 b0=*reinterpret_cast<const bf16x8*>(kb+d0*2048);
    const bf16x8 b1=*reinterpret_cast<const bf16x8*>(kb+d0*2048+512);
    if(d0==0){p0=__builtin_amdgcn_mfma_f32_32x32x16_bf16(b0,qr[0],negm,0,0,0);p1=__builtin_amdgcn_mfma_f32_32x32x16_bf16(b1,qr[0],negm,0,0,0);}
    else{p0=__builtin_amdgcn_mfma_f32_32x32x16_bf16(b0,qr[d0],p0,0,0,0);p1=__builtin_amdgcn_mfma_f32_32x32x16_bf16(b1,qr[d0],p1,0,0,0);}}
}
typedef __attribute__((address_space(3))) const char* lds_cptr;
typedef short v4i16_t __attribute__((ext_vector_type(4)));
__device__ __forceinline__ void kload8(bf16x8*kf,lds_cptr kp){
  kf[0]=*(const __attribute__((address_space(3))) bf16x8*)(kp);      kf[1]=*(const __attribute__((address_space(3))) bf16x8*)(kp+512);
  kf[2]=*(const __attribute__((address_space(3))) bf16x8*)(kp+2048); kf[3]=*(const __attribute__((address_space(3))) bf16x8*)(kp+2560);
  kf[4]=*(const __attribute__((address_space(3))) bf16x8*)(kp+4096); kf[5]=*(const __attribute__((address_space(3))) bf16x8*)(kp+4608);
  kf[6]=*(const __attribute__((address_space(3))) bf16x8*)(kp+6144); kf[7]=*(const __attribute__((address_space(3))) bf16x8*)(kp+6656);
}
__device__ __forceinline__ void kload2(bf16x8*kf,lds_cptr kp,int j){ kf[2*j]=*(const __attribute__((address_space(3))) bf16x8*)(kp+j*2048); kf[2*j+1]=*(const __attribute__((address_space(3))) bf16x8*)(kp+j*2048+512); }
__device__ __forceinline__ s16x4 vtr(lds_cptr p){ return __builtin_bit_cast(s16x4,__builtin_amdgcn_ds_read_tr16_b64_v4i16((__attribute__((address_space(3))) v4i16_t*)p)); }
__device__ __forceinline__ float rowmax(const f32x16&p0,const f32x16&p1){
  float a=max3f(p0[0],p0[1],p1[0]),b=max3f(p0[2],p0[3],p1[1]);a=max3f(a,p1[2],p1[3]);
  #pragma unroll
  for(int r=4;r<16;r+=4){a=max3f(a,p0[r],p0[r+1]);b=max3f(b,p0[r+2],p0[r+3]);a=max3f(a,p1[r],p1[r+1]);b=max3f(b,p1[r+2],p1[r+3]);}
  const float m=max2f(a,b);
  auto rr=__builtin_amdgcn_permlane32_swap(__float_as_uint(m),__float_as_uint(m),false,false);
  return max2f(__uint_as_float(rr[0]),__uint_as_float(rr[1]));
}
__device__ __forceinline__ void pv(f32x16*o,int vb,bf16x8 pa0,bf16x8 pa1,bf16x8 pa2,bf16x8 pa3){
  #pragma unroll
  for(int d0=0;d0<2;++d0){s16x4 lo[4],hi[4];
    #pragma unroll
    for(int ks=0;ks<4;++ks){
      asm volatile("ds_read_b64_tr_b16 %0,%1 offset:%c2":"=&v"(lo[ks]):"v"(vb),"i"(d0*4096+ks*1024):"memory");
      asm volatile("ds_read_b64_tr_b16 %0,%1 offset:%c2":"=&v"(hi[ks]):"v"(vb),"i"(d0*4096+ks*1024+512):"memory");}
    asm volatile("s_waitcnt lgkmcnt(0)":::"memory");SBAR();
    #define PK(k) (bf16x8){lo[k][0],lo[k][1],lo[k][2],lo[k][3],hi[k][0],hi[k][1],hi[k][2],hi[k][3]}
    o[d0]=__builtin_amdgcn_mfma_f32_32x32x16_bf16(pa0,PK(0),o[d0],0,0,0);
    o[d0]=__builtin_amdgcn_mfma_f32_32x32x16_bf16(pa1,PK(1),o[d0],0,0,0);
    o[d0]=__builtin_amdgcn_mfma_f32_32x32x16_bf16(pa2,PK(2),o[d0],0,0,0);
    o[d0]=__builtin_amdgcn_mfma_f32_32x32x16_bf16(pa3,PK(3),o[d0],0,0,0);
    #undef PK
  }
}

#ifndef ATTN_STORE16
#define ATTN_STORE16(p,v) (*(u32x4*)(p)=(v))
#endif
template<int THRL> __device__ __forceinline__ void attn_unit(int b,int h,int qb,const bf16*Q,const bf16*__restrict__ K,const bf16*__restrict__ V,bf16*O,int opitch,const float*__restrict__ KS,char*shm,const int wid){
  int lane_=__builtin_amdgcn_mbcnt_hi(~0u,__builtin_amdgcn_mbcnt_lo(~0u,0u)); asm volatile("":"+v"(lane_)); const int lane=lane_,r32=lane&31,hi=lane>>5;
  const long rowbase=(long)b*SEQ; const int q0=qb*QB;
  const bf16*Qw=Q+(rowbase+q0+wid*QBLK)*DM+h*D;
  const bf16*Kh=K+rowbase*DM+h*D,*Vh=V+rowbase*DM+h*D;
  const unsigned lds0=(unsigned)(uintptr_t)shm;
  float*wsf=(float*)(shm+LDS_WS)+wid*64;
  const bf16*ksrc=Kh+(long)lane*DM+wid*8;
  const bf16*vsrc=Vh+(long)(16*(wid&3)+(lane>>2))*DM+(wid>>2)*32+(lane&3)*8;
  const unsigned kdst=lds0+LDS_K+wid*1024, vdst=lds0+LDS_V+wid*1024;
  #define DMA_K(t,slot) glds16(ksrc+(long)(t)*KVBLK*DM,(unsigned)__builtin_amdgcn_readfirstlane(kdst+(slot)))
  #define DMA_V(t,slot) glds16(vsrc+(long)(t)*KVBLK*DM,(unsigned)__builtin_amdgcn_readfirstlane(vdst+(slot)))
  const int vb0=(int)(lds0+LDS_V)+((lane>>4)&1)*32+(lane&3)*8+(4*hi+((lane&15)>>2))*64;
  const char*Kbase=shm+LDS_K; bf16x8 kf[8];
  const lds_cptr shm3=(lds_cptr)shm; const lds_cptr kp0=shm3+LDS_K+hi*1024+r32*16; const lds_cptr vp0=shm3+LDS_V+((lane>>4)&1)*32+(lane&3)*8+(4*hi+((lane&15)>>2))*64;
  const int NT=(q0+QB)/KVBLK;
  DMA_K(0,0);DMA_V(0,0);DMA_K(1,SLOTB);
  bf16x8 qr[4];
  #pragma unroll
  for(int d0=0;d0<4;++d0)qr[d0]=*reinterpret_cast<const bf16x8*>(&Qw[(long)r32*DM+d0*16+hi*8]);
  unsigned selmask=(1u<<qb)-1u;
  if(qb>3){
    float sc[7];
    #pragma unroll
    for(int n=0;n<7;++n){ sc[n]=-INFINITY;
      if(n<qb){ const float*kp=KS+((long)(b*8+n)*DM+h*D+hi*8); float a=0.f;
        #pragma unroll
        for(int d0=0;d0<4;++d0){ const float4 k0=*reinterpret_cast<const float4*>(kp+d0*16),k1=*reinterpret_cast<const float4*>(kp+d0*16+4);
          #define QF(j) __uint_as_float(((unsigned)(unsigned short)qr[d0][j])<<16)
          a+=QF(0)*k0.x+QF(1)*k0.y+QF(2)*k0.z+QF(3)*k0.w+QF(4)*k1.x+QF(5)*k1.y+QF(6)*k1.z+QF(7)*k1.w;
          #undef QF
        }
        { auto rr=__builtin_amdgcn_permlane32_swap(__float_as_uint(a),__float_as_uint(a),false,false); a=__uint_as_float(rr[0])+__uint_as_float(rr[1]); } sc[n]=a; }
      asm volatile("":::"memory"); }
    selmask=0u;
    #pragma unroll
    for(int n=0;n<7;++n){ int rk=0;
      #pragma unroll
      for(int m2=0;m2<7;++m2){ if(m2!=n) rk+=(sc[m2]>sc[n]||(sc[m2]==sc[n]&&m2<n))?1:0; }
      if(n<qb&&rk<3)selmask|=(1u<<n); }
  }
  float mhat=0.f,l_reg=0.f;f32x16 o[2];o[0]=f32x16{};o[1]=f32x16{};const f32x16 negm=f32x16{};
  const int qrel=wid*QBLK+r32;
  #define CMASK(P0,P1,t) do{const int t_=(t); const int jb_=t_-(NT-4); if(jb_>=0)cmask(P0,P1,jb_,qrel,hi); else if(!((selmask>>(t_>>2))&1u)){ _Pragma("unroll") for(int r_=0;r_<16;++r_){P0[r_]=-INFINITY;P1[r_]=-INFINITY;} } }while(0)
  bool resc=false;
  #define START(P0,P1) do{ const float rm=rowmax(P0,P1); resc=false; \
    { const float dl=__builtin_fmaxf(rm,-100.f); mhat=fadd_s(mhat,dl); \
      _Pragma("unroll") for(int r=0;r<16;++r){P0[r]=fsub_s(P0[r],dl);P1[r]=fsub_s(P1[r],dl);} \
      } \
    _Pragma("unroll") for(int r=0;r<16;++r)P0[r]=__builtin_amdgcn_exp2f(P0[r]); }while(0)
  #define RESC() do{ if(resc){ asm volatile("s_waitcnt lgkmcnt(0)":::"memory"); \
      _Pragma("unroll") for(int d_=0;d_<2;++d_) _Pragma("unroll") for(int r=0;r<16;++r)o[d_][r]*=wsf[crow(r,hi)]; } }while(0)
  f32x16 pA0,pA1,pB0,pB1;
  int sl_prev=0,sl_cur=0,sl_next=SLOTB;
  #define ROT() do{sl_prev=sl_cur;sl_cur=sl_next;sl_next=(sl_next==(NSLOT-1)*SLOTB)?0:sl_next+SLOTB;}while(0)
  DMA_K(2,2*SLOTB);
  WAIT_BAR(3);
  qkt(pA0,pA1,Kbase,qr,negm,r32,hi);asm volatile("s_nop 15\n\ts_nop 7":"+v"(pA0),"+v"(pA1));CMASK(pA0,pA1,0);
  START(pA0,pA1);
  _Pragma("unroll") for(int r=0;r<16;++r)pA1[r]=__builtin_amdgcn_exp2f(pA1[r]);
  WAIT_BAR(0);
  DMA_K(3,0);DMA_V(1,SLOTB);
  ROT();
  kload8(kf,kp0+sl_cur);
  WAIT_BAR(2);
  s16x4 vlo[8],vhi[8]; u32x4 pw0,pw1,pw2,pw3;
  #define PKW(P,B) cvtpk_s(P[B],P[B+1])
  #define PAF(k) __builtin_bit_cast(bf16x8,pw##k)
  #define VFR(i) (bf16x8){vlo[i][0],vlo[i][1],vlo[i][2],vlo[i][3],vhi[i][0],vhi[i][1],vhi[i][2],vhi[i][3]}
  #define PIN(x) asm volatile("":"+v"(x))
  #define MX3(a,b,c) __builtin_fmaxf(__builtin_fmaxf((a),(b)),(c))
  #define GAPA(MF,A0,A1,A2,A3,W0,W1,PW) do{ MF; sacc+=A0; sacc+=A1; sacc+=A2; sacc+=A3; PIN(sacc); W0; W1; PIN(PW); SBAR(); }while(0)
  #define EX(v) __builtin_amdgcn_exp2f(v)
  #define GAPB(MF,X,B) do{ MF; X[B]=EX(X[B]); X[B+1]=EX(X[B+1]); X[B+2]=EX(X[B+2]); X[B+3]=EX(X[B+3]); PIN(X); SBAR(); }while(0)
  #define VRD(i) do{ vlo[i]=vtr(vp_+(((i)>>2)*4096+((i)&3)*1024)); vhi[i]=vtr(vp_+(((i)>>2)*4096+((i)&3)*1024+512)); }while(0)
  #define KRD(G,j) do{ if(G){ kload2(kf,kp0+sl_next,j); SBAR(); } }while(0)
  #define STEP(C0,C1,P0,P1,t,GK,GV,GL) do{ SBAR(); \
    const lds_cptr vp_=vp0+sl_prev; \
    VRD(0); SBAR(); float sacc=(P0[0]+P0[1]); \
    GAPA(C0=__builtin_amdgcn_mfma_f32_32x32x16_bf16(kf[0],qr[0],negm,0,0,0), P0[2],P0[3],P0[4],P0[5],     pw0[0]=PKW(P0,0), pw0[1]=PKW(P0,2), pw0); \
    VRD(4); SBAR(); GAPA(C1=__builtin_amdgcn_mfma_f32_32x32x16_bf16(kf[1],qr[0],negm,0,0,0), P0[6],P0[7],P0[8],P0[9],     pw0[2]=PKW(P0,4), pw0[3]=PKW(P0,6), pw0); \
    VRD(1); SBAR(); GAPA(C0=__builtin_amdgcn_mfma_f32_32x32x16_bf16(kf[2],qr[1],C0,0,0,0),   P0[10],P0[11],P0[12],P0[13], pw1[0]=PKW(P0,8), pw1[1]=PKW(P0,10), pw1); \
    VRD(5); SBAR(); GAPA(C1=__builtin_amdgcn_mfma_f32_32x32x16_bf16(kf[3],qr[1],C1,0,0,0),   P0[14],P0[15],P1[0],P1[1],   pw1[2]=PKW(P0,12),pw1[3]=PKW(P0,14), pw1); \
    VRD(2); SBAR(); GAPA(C0=__builtin_amdgcn_mfma_f32_32x32x16_bf16(kf[4],qr[2],C0,0,0,0),   P1[2],P1[3],P1[4],P1[5],     pw2[0]=PKW(P1,0), pw2[1]=PKW(P1,2), pw2); \
    VRD(6); SBAR(); GAPA(C1=__builtin_amdgcn_mfma_f32_32x32x16_bf16(kf[5],qr[2],C1,0,0,0),   P1[6],P1[7],P1[8],P1[9],     pw2[2]=PKW(P1,4), pw2[3]=PKW(P1,6), pw2); \
    VRD(3); SBAR(); GAPA(C0=__builtin_amdgcn_mfma_f32_32x32x16_bf16(kf[6],qr[3],C0,0,0,0),   P1[10],P1[11],P1[12],P1[13], pw3[0]=PKW(P1,8), pw3[1]=PKW(P1,10), pw3); \
    VRD(7); SBAR(); GAPA(C1=__builtin_amdgcn_mfma_f32_32x32x16_bf16(kf[7],qr[3],C1,0,0,0),   P1[14],P1[15],0.f,0.f,       pw3[2]=PKW(P1,12),pw3[3]=PKW(P1,14), pw3); \
    l_reg+=sacc; \
    if(GK){DMA_K((t)+3,sl_cur);} if(GV){DMA_V((t)+1,sl_next);} \
    _Pragma("unroll") for(int r=0;r<16;++r){C0[r]-=mhat;C1[r]-=mhat;} \
    CMASK(C0,C1,t); \
    { float a=MX3(C0[0],C0[1],C1[0]),b=MX3(C0[2],C0[3],C1[1]); a=MX3(a,C1[2],C1[3]); \
      _Pragma("unroll") for(int r=4;r<16;r+=4){a=MX3(a,C0[r],C0[r+1]);b=MX3(b,C0[r+2],C0[r+3]);a=MX3(a,C1[r],C1[r+1]);b=MX3(b,C1[r+2],C1[r+3]);} \
      float rm=__builtin_fmaxf(a,b); { auto rr=__builtin_amdgcn_permlane32_swap(__float_as_uint(rm),__float_as_uint(rm),false,false); rm=__builtin_fmaxf(__uint_as_float(rr[0]),__uint_as_float(rr[1])); } \
      resc=false; \
      if(__builtin_expect(__any(rm>(float)THRL),0)){ const float dl=__builtin_fmaxf(rm,0.f); mhat+=dl; \
        _Pragma("unroll") for(int r=0;r<16;++r){C0[r]-=dl;C1[r]-=dl;} \
        const float f=__builtin_amdgcn_exp2f(-dl); l_reg*=f; if(hi==0)wsf[r32]=f; resc=true; } } \
    SBAR(); \
    GAPB(o[0]=__builtin_amdgcn_mfma_f32_32x32x16_bf16(PAF(0),VFR(0),o[0],0,0,0), C0,0); \
    GAPB(o[1]=__builtin_amdgcn_mfma_f32_32x32x16_bf16(PAF(0),VFR(4),o[1],0,0,0), C0,4); \
    KRD(GL,0); GAPB(o[0]=__builtin_amdgcn_mfma_f32_32x32x16_bf16(PAF(1),VFR(1),o[0],0,0,0), C0,8); \
    KRD(GL,1); GAPB(o[1]=__builtin_amdgcn_mfma_f32_32x32x16_bf16(PAF(1),VFR(5),o[1],0,0,0), C0,12); \
    KRD(GL,2); GAPB(o[0]=__builtin_amdgcn_mfma_f32_32x32x16_bf16(PAF(2),VFR(2),o[0],0,0,0), C1,0); \
    KRD(GL,3); GAPB(o[1]=__builtin_amdgcn_mfma_f32_32x32x16_bf16(PAF(2),VFR(6),o[1],0,0,0), C1,4); \
    GAPB(o[0]=__builtin_amdgcn_mfma_f32_32x32x16_bf16(PAF(3),VFR(3),o[0],0,0,0), C1,8); \
    GAPB(o[1]=__builtin_amdgcn_mfma_f32_32x32x16_bf16(PAF(3),VFR(7),o[1],0,0,0), C1,12); \
    }while(0)
  int t=1;
  #undef CMASK
  #define CMASK(P0,P1,t) do{ if(!((selmask>>((t)>>2))&1u)){ _Pragma("unroll") for(int r_=0;r_<16;++r_){P0[r_]=-INFINITY;P1[r_]=-INFINITY;} } }while(0)
  for(;t+5<NT;t+=2){
    STEP(pB0,pB1,pA0,pA1,t,true,true,true);     WAIT_BAR(2); RESC(); ROT();
    STEP(pA0,pA1,pB0,pB1,t+1,true,true,true);   WAIT_BAR(2); RESC(); ROT();
  }
  #undef CMASK
  int qrel2=qrel,hi2=hi; asm volatile("":"+v"(qrel2),"+v"(hi2));
  #define CMASK(P0,P1,t) do{const int t_=(t); const int jb_=t_-(NT-4); if(jb_>=0)cmask(P0,P1,jb_,qrel2,hi2); else if(!((selmask>>(t_>>2))&1u)){ _Pragma("unroll") for(int r_=0;r_<16;++r_){P0[r_]=-INFINITY;P1[r_]=-INFINITY;} } }while(0)
  #define ENDW(tt) do{ if((tt)+3<NT){WAIT_BAR(2);} else if((tt)+2<NT){WAIT_BAR(1);} else {WAIT_BAR(0);} }while(0)
  for(;t+1<NT;t+=2){
    STEP(pB0,pB1,pA0,pA1,t,(t+3<NT),(t+1<NT),(t+1<NT));       ENDW(t);   RESC(); ROT();
    STEP(pA0,pA1,pB0,pB1,t+1,(t+4<NT),(t+2<NT),(t+2<NT));     ENDW(t+1); RESC(); ROT();
  }
  STEP(pB0,pB1,pA0,pA1,NT-1,false,false,false); RESC();
  { float sacc=pB0[0]+pB0[1]; _Pragma("unroll") for(int r=2;r<16;++r)sacc+=pB0[r]; _Pragma("unroll") for(int r=0;r<16;++r)sacc+=pB1[r]; l_reg+=sacc;
    pw0=(u32x4){PKW(pB0,0),PKW(pB0,2),PKW(pB0,4),PKW(pB0,6)};pw1=(u32x4){PKW(pB0,8),PKW(pB0,10),PKW(pB0,12),PKW(pB0,14)};pw2=(u32x4){PKW(pB1,0),PKW(pB1,2),PKW(pB1,4),PKW(pB1,6)};pw3=(u32x4){PKW(pB1,8),PKW(pB1,10),PKW(pB1,12),PKW(pB1,14)};
    SBAR(); pv(o,vb0+sl_cur,PAF(0),PAF(1),PAF(2),PAF(3)); }
  #undef PKW
  #undef PAF
  #undef VFR
  #undef PIN
  #undef MX3
  #undef GAPA
  #undef GAPB
  #undef EX
  #undef VRD
  #undef KRD
  #undef STEP
  #undef ENDW
  {auto rr=__builtin_amdgcn_permlane32_swap(__float_as_uint(l_reg),__float_as_uint(l_reg),false,false);l_reg=__uint_as_float(rr[0])+__uint_as_float(rr[1]);}
  if(hi==0)wsf[32+r32]=l_reg;asm volatile("s_waitcnt lgkmcnt(0)":::"memory");
  float rli[16];
  #pragma unroll
  for(int r=0;r<16;++r)rli[r]=__builtin_amdgcn_rcpf(wsf[32+crow(r,hi)]);
  bf16*Ow=O+(rowbase+q0+wid*QBLK)*(long)opitch+h*D;
  { bf16*stg=(bf16*)(shm+LDS_OST)+wid*2048;
    #pragma unroll
    for(int r=0;r<16;++r){const int orow=crow(r,hi);
      #pragma unroll
      for(int d0=0;d0<2;++d0)stg[orow*64+d0*32+r32]=__float2bfloat16(o[d0][r]*rli[r]);}
    asm volatile("s_waitcnt lgkmcnt(0)":::"memory");
    #pragma unroll
    for(int i=0;i<4;++i){const int row=i*8+(lane>>3),ch=lane&7; const u32x4 v=*(const u32x4*)(stg+row*64+ch*8); ATTN_STORE16(Ow+(long)row*opitch+ch*8,v);} }
  asm volatile("s_waitcnt lgkmcnt(0)\n\ts_barrier":::"memory");
  #undef DMA_K
  #undef DMA_V
  #undef CMASK
  #undef START
  #undef RESC
  #undef ROT
}
constexpr int ATTN_LDS_BYTES=LDS_BYTES;
struct AttnTensors { const bf16* Q; const bf16* K; const bf16* V; bf16* O; int opitch; const float* KS; };
#undef SBAR
#undef WAIT_BAR
}
constexpr int NWAVES = 8;
#ifndef MK_N_LAUNCHES
#define MK_N_LAUNCHES 1
#endif
constexpr int N_LAUNCHES = MK_N_LAUNCHES;
constexpr int PER_PHASE = 10;

constexpr int D = 1024, NBATCH = 8, SEQ = 2048, MP = NBATCH * SEQ, NS = 128, MALL = MP + 256, NPAN = MALL / 256;
constexpr int MEMR = 2048, XNROWS = MALL + MEMR;
constexpr int FF = 4096, PW = 512, AW = 512, NH = 8, HD = 64, PST = 15, NPAGES = 16, PAGE = 128;
constexpr float EPS = 1e-6f;
constexpr float CROSS_C2 = 0.0625f * 1.4426950408889634f;
constexpr size_t O_YP = 0, O_YS = O_YP + (size_t)MP * D, O_KP = O_YS + (size_t)NS * D, O_VP = O_KP + (size_t)MP * AW, O_POOLP = O_VP + (size_t)MP * AW,
                 O_MK = O_POOLP + (size_t)NBATCH * PST * PW, O_MV = O_MK + (size_t)MEMR * D, O_KS = O_MV + (size_t)MEMR * D, O_VS = O_KS + (size_t)NS * AW, O_POOLS = O_VS + (size_t)NS * AW,
                 O_END = O_POOLS + (size_t)NS * PST * PW;
static_assert(O_END == 39055360, "output size");

constexpr size_t MiB = 1u << 20;
constexpr size_t WS_CTL = 0, CTL_ZERO_BYTES = 1 * MiB;
constexpr size_t WS_WIN = 2 * MiB;
constexpr size_t WS_WOUT = 10 * MiB, WS_WCQ = 12 * MiB, WS_WCO = 14 * MiB;
constexpr size_t WS_WUP = 16 * MiB;
constexpr size_t WS_WDN = 24 * MiB;
constexpr size_t WS_WPOOL = 32 * MiB;
constexpr size_t WS_ROPE = 33 * MiB;
constexpr size_t WS_SACC = 516 * MiB;
constexpr size_t SA_PS = 0, SA_A1 = 1 * MiB, SA_AQ = SA_A1 + 512 * 1024, SA_A3 = SA_AQ + 512 * 1024, SA_AD = SA_A3 + 512 * 1024, SACC_BYTES = 3 * MiB;
constexpr size_t WS_HBS = 351 * MiB;
constexpr size_t WS_XN = 36 * MiB;
constexpr size_t WS_U = 74 * MiB, WS_Q = 91 * MiB, WS_K = 108 * MiB, WS_V = 125 * MiB;
constexpr size_t WS_MIX = 142 * MiB;
constexpr size_t WS_X1 = 176 * MiB;
constexpr size_t WS_XG = 242 * MiB;
constexpr size_t WS_QC = 276 * MiB;
constexpr size_t WS_OC = 310 * MiB;
constexpr size_t WS_MKB = 343 * MiB;
constexpr size_t WS_MVT = 347 * MiB;
constexpr size_t WS_PB = 352 * MiB;
constexpr size_t WS_HB = 384 * MiB;
constexpr size_t WS_END = 520 * MiB;
static_assert(WS_XN + (size_t)XNROWS * D * 2 <= WS_U && WS_V + (size_t)MALL * 512 * 2 <= WS_MIX && WS_MIX + (size_t)MALL * D * 2 <= WS_X1 && WS_X1 + (size_t)MALL * D * 4 <= WS_XG &&
              WS_XG + (size_t)MALL * D * 2 <= WS_QC && WS_QC + (size_t)MALL * D * 2 <= WS_OC && WS_OC + (size_t)MALL * D * 2 <= WS_MKB && WS_MKB + 4 * MiB <= WS_MVT && WS_MVT + 4 * MiB <= WS_HBS && WS_HBS + MiB <= WS_PB && WS_HB + (size_t)MALL * FF * 2 <= WS_SACC && WS_SACC + SACC_BYTES <= WS_END, "d_ws map");
constexpr int CW_TMO = 0, CW_CODE = 1;
constexpr int CW_Q2 = 256, CW_Q5 = 512;
constexpr int CW_BAR = 4096;
constexpr int CW_KSUM = 16384;
constexpr int CW_SS1 = 49152, CW_SS2 = CW_SS1 + 16896, CW_SS3 = CW_SS2 + 16896;
static_assert((CW_SS3 + 16896) * 4 <= (int)CTL_ZERO_BYTES && CW_KSUM + 8 * 8 * 512 <= CW_SS1, "CTL words inside the memset region");

constexpr int RING_OFF = 0, RING_BYTES = 131072;
constexpr int LDSCTL_OFF = RING_BYTES, MISC_OFF = LDSCTL_OFF + 320;
constexpr int LDS_BYTES = 147456;
static_assert(MISC_OFF + 128 <= LDS_BYTES, "LDS map");

#define GAS __attribute__((address_space(1)))
#define LAS __attribute__((address_space(3)))
typedef unsigned short bf16;
typedef unsigned v4u __attribute__((ext_vector_type(4)));
typedef unsigned v2u __attribute__((ext_vector_type(2)));
typedef float f32x4 __attribute__((ext_vector_type(4)));
typedef short bf16x8 __attribute__((ext_vector_type(8)));
typedef GAS unsigned gu32;
typedef GAS unsigned long long gu64;
#define RLX_AGENT __ATOMIC_RELAXED, __HIP_MEMORY_SCOPE_AGENT
#define LDS_WAIT() asm volatile("s_waitcnt lgkmcnt(0)" ::: "memory")
#define VM_WAIT() asm volatile("s_waitcnt vmcnt(0)" ::: "memory")
__device__ __forceinline__ unsigned f2bf(float f) { unsigned u = __builtin_bit_cast(unsigned, f); return (u + 0x7fffu + ((u >> 16) & 1u)) >> 16; }
__device__ __forceinline__ unsigned pk2(float lo, float hi) { return f2bf(lo) | (f2bf(hi) << 16); }
__device__ __forceinline__ float bf2f(unsigned short b) { return __uint_as_float(((unsigned)b) << 16); }

#define XB_TMO      128
#define XB_XCNT(j)  (256  + 64 * (j))
#define XB_XSUB(j)  (1280 + 64 * (j))
#define XB_XGEN(j)  (2304 + 64 * (j))
#define XB_TOP      3328
#define XB_TOPGEN   3392
#define XCD_BAR_WORDS 3456
#define XB_SPIN_CAP (1u << 18)

__device__ __forceinline__ unsigned xb_ld(unsigned* p)              { return __hip_atomic_load(p, __ATOMIC_RELAXED, __HIP_MEMORY_SCOPE_AGENT); }
__device__ __forceinline__ unsigned xb_add(unsigned* p, unsigned v) { return __hip_atomic_fetch_add(p, v, __ATOMIC_RELAXED, __HIP_MEMORY_SCOPE_AGENT); }
__device__ __forceinline__ unsigned xb_xcc_id() { return (unsigned)__builtin_amdgcn_s_getreg((3 << 11) | 20) & 0xFu; }
#define XB_SPIN(cond, bar) do { unsigned _sp = 0; while (cond) { __builtin_amdgcn_s_sleep(1); \
    if ((++_sp & 255u) == 0u) { if (xb_ld(&(bar)[XB_TMO])) break; if (_sp > XB_SPIN_CAP) { atomicAdd(&(bar)[XB_TMO], 1u); break; } } } } while (0)

struct XcdBarrier {
    unsigned* bar; unsigned x;
    int wave;
    volatile LAS unsigned* st;
};

__device__ __forceinline__ bool xb_thread0(int wave) { return wave == 0 && __builtin_amdgcn_mbcnt_hi(~0u, __builtin_amdgcn_mbcnt_lo(~0u, 0u)) == 0u; }
__device__ __forceinline__ XcdBarrier xcd_barrier_post(unsigned* bar, volatile LAS unsigned* st, int wave) {
    XcdBarrier b; b.bar = bar; b.x = xb_xcc_id(); b.st = st; b.wave = wave;
    if (xb_thread0(wave)) (void)xb_add(&bar[XB_XCNT(b.x)], 1u);
    return b;
}
__device__ __forceinline__ void xcd_barrier_complete(unsigned* bar, unsigned x, unsigned& nloc, unsigned& nx) {
    const unsigned G = gridDim.x * gridDim.y * gridDim.z;
    unsigned sum, cnt, mine, sp = 0u;
    for (;;) {
        sum = 0u; cnt = 0u; mine = 0u;
#pragma unroll
        for (unsigned j = 0; j < 16; ++j) { const unsigned c = xb_ld(&bar[XB_XCNT(j)]); sum += c; cnt += (c > 0u) ? 1u : 0u; mine = (j == x) ? c : mine; }
        if (sum == G) break;
        __builtin_amdgcn_s_sleep(1);
        if ((++sp & 255u) == 0u) { if (xb_ld(&bar[XB_TMO])) break; if (sp > XB_SPIN_CAP) { atomicAdd(&bar[XB_TMO], 1u); break; } }
    }
    nloc = mine > 0u ? mine : 1u; nx = cnt > 0u ? cnt : 1u;
}

__device__ __forceinline__ void xcd_barrier(const XcdBarrier& b) {
    asm volatile("s_waitcnt vmcnt(0)" ::: "memory");
    __syncthreads();
    if (xb_thread0(b.wave)) {
        unsigned* bar = b.bar;
        __builtin_amdgcn_s_waitcnt(0);
        unsigned nloc = b.st[0], nx = b.st[1];
        if (nloc == 0u) { xcd_barrier_complete(bar, b.x, nloc, nx); b.st[0] = nloc; b.st[1] = nx; }
        const unsigned old = xb_add(&bar[XB_XSUB(b.x)], 1u);
        const unsigned gen = old / nloc;
        if (old + 1u == (gen + 1u) * nloc) {
            __builtin_amdgcn_fence(__ATOMIC_RELEASE, "agent");
            asm volatile("s_waitcnt vmcnt(0)" ::: "memory");
            const unsigned og = xb_add(&bar[XB_TOP], 1u);
            const unsigned tg = og / nx;
            if (og + 1u == (tg + 1u) * nx) xb_add(&bar[XB_TOPGEN], 1u);
            else XB_SPIN(xb_ld(&bar[XB_TOPGEN]) == tg, bar);
            __builtin_amdgcn_fence(__ATOMIC_ACQUIRE, "agent");
            xb_add(&bar[XB_XGEN(b.x)], 1u);
            asm volatile("s_waitcnt vmcnt(0)" ::: "memory");
        } else {
            XB_SPIN(xb_ld(&bar[XB_XGEN(b.x)]) == gen, bar);
            __builtin_amdgcn_fence(__ATOMIC_ACQUIRE, "agent");
            asm volatile("s_waitcnt vmcnt(0)" ::: "memory");
        }
    }
    __syncthreads();
}


struct Args { const void* in[24]; float* out; unsigned char* ws; int ph_lo, ph_hi; };
struct Frame {
    LAS unsigned char* lds;
    volatile LAS unsigned* MISC;
    gu32* ctl;
    int wave;
    int vcu, G;
    float* out;
    unsigned char* ws;
};
#define WSP(T, off) ((T*)(F.ws + (off)))
__device__ __forceinline__ int LANE() { return (int)__builtin_amdgcn_mbcnt_hi(~0u, __builtin_amdgcn_mbcnt_lo(~0u, 0u)); }
#define TID(F) ((F).wave * 64 + LANE())

__device__ __forceinline__ float xshfl(float v, int m, int lane) { return __builtin_bit_cast(float, __builtin_amdgcn_ds_bpermute((lane ^ m) << 2, __builtin_bit_cast(int, v))); }
__device__ __forceinline__ float wave_sum(float v, int lane) {
#pragma unroll
    for (int o = 1; o < 64; o <<= 1) v += xshfl(v, o, lane);
    return v;
}
__device__ __forceinline__ float wave_max(float v, int lane) {
#pragma unroll
    for (int o = 1; o < 64; o <<= 1) v = __builtin_fmaxf(v, xshfl(v, o, lane));
    return v;
}
__device__ __forceinline__ int win_dst_row(int n) { if (n < 512 || n >= 1536) return n; const int t = n & ~255, j = n & 255, hh = j >> 6, p = (j >> 5) & 1, i = j & 31; return t + 128 * p + 32 * hh + i; }
template <bool WINPERM> __device__ __forceinline__ void p0_transpose_item(const float* W, int K, int N, bf16* WT, int row_off, LAS float* scr, int item, int lane) {
    const int nblk = N / 32, kb = item / nblk, nb = item % nblk, k0 = 64 * kb, n0 = 32 * nb;
#pragma unroll 8
    for (int i = 0; i < 32; ++i) { const int kk = 2 * i + (lane >> 5); scr[kk * 33 + (lane & 31)] = W[(size_t)(k0 + kk) * N + n0 + (lane & 31)]; }
    LDS_WAIT(); asm volatile("" ::: "memory");
    const int c = lane & 7;
#pragma unroll
    for (int j = 0; j < 4; ++j) { const int n = (lane >> 3) + 8 * j; const LAS float* s = scr + (8 * c) * 33 + n;
        v4u o; o.x = pk2(s[0 * 33], s[1 * 33]); o.y = pk2(s[2 * 33], s[3 * 33]); o.z = pk2(s[4 * 33], s[5 * 33]); o.w = pk2(s[6 * 33], s[7 * 33]);
        const int drow = WINPERM ? win_dst_row(n0 + n) : (n0 + n);
        *(GAS v4u*)(WT + (size_t)(row_off + drow) * K + k0 + 8 * c) = o; }
    LDS_WAIT(); asm volatile("" ::: "memory");
}
__device__ __forceinline__ void rms_row_to_bf16(int lane, const float* xrow, const float* gain, bf16* orow) {
    const GAS f32x4* xr = (const GAS f32x4*)xrow + lane; const GAS f32x4* gr = (const GAS f32x4*)gain + lane;
    f32x4 v[4]; float s = 0.f;
#pragma unroll
    for (int j = 0; j < 4; ++j) { v[j] = xr[64 * j]; s += (v[j].x * v[j].x + v[j].y * v[j].y) + (v[j].z * v[j].z + v[j].w * v[j].w); }
    const float rstd = 1.f / sqrtf(wave_sum(s, lane) * (1.f / D) + EPS);
    GAS unsigned long long* o8 = (GAS unsigned long long*)orow + lane;
#pragma unroll
    for (int j = 0; j < 4; ++j) { const f32x4 g = gr[64 * j]; o8[64 * j] = (unsigned long long)pk2(v[j].x * rstd * g.x, v[j].y * rstd * g.y) | ((unsigned long long)pk2(v[j].z * rstd * g.z, v[j].w * rstd * g.w) << 32); }
}
__device__ __forceinline__ void p0_prologue(Frame& F, const Args& A) {
    LAS float* scr = (LAS float*)(F.lds + RING_OFF + F.wave * 16384);
    const int gw = F.vcu * NWAVES + F.wave, NGW = F.G * NWAVES;
    bf16* WIN = WSP(bf16, WS_WIN);
    constexpr int I_IN = (D / 64) * (2048 / 32), I_SQ = (D / 64) * (D / 32), I_UP = (D / 64) * (FF / 32), I_DN = (FF / 64) * (D / 32), I_PL = (128 / 64) * (128 / 32);
    constexpr int NITEMS = I_IN + 5 * I_SQ + I_UP + I_DN + 4 * I_PL;
    for (int it = gw; it < NITEMS; it += NGW) {
        int r = it;
        if (r < I_IN) { p0_transpose_item<true>(((const float*)A.in[10]), D, 2048, WIN, 0, scr, r, LANE()); continue; } r -= I_IN;
        if (r < I_SQ) { p0_transpose_item<false>(((const float*)A.in[17]), D, D, WIN, 2048, scr, r, LANE()); continue; } r -= I_SQ;
        if (r < I_SQ) { p0_transpose_item<false>(((const float*)A.in[18]), D, D, WIN, 3072, scr, r, LANE()); continue; } r -= I_SQ;
        if (r < I_SQ) { p0_transpose_item<false>(((const float*)A.in[13]), D, D, WSP(bf16, WS_WOUT), 0, scr, r, LANE()); continue; } r -= I_SQ;
        if (r < I_SQ) { p0_transpose_item<false>(((const float*)A.in[16]), D, D, WSP(bf16, WS_WCQ), 0, scr, r, LANE()); continue; } r -= I_SQ;
        if (r < I_SQ) { p0_transpose_item<false>(((const float*)A.in[19]), D, D, WSP(bf16, WS_WCO), 0, scr, r, LANE()); continue; } r -= I_SQ;
        if (r < I_UP) { p0_transpose_item<false>(((const float*)A.in[21]), D, FF, WSP(bf16, WS_WUP), 0, scr, r, LANE()); continue; } r -= I_UP;
        if (r < I_DN) { p0_transpose_item<false>(((const float*)A.in[22]), FF, D, WSP(bf16, WS_WDN), 0, scr, r, LANE()); continue; } r -= I_DN;
        { const int g = r / I_PL; p0_transpose_item<false>(((const float*)A.in[11]) + (size_t)g * 128 * 128, 128, 128, WSP(bf16, WS_WPOOL) + (size_t)g * 128 * 128, 0, scr, r % I_PL, LANE()); }
    }
    bf16* XN = WSP(bf16, WS_XN);
    for (int m = gw; m < XNROWS; m += NGW) {
        if (m < MP) rms_row_to_bf16(LANE(), ((const float*)A.in[0]) + (size_t)m * D, ((const float*)A.in[9]), XN + (size_t)m * D);
        else if (m < MP + NS) rms_row_to_bf16(LANE(), ((const float*)A.in[1]) + (size_t)(m - MP) * D, ((const float*)A.in[9]), XN + (size_t)m * D);
        else if (m < MALL) { GAS unsigned long long* o8 = (GAS unsigned long long*)(XN + (size_t)m * D) + LANE(); o8[0] = 0ull; o8[64] = 0ull; o8[128] = 0ull; o8[192] = 0ull; }
        else rms_row_to_bf16(LANE(), ((const float*)A.in[8]) + (size_t)(m - MALL) * D, ((const float*)A.in[15]), XN + (size_t)m * D);
    }
    { float* rc = WSP(float, WS_ROPE); float* rs = rc + 2049 * 32; const int gt = F.vcu * (NWAVES * 64) + TID(F), NT = F.G * NWAVES * 64;
      for (int e = gt; e < 2049 * 32; e += NT) { const int pos = e >> 5, i = e & 31; const float invf = exp2f(-(float)i * (13.287712379549449f / 32.0f)); const double a = (double)pos * (double)invf; const double kq = __builtin_rint(a * 0.15915494309189535); const float rr = (float)(a - kq * 6.283185307179586); rc[e] = cosf(rr); rs[e] = sinf(rr); }
      { GAS f32x4* z = (GAS f32x4*)WSP(float, WS_SACC); for (int e = gt; e < (int)(SACC_BYTES / 16); e += NT) z[e] = (f32x4){0.f, 0.f, 0.f, 0.f}; }
      const GAS f32x4* sp = (const GAS f32x4*)((const float*)A.in[6]); GAS f32x4* po = (GAS f32x4*)(F.out + O_POOLS);
      for (int e = gt; e < NS * 14 * (PW / 4); e += NT) { const int s = e / (14 * 128), r = (e / 128) % 14, c = e & 127; po[(s * 15 + r) * 128 + c] = sp[(s * 15 + r + 1) * 128 + c]; } }
}
constexpr int POOL_LD = 136;
__device__ __forceinline__ void pool_mma_store(Frame& F, const Args& A, int row0, int g) {
    const LAS unsigned char* DB = F.lds + RING_OFF + 40960;
    const int fr = LANE() & 15, fq = LANE() >> 4, w = F.wave;
    const bf16* WP = WSP(bf16, WS_WPOOL) + (size_t)g * 128 * 128;
    f32x4 acc[8];
#pragma unroll
    for (int nb = 0; nb < 8; ++nb) acc[nb] = (f32x4){0.f, 0.f, 0.f, 0.f};
#pragma unroll
    for (int ks = 0; ks < 4; ++ks) {
        const bf16x8 a = *(const LAS bf16x8*)(DB + ((16 * w + fr) * POOL_LD + ks * 32 + 8 * fq) * 2);
#pragma unroll
        for (int nb = 0; nb < 8; ++nb) { const bf16x8 b = *(const GAS bf16x8*)(WP + (size_t)(nb * 16 + fr) * 128 + ks * 32 + 8 * fq); acc[nb] = __builtin_amdgcn_mfma_f32_16x16x32_bf16(b, a, acc[nb], 0, 0, 0); }
    }
    bf16* MIX = WSP(bf16, WS_MIX);
#pragma unroll
    for (int nb = 0; nb < 8; ++nb) { const int col = g * 128 + nb * 16 + 4 * fq; const f32x4 sp = *(const GAS f32x4*)(((const float*)A.in[12]) + col); const f32x4 v = acc[nb] * sp;
        v2u o; o.x = pk2(v[0], v[1]); o.y = pk2(v[2], v[3]); *(GAS v2u*)(MIX + (size_t)(row0 + 16 * w + fr) * D + col) = o; }
}
__device__ __forceinline__ void pool_unit(Frame& F, const Args& A, int L) {
    LAS unsigned short* UB = (LAS unsigned short*)(F.lds + RING_OFF);
    LAS unsigned short* DB = (LAS unsigned short*)(F.lds + RING_OFF + 40960);
    const int c = TID(F) & 127, strip = TID(F) >> 7;
    if (L < 512) {
        const int pnl = L >> 2, g = L & 3, r0 = pnl * 128, w = 2 << g; const bool first = (r0 & (SEQ - 1)) == 0;
        const bf16* U = WSP(bf16, WS_U);
        for (int e = TID(F); e < 144 * 16; e += NWAVES * 64) { const int rr = e >> 4, ch = e & 15; v4u v = {0u, 0u, 0u, 0u};
            if (!(first && rr < 16)) v = *(const GAS v4u*)(U + (size_t)(r0 - 16 + rr) * PW + g * 128 + ch * 8);
            *(LAS v4u*)(UB + rr * POOL_LD + ch * 8) = v; }
        LDS_WAIT(); __syncthreads();
        const int rs = strip * 32; float s = 0.f;
        for (int j = 1; j < w; ++j) s += bf2f(UB[(16 + rs - j) * POOL_LD + c]);
        const int pos0 = (r0 & (SEQ - 1)) + rs; const float invw = 1.0f / (float)w;
        for (int r = 0; r < 32; ++r) { const float uv = bf2f(UB[(16 + rs + r) * POOL_LD + c]); s += uv; const int pos = pos0 + r;
            const float inv = (pos + 1 >= w) ? invw : 1.0f / (float)(pos + 1);
            DB[(rs + r) * POOL_LD + c] = (unsigned short)f2bf(s * inv - uv); s -= bf2f(UB[(16 + rs + r - w + 1) * POOL_LD + c]); }
        LDS_WAIT(); __syncthreads();
        pool_mma_store(F, A, r0, g);
    } else {
        const int g = L - 512, w = 2 << g; const float invw = 1.0f / (float)w;
        const float* ps = WSP(float, WS_SACC + SA_PS);
        for (int r = 0; r < 32; ++r) { const int smp = strip * 32 + r; const float uv = ps[(size_t)smp * 2048 + g * 128 + c]; float s = uv;
            F.out[O_POOLS + (size_t)(smp * 15 + 14) * PW + g * 128 + c] = uv;
            for (int j = 1; j < w; ++j) s += ((const float*)A.in[6])[(size_t)(smp * 15 + 15 - j) * PW + g * 128 + c];
            DB[smp * POOL_LD + c] = (unsigned short)f2bf(s * invw - uv); }
        LDS_WAIT(); __syncthreads();
        pool_mma_store(F, A, MP, g);
    }
    LDS_WAIT(); __syncthreads();
}
__device__ __forceinline__ void sample_moba(Frame& F, const Args& A, int b) {
    int lane_ = LANE(); asm volatile("" : "+v"(lane_)); const int h = F.wave, lane = lane_, sub = lane & 15, rw = lane >> 4;
    LAS float* LG = (LAS float*)(F.lds + RING_OFF + h * 8192);
    const int* pt = ((const int*)A.in[7]) + b * NPAGES;
    const float* ps = WSP(float, WS_SACC + SA_PS) + (size_t)b * 2048;
    f32x4 qv, kn, vn;
    { const int i4 = 4 * (sub & 7); const float* rc = WSP(float, WS_ROPE) + 2048 * 32 + i4; const f32x4 c = *(const GAS f32x4*)rc, sn = *(const GAS f32x4*)(rc + 2049 * 32);
      const f32x4 q1 = *(const GAS f32x4*)(ps + 512 + h * 64 + i4), q2 = *(const GAS f32x4*)(ps + 512 + h * 64 + 32 + i4), k1 = *(const GAS f32x4*)(ps + 1024 + h * 64 + i4), k2 = *(const GAS f32x4*)(ps + 1024 + h * 64 + 32 + i4);
      qv = (sub < 8) ? (q1 * c - q2 * sn) : (q2 * c + q1 * sn); kn = (sub < 8) ? (k1 * c - k2 * sn) : (k2 * c + k1 * sn); vn = *(const GAS f32x4*)(ps + 1536 + h * 64 + 4 * sub);
      if (rw == 0) { *(GAS f32x4*)(F.out + O_KS + (size_t)b * 512 + h * 64 + 4 * sub) = kn; *(GAS f32x4*)(F.out + O_VS + (size_t)b * 512 + h * 64 + 4 * sub) = vn; }
      qv = qv * 0.125f; }
    LAS float* BS = (LAS float*)(F.lds + RING_OFF + 65536 + h * 64);
#pragma unroll 1
    for (int n = 0; n < 8; ++n) {
        float sacc = 0.f;
#pragma unroll 1
        for (int pg = 0; pg < 2; ++pg) { const int page = __builtin_amdgcn_readfirstlane(pt[2 * n + pg]);
            const float* base = ((const float*)A.in[2]) + ((size_t)page * PAGE * NH + h) * HD + 4 * sub;
#pragma unroll 1
            for (int g8 = 0; g8 < 4; ++g8) { f32x4 kv[8];
#pragma unroll
                for (int u = 0; u < 8; ++u) kv[u] = __builtin_nontemporal_load((const GAS f32x4*)(base + (size_t)(4 * (g8 * 8 + u) + rw) * (NH * HD)));
#pragma unroll
                for (int u = 0; u < 8; ++u) { float p = (kv[u][0] * qv[0] + kv[u][1] * qv[1]) + (kv[u][2] * qv[2] + kv[u][3] * qv[3]);
                    p += xshfl(p, 1, lane); p += xshfl(p, 2, lane); p += xshfl(p, 4, lane); p += xshfl(p, 8, lane);
                    if (sub == 0) LG[n * 256 + pg * 128 + 4 * (g8 * 8 + u) + rw] = p; sacc += p; } } }
        sacc += xshfl(sacc, 16, lane); sacc += xshfl(sacc, 32, lane); if (lane == 0) BS[n] = sacc;
    }
    LDS_WAIT();
    float bsum[8];
#pragma unroll
    for (int n = 0; n < 8; ++n) bsum[n] = BS[n];
    unsigned sel = 0u;
#pragma unroll
    for (int n = 0; n < 8; ++n) { int rk = 0;
#pragma unroll
        for (int m2 = 0; m2 < 8; ++m2) if (m2 != n) rk += (bsum[m2] > bsum[n] || (bsum[m2] == bsum[n] && m2 < n)) ? 1 : 0;
        if (rk < 3) sel |= 1u << n; }
    sel = __builtin_amdgcn_readfirstlane(sel);
    float pown = (kn[0] * qv[0] + kn[1] * qv[1]) + (kn[2] * qv[2] + kn[3] * qv[3]);
    pown += xshfl(pown, 1, lane); pown += xshfl(pown, 2, lane); pown += xshfl(pown, 4, lane); pown += xshfl(pown, 8, lane);
    LDS_WAIT();
    float mx = pown;
#pragma unroll
    for (int n = 0; n < 8; ++n) if ((sel >> n) & 1u) { const f32x4 l4 = *(const LAS f32x4*)(LG + n * 256 + 4 * lane); mx = __builtin_fmaxf(mx, __builtin_fmaxf(__builtin_fmaxf(l4[0], l4[1]), __builtin_fmaxf(l4[2], l4[3]))); }
    mx = wave_max(mx, lane);
    f32x4 oacc = {0.f, 0.f, 0.f, 0.f}; float lsum = 0.f;
#pragma unroll 1
    for (int n = 0; n < 8; ++n) if ((sel >> n) & 1u) {
#pragma unroll 1
        for (int pg = 0; pg < 2; ++pg) { const int page = __builtin_amdgcn_readfirstlane(pt[2 * n + pg]);
            const float* base = ((const float*)A.in[3]) + ((size_t)page * PAGE * NH + h) * HD + 4 * sub;
            for (int g8 = 0; g8 < 4; ++g8) { f32x4 vv[8];
#pragma unroll
                for (int u = 0; u < 8; ++u) vv[u] = __builtin_nontemporal_load((const GAS f32x4*)(base + (size_t)(4 * (g8 * 8 + u) + rw) * (NH * HD)));
#pragma unroll
                for (int u = 0; u < 8; ++u) { const float e = __expf(LG[n * 256 + pg * 128 + 4 * (g8 * 8 + u) + rw] - mx); lsum += e; oacc += vv[u] * e; } } } }
    { const float e = __expf(pown - mx); if (rw == 0) { lsum += e; oacc += vn * e; } }
    lsum += xshfl(lsum, 16, lane); lsum += xshfl(lsum, 32, lane);
#pragma unroll
    for (int j = 0; j < 4; ++j) { float v = oacc[j]; v += xshfl(v, 16, lane); v += xshfl(v, 32, lane); oacc[j] = v; }
    if (lane < 16) { const float inv = 1.0f / lsum; v2u o; o.x = pk2(oacc[0] * inv, oacc[1] * inv); o.y = pk2(oacc[2] * inv, oacc[3] * inv);
        *(GAS v2u*)(WSP(bf16, WS_MIX) + (size_t)(MP + b) * D + PW + h * 64 + 4 * sub) = o; }
    LDS_WAIT();
}
__device__ __forceinline__ void sample_cross(Frame& F, const Args& A, int b) {
    int lane_ = LANE(); asm volatile("" : "+v"(lane_)); const int lane = lane_, w = F.wave;
    LAS float* LG = (LAS float*)(F.lds + RING_OFF);
    LAS float* PO = (LAS float*)(F.lds + RING_OFF + 4096);
    f32x4 q[4];
    { const float* xs = ((const float*)A.in[1]) + (size_t)b * D; const float* a1 = WSP(float, WS_SACC + SA_A1) + (size_t)b * D; const float* aq = WSP(float, WS_SACC + SA_AQ) + (size_t)b * D; float ss = 0.f;
#pragma unroll
      for (int hh = 0; hh < 4; ++hh) { const f32x4 x = *(const GAS f32x4*)(xs + hh * 256 + 4 * lane) + *(const GAS f32x4*)(a1 + hh * 256 + 4 * lane); ss += (x[0] * x[0] + x[1] * x[1]) + (x[2] * x[2] + x[3] * x[3]); q[hh] = *(const GAS f32x4*)(aq + hh * 256 + 4 * lane); }
      const float r1 = CROSS_C2 / sqrtf(wave_sum(ss, lane) * (1.0f / D) + EPS);
#pragma unroll
      for (int hh = 0; hh < 4; ++hh) q[hh] = q[hh] * r1; }
    const float* kb = ((const float*)A.in[4]) + (size_t)b * 256 * D;
    for (int k0 = 0; k0 < 32; k0 += 2) { f32x4 kv[2][4];
#pragma unroll
        for (int u = 0; u < 2; ++u)
#pragma unroll
            for (int hh = 0; hh < 4; ++hh) kv[u][hh] = __builtin_nontemporal_load((const GAS f32x4*)(kb + (size_t)(w + 8 * (k0 + u)) * D + hh * 256 + 4 * lane));
#pragma unroll
        for (int u = 0; u < 2; ++u)
#pragma unroll
            for (int hh = 0; hh < 4; ++hh) { float p = (kv[u][hh][0] * q[hh][0] + kv[u][hh][1] * q[hh][1]) + (kv[u][hh][2] * q[hh][2] + kv[u][hh][3] * q[hh][3]); p = wave_sum(p, lane); if (lane == 0) LG[hh * 256 + w + 8 * (k0 + u)] = p; } }
    LDS_WAIT(); __syncthreads();
    if (w < 4) { const f32x4 l4 = *(const LAS f32x4*)(LG + w * 256 + 4 * lane); const float mx = wave_max(__builtin_fmaxf(__builtin_fmaxf(l4[0], l4[1]), __builtin_fmaxf(l4[2], l4[3])), lane);
        f32x4 e; e[0] = __builtin_amdgcn_exp2f(l4[0] - mx); e[1] = __builtin_amdgcn_exp2f(l4[1] - mx); e[2] = __builtin_amdgcn_exp2f(l4[2] - mx); e[3] = __builtin_amdgcn_exp2f(l4[3] - mx);
        const float inv = 1.0f / wave_sum((e[0] + e[1]) + (e[2] + e[3]), lane); *(LAS f32x4*)(LG + w * 256 + 4 * lane) = e * inv; }
    LDS_WAIT(); __syncthreads();
    const float* vb = ((const float*)A.in[5]) + (size_t)b * 256 * D;
    f32x4 oacc[4];
#pragma unroll
    for (int hh = 0; hh < 4; ++hh) oacc[hh] = (f32x4){0.f, 0.f, 0.f, 0.f};
    for (int k0 = 0; k0 < 32; k0 += 2) { f32x4 vv[2][4];
#pragma unroll
        for (int u = 0; u < 2; ++u)
#pragma unroll
            for (int hh = 0; hh < 4; ++hh) vv[u][hh] = __builtin_nontemporal_load((const GAS f32x4*)(vb + (size_t)(w + 8 * (k0 + u)) * D + hh * 256 + 4 * lane));
#pragma unroll
        for (int u = 0; u < 2; ++u)
#pragma unroll
            for (int hh = 0; hh < 4; ++hh) oacc[hh] += vv[u][hh] * LG[hh * 256 + w + 8 * (k0 + u)]; }
#pragma unroll
    for (int hh = 0; hh < 4; ++hh) *(LAS f32x4*)(PO + w * 1024 + hh * 256 + 4 * lane) = oacc[hh];
    LDS_WAIT(); __syncthreads();
    { const int c = 2 * (w * 64 + lane); float a0 = 0.f, a1 = 0.f;
#pragma unroll
      for (int ww = 0; ww < 8; ++ww) { a0 += PO[ww * 1024 + c]; a1 += PO[ww * 1024 + c + 1]; }
      *(GAS unsigned*)(WSP(bf16, WS_OC) + (size_t)(MP + b) * D + c) = pk2(a0, a1); }
    LDS_WAIT(); __syncthreads();
}
__device__ __forceinline__ void cross_unit(Frame& F, int pm, int h) {
    const int b = pm >> 3;
    bf16* PB = WSP(bf16, WS_PB) + (size_t)blockIdx.x * 65536;
    { pg8::Gemm g{WSP(bf16, WS_QC) + (size_t)pm * 256 * D + h * 256, WSP(bf16, WS_MKB) + (size_t)b * 256 * D + h * 256, 256, D, D};
      pg8::EpiSoftmaxP E{PB}; pg8::OneUnit S;
      pg8::gemm_phase<pg8::EpiSoftmaxP, pg8::OneUnit, false, false>(F.lds + RING_OFF, g, S, E, F.wave); }
    VM_WAIT(); __syncthreads(); __builtin_amdgcn_fence(__ATOMIC_ACQUIRE, "agent"); VM_WAIT(); __syncthreads();
    { pg8::Gemm g{PB, WSP(bf16, WS_MVT) + (size_t)(b * 4 + h) * 65536, 256, 256, 256};
      pg8::EpiTile E{WSP(bf16, WS_OC) + (size_t)pm * 256 * D + h * 256, D}; pg8::OneUnit S;
      pg8::gemm_phase<pg8::EpiTile, pg8::OneUnit, false, false>(F.lds + RING_OFF, g, S, E, F.wave); }
    VM_WAIT(); __syncthreads();
}
__device__ __forceinline__ void final_norm(Frame& F, const Args& A) {
    const int gw = F.vcu * NWAVES + F.wave, NGW = F.G * NWAVES; const float* ss3 = (const float*)(F.ctl + CW_SS3); const GAS f32x4* gr = (const GAS f32x4*)((const float*)A.in[23]) + LANE();
    for (int m = gw; m < MP + NS; m += NGW) {
        if (m < MP) { float* row = F.out + O_YP + (size_t)m * D; const float r = 1.0f / sqrtf(ss3[m] * (1.0f / D) + EPS); GAS f32x4* xr = (GAS f32x4*)row + LANE();
#pragma unroll
            for (int j = 0; j < 4; ++j) { const f32x4 v = xr[64 * j], g = gr[64 * j]; xr[64 * j] = v * r * g; } }
        else { const int b = m - MP; const GAS f32x4* x0 = (const GAS f32x4*)(((const float*)A.in[1]) + (size_t)b * D) + LANE(); const GAS f32x4* x1 = (const GAS f32x4*)(WSP(float, WS_SACC + SA_A1) + (size_t)b * D) + LANE();
            const GAS f32x4* x2 = (const GAS f32x4*)(WSP(float, WS_SACC + SA_A3) + (size_t)b * D) + LANE(); const GAS f32x4* x3 = (const GAS f32x4*)(WSP(float, WS_SACC + SA_AD) + (size_t)b * D) + LANE();
            f32x4 v[4]; float ss = 0.f;
#pragma unroll
            for (int j = 0; j < 4; ++j) { v[j] = (x0[64 * j] + x1[64 * j]) + (x2[64 * j] + x3[64 * j]); ss += (v[j][0] * v[j][0] + v[j][1] * v[j][1]) + (v[j][2] * v[j][2] + v[j][3] * v[j][3]); }
            const float r = 1.0f / sqrtf(wave_sum(ss, LANE()) * (1.0f / D) + EPS); GAS f32x4* yr = (GAS f32x4*)(F.out + O_YS + (size_t)b * D) + LANE();
#pragma unroll
            for (int j = 0; j < 4; ++j) yr[64 * j] = v[j] * r * gr[64 * j]; }
    }
}
struct ASrcBf16 { const bf16* Ab; int lda;
    __device__ __forceinline__ bf16x8 frag(int row, int k, float&) const { return *(const GAS bf16x8*)(Ab + (size_t)row * lda + k); } };
struct ASrcSum { const float *X, *Y, *Z, *g;
    __device__ __forceinline__ bf16x8 frag(int row, int k, float& ss) const {
        f32x4 a0 = *(const GAS f32x4*)(X + (size_t)row * D + k) + *(const GAS f32x4*)(Y + (size_t)row * D + k), a1 = *(const GAS f32x4*)(X + (size_t)row * D + k + 4) + *(const GAS f32x4*)(Y + (size_t)row * D + k + 4);
        if (Z) { a0 += *(const GAS f32x4*)(Z + (size_t)row * D + k); a1 += *(const GAS f32x4*)(Z + (size_t)row * D + k + 4); }
        ss += (a0[0] * a0[0] + a0[1] * a0[1]) + (a0[2] * a0[2] + a0[3] * a0[3]) + (a1[0] * a1[0] + a1[1] * a1[1]) + (a1[2] * a1[2] + a1[3] * a1[3]);
        const f32x4 g0 = *(const GAS f32x4*)(g + k), g1 = *(const GAS f32x4*)(g + k + 4); a0 = a0 * g0; a1 = a1 * g1;
        v4u w; w.x = pk2(a0[0], a0[1]); w.y = pk2(a0[2], a0[3]); w.z = pk2(a1[0], a1[1]); w.w = pk2(a1[2], a1[3]); return __builtin_bit_cast(bf16x8, w); } };
__device__ __forceinline__ int win_src_col(int c) { if (c < 512 || c >= 1536) return c; const int t = c & ~255, j = c & 255, p = j >> 7, hh = (j >> 5) & 3, i = j & 31; return t + 64 * hh + 32 * p + i; }
template <class AS, int EPI, bool WINPERM = false> __device__ __forceinline__ void sample_gemm(Frame& F, const AS& as, const bf16* Bt, int ldb, int N, int K, float* OUT, bf16* OUTB) {
    const int nsl = N / 16; int nsplit = F.G / nsl; if (nsplit < 1 || EPI == 1) nsplit = 1; const int ksteps = K / 32 / nsplit;
    int lane_ = LANE(); asm volatile("" : "+v"(lane_)); const int lane = lane_, fr = lane & 15, fq = lane >> 4, row = 16 * F.wave + fr;
    for (int v = F.vcu; v < nsl * nsplit; v += F.G) { const int sl = v % nsl, sp = v / nsl;
        f32x4 acc = {0.f, 0.f, 0.f, 0.f}; float ss = 0.f; const bf16* bp = Bt + (size_t)(16 * sl + fr) * ldb + 8 * fq;
#pragma unroll 8
        for (int ks = sp * ksteps; ks < (sp + 1) * ksteps; ++ks) { const bf16x8 a = as.frag(row, 32 * ks + 8 * fq, ss); const bf16x8 b = *(const GAS bf16x8*)(bp + 32 * ks); acc = __builtin_amdgcn_mfma_f32_16x16x32_bf16(b, a, acc, 0, 0, 0); }
        if (EPI == 0) { float* o = OUT + (size_t)row * N + (WINPERM ? win_src_col(16 * sl + 4 * fq) : 16 * sl + 4 * fq); unsafeAtomicAdd(o, acc[0]); unsafeAtomicAdd(o + 1, acc[1]); unsafeAtomicAdd(o + 2, acc[2]); unsafeAtomicAdd(o + 3, acc[3]); }
        else { ss += xshfl(ss, 16, lane); ss += xshfl(ss, 32, lane); const float r = 1.0f / sqrtf(ss * (1.0f / D) + EPS);
            f32x4 hv = acc * r; hv = __builtin_elementwise_max(hv, (f32x4){0.f, 0.f, 0.f, 0.f}); hv = hv * hv; v2u o; o.x = pk2(hv[0], hv[1]); o.y = pk2(hv[2], hv[3]); *(GAS v2u*)(OUTB + (size_t)row * N + 16 * sl + 4 * fq) = o; }
    }
}
__device__ __forceinline__ int next_task(Frame& F, gu32* head) {
    int slot = 16; asm volatile("" : "+v"(slot));
    __syncthreads();
    if (TID(F) + slot == 16) F.MISC[slot] = __hip_atomic_fetch_add(head, 1u, RLX_AGENT);
    __syncthreads();
    return __builtin_amdgcn_readfirstlane((int)F.MISC[slot]);
}
#ifndef REPMASK
#define REPMASK 0
#endif
#define NREP(k) (1 + ((REPMASK >> (k)) & 1))
#ifndef SKIPMASK
#define SKIPMASK 0
#endif
__global__ void __launch_bounds__(NWAVES * 64, 2) mk_fwd(Args args) {
    const Args& A = args;
    extern __shared__ __attribute__((aligned(16))) unsigned char lds[];
    Frame F;
    F.lds = (LAS unsigned char*)lds;
    F.MISC = (volatile LAS unsigned*)(F.lds + MISC_OFF);
    F.wave = __builtin_amdgcn_readfirstlane((int)(threadIdx.x >> 6));
    F.G = gridDim.x; { const int bx = blockIdx.x; F.vcu = (F.G % 8 == 0) ? (bx % 8) * (F.G / 8) + bx / 8 : bx; }
    F.ws = args.ws; F.out = args.out; F.ctl = (gu32*)(args.ws + WS_CTL);
    for (int u = TID(F); u < (LDS_BYTES - LDSCTL_OFF) / 4; u += NWAVES * 64) ((LAS unsigned*)(F.lds + LDSCTL_OFF))[u] = 0u;
    __syncthreads();
    XcdBarrier bar; bar.bar = (unsigned*)(F.ctl + CW_BAR); bar.x = 0; bar.st = nullptr; bar.wave = F.wave;
    if (N_LAUNCHES != PER_PHASE) bar = xcd_barrier_post((unsigned*)(F.ctl + CW_BAR), F.MISC + 8, F.wave);
#define GRID_BAR(seam) do { if (N_LAUNCHES == PER_PHASE) { if (TID(F) == 0) __hip_atomic_store(F.ctl + CW_TMO, 0xBADBA0u | (unsigned)(seam), RLX_AGENT); } else { xcd_barrier(bar); } } while (0)
    const int lo = args.ph_lo, hi = args.ph_hi;
#define IN(k) (lo <= (k) && (k) < hi)
#define BOTH(k) (IN(k) && IN((k) + 1))
    float* const ss1 = (float*)(F.ctl + CW_SS1); float* const ss2 = (float*)(F.ctl + CW_SS2); float* const ss3 = (float*)(F.ctl + CW_SS3);
    float* const X1 = WSP(float, WS_X1);

    if (IN(0) && !(SKIPMASK & (1 << 0))) { for (int rp = 0; rp < NREP(0); ++rp) p0_prologue(F, A); if (BOTH(0)) GRID_BAR(0); }

    if (IN(1) && !(SKIPMASK & (1 << 1))) {
        { ASrcBf16 as{WSP(bf16, WS_XN) + (size_t)MP * D, D}; sample_gemm<ASrcBf16, 0, true>(F, as, WSP(bf16, WS_WIN), D, 2048, D, WSP(float, WS_SACC + SA_PS), nullptr); }
        for (int rp = 0; rp < NREP(1); ++rp) {
        pg8::Gemm g{WSP(bf16, WS_XN), WSP(bf16, WS_WIN), D, D, D}; pg8::StaticOrder S; S.init(MP, 2048, F.G, (int)blockIdx.x);
        float* rc = WSP(float, WS_ROPE);
        pg8::EpiQKV E{WSP(bf16, WS_U), WSP(bf16, WS_Q), WSP(bf16, WS_K), WSP(bf16, WS_V), WSP(bf16, WS_MKB), WSP(bf16, WS_MVT), (float*)(F.ctl + CW_KSUM), rc, rc + 2049 * 32,
                      F.out + O_KP, F.out + O_VP, F.out + O_POOLP, F.out + O_MK, F.out + O_MV, attn_body::C2};
        pg8::gemm_phase<pg8::EpiQKV, pg8::StaticOrder, true, true>(F.lds + RING_OFF, g, S, E, F.wave);
        }
        if (BOTH(1)) GRID_BAR(1);
    }

    if (IN(2) && !(SKIPMASK & (1 << 2))) {
        const attn_body::AttnTensors AT{(const attn_body::bf16*)WSP(bf16, WS_Q), (const attn_body::bf16*)WSP(bf16, WS_K), (const attn_body::bf16*)WSP(bf16, WS_V), (attn_body::bf16*)(WSP(bf16, WS_MIX) + PW), D, (const float*)(F.ctl + CW_KSUM)};
        for (int rp = 0; rp < NREP(10); ++rp)
        for (;;) { const int t = next_task(F, F.ctl + rp * 1024 + CW_Q2); if (t >= NS) break; sample_moba(F, A, t); }
        for (int rp = 0; rp < NREP(11); ++rp)
        for (;;) { const int i = next_task(F, F.ctl + rp * 1024 + CW_Q2 + 64); if (i >= 64) break;
            pg8::Gemm g{WSP(bf16, WS_XN), WSP(bf16, WS_WIN), D, D, D}; pg8::OneUnitAt S{65 + (i & 7), 8 + (i >> 3)};
            float* rc = WSP(float, WS_ROPE);
            pg8::EpiQKV E{WSP(bf16, WS_U), WSP(bf16, WS_Q), WSP(bf16, WS_K), WSP(bf16, WS_V), WSP(bf16, WS_MKB), WSP(bf16, WS_MVT), (float*)(F.ctl + CW_KSUM), rc, rc + 2049 * 32,
                          F.out + O_KP, F.out + O_VP, F.out + O_POOLP, F.out + O_MK, F.out + O_MV, attn_body::C2};
            pg8::gemm_phase<pg8::EpiQKV, pg8::OneUnitAt, false, true>(F.lds + RING_OFF, g, S, E, F.wave); }
        for (int rp = 0; rp < NREP(12); ++rp)
        for (;;) { const int i = next_task(F, F.ctl + rp * 1024 + CW_Q2 + 128); if (i >= 512) break; const int qb = 7 - (i >> 6), bh = i & 63;
            attn_body::attn_unit<8>(bh >> 3, bh & 7, qb, AT.Q, AT.K, AT.V, AT.O, AT.opitch, AT.KS, (char*)lds + RING_OFF, F.wave); }
        for (int rp = 0; rp < NREP(13); ++rp)
        for (;;) { const int i = next_task(F, F.ctl + rp * 1024 + CW_Q2 + 192); if (i >= 516) break; pool_unit(F, A, i); }
        if (BOTH(2)) GRID_BAR(2);
    }

    if (IN(3) && !(SKIPMASK & (1 << 3))) {
        { ASrcBf16 as{WSP(bf16, WS_MIX) + (size_t)MP * D, D}; sample_gemm<ASrcBf16, 0>(F, as, WSP(bf16, WS_WOUT), D, D, D, WSP(float, WS_SACC + SA_A1), nullptr); }
        pg8::Gemm g{WSP(bf16, WS_MIX), WSP(bf16, WS_WOUT), D, D, D}; pg8::StaticOrder S; S.init(MP, D, F.G, (int)blockIdx.x);
        pg8::EpiRes E{((const float*)A.in[0]), X1, WSP(bf16, WS_XG), ((const float*)A.in[14]), ss1};
        pg8::gemm_phase<pg8::EpiRes, pg8::StaticOrder, true, true>(F.lds + RING_OFF, g, S, E, F.wave);
        if (BOTH(3)) GRID_BAR(3);
    }
    if (IN(4) && !(SKIPMASK & (1 << 4))) {
        { ASrcSum as{((const float*)A.in[1]), WSP(float, WS_SACC + SA_A1), nullptr, ((const float*)A.in[14])}; sample_gemm<ASrcSum, 0>(F, as, WSP(bf16, WS_WCQ), D, D, D, WSP(float, WS_SACC + SA_AQ), nullptr); }
        for (int rp = 0; rp < NREP(4); ++rp) {
        pg8::Gemm g{WSP(bf16, WS_XG), WSP(bf16, WS_WCQ), D, D, D}; pg8::StaticOrder S; S.init(MP, D, F.G, (int)blockIdx.x);
        pg8::EpiScale<0> E{WSP(bf16, WS_QC), D, ss1, CROSS_C2};
        pg8::gemm_phase<pg8::EpiScale<0>, pg8::StaticOrder, true, true>(F.lds + RING_OFF, g, S, E, F.wave);
        }
        if (BOTH(4)) GRID_BAR(4);
    }
    if (IN(5) && !(SKIPMASK & (1 << 5))) {
        for (int rp = 0; rp < NREP(14); ++rp)
        for (;;) { const int t = next_task(F, F.ctl + rp * 1024 + CW_Q5); if (t >= NS) break; sample_cross(F, A, t); }
        for (int rp = 0; rp < NREP(15); ++rp)
        for (;;) { const int L = next_task(F, F.ctl + rp * 1024 + CW_Q5 + 64); if (L >= 256) break; cross_unit(F, L >> 2, L & 3); }
        if (BOTH(5)) GRID_BAR(5);
    }
    if (IN(6) && !(SKIPMASK & (1 << 6))) {
        { ASrcBf16 as{WSP(bf16, WS_OC) + (size_t)MP * D, D}; sample_gemm<ASrcBf16, 0>(F, as, WSP(bf16, WS_WCO), D, D, D, WSP(float, WS_SACC + SA_A3), nullptr); }
        pg8::Gemm g{WSP(bf16, WS_OC), WSP(bf16, WS_WCO), D, D, D}; pg8::StaticOrder S; S.init(MP, D, F.G, (int)blockIdx.x);
        pg8::EpiRes E{X1, X1, WSP(bf16, WS_XG), ((const float*)A.in[20]), ss2};
        pg8::gemm_phase<pg8::EpiRes, pg8::StaticOrder, true, true>(F.lds + RING_OFF, g, S, E, F.wave);
        if (BOTH(6)) GRID_BAR(6);
    }
    if (IN(7) && !(SKIPMASK & (1 << 7))) {
        { ASrcSum as{((const float*)A.in[1]), WSP(float, WS_SACC + SA_A1), WSP(float, WS_SACC + SA_A3), ((const float*)A.in[20])}; sample_gemm<ASrcSum, 1>(F, as, WSP(bf16, WS_WUP), D, FF, D, nullptr, WSP(bf16, WS_HBS)); }
        for (int rp = 0; rp < NREP(7); ++rp) {
        pg8::Gemm g{WSP(bf16, WS_XG), WSP(bf16, WS_WUP), D, D, D}; pg8::StaticOrder S; S.init(MP, FF, F.G, (int)blockIdx.x);
        pg8::EpiScale<1> E{WSP(bf16, WS_HB), FF, ss2, 1.0f};
        pg8::gemm_phase<pg8::EpiScale<1>, pg8::StaticOrder, true, true>(F.lds + RING_OFF, g, S, E, F.wave);
        }
        if (BOTH(7)) GRID_BAR(7);
    }
    if (IN(8) && !(SKIPMASK & (1 << 8))) {
        { ASrcBf16 as{WSP(bf16, WS_HBS), FF}; sample_gemm<ASrcBf16, 0>(F, as, WSP(bf16, WS_WDN), FF, D, FF, WSP(float, WS_SACC + SA_AD), nullptr); }
        pg8::Gemm g{WSP(bf16, WS_HB), WSP(bf16, WS_WDN), FF, FF, FF}; pg8::StaticOrder S; S.init(MP, D, F.G, (int)blockIdx.x);
        pg8::EpiRes E{X1, F.out + O_YP, nullptr, nullptr, ss3};
        pg8::gemm_phase<pg8::EpiRes, pg8::StaticOrder, true, true>(F.lds + RING_OFF, g, S, E, F.wave);
        if (BOTH(8)) GRID_BAR(8);
    }
    if (IN(9) && !(SKIPMASK & (1 << 9))) { final_norm(F, A); }
#undef IN
#undef BOTH
}

extern "C" void kernel_launch(void* const* d_in, const int* in_sizes, int n_in, void* d_out, int out_size, void* d_ws, size_t ws_size, hipStream_t stream) {
    static int grid = 0;
    if (grid == 0) {
        if (n_in != 24 || in_sizes[0] != MP * D || (size_t)out_size != O_END || ws_size < WS_END) { fprintf(stderr, "kernel_launch: unexpected shapes: n_in %d in0 %d out %d ws %zu; nothing launched\n", n_in, n_in > 0 ? in_sizes[0] : -1, out_size, ws_size); grid = -1; return; }
        int dev = 0, cus = 0, per_cu = 0;
        if (hipGetDevice(&dev) != hipSuccess || hipDeviceGetAttribute(&cus, hipDeviceAttributeMultiprocessorCount, dev) != hipSuccess) { fprintf(stderr, "kernel_launch: hipGetDevice / hipDeviceGetAttribute failed\n"); grid = -1; return; }
        if (hipFuncSetAttribute((const void*)mk_fwd, hipFuncAttributeMaxDynamicSharedMemorySize, LDS_BYTES) != hipSuccess) { fprintf(stderr, "kernel_launch: hipFuncSetAttribute failed\n"); grid = -1; return; }
        if (hipOccupancyMaxActiveBlocksPerMultiprocessor(&per_cu, (const void*)mk_fwd, NWAVES * 64, LDS_BYTES) != hipSuccess || per_cu < 1) { fprintf(stderr, "kernel_launch: occupancy query reports %d workgroups per CU\n", per_cu); }
        (void)hipGetLastError();
        grid = cus;
        if (grid > 256) grid = 256;
    }
    if (grid < 0) return;
    if (hipMemsetAsync((char*)d_ws + WS_CTL, 0, CTL_ZERO_BYTES, stream) != hipSuccess) { fprintf(stderr, "kernel_launch: hipMemsetAsync failed\n"); return; }
    Args a{};
    for (int i = 0; i < 24; ++i) a.in[i] = d_in[i];
    a.out = (float*)d_out; a.ws = (unsigned char*)d_ws;
    for (int li = 0; li < N_LAUNCHES; ++li) {
        a.ph_lo = (N_LAUNCHES == PER_PHASE) ? li : 0; a.ph_hi = (N_LAUNCHES == PER_PHASE) ? li + 1 : PER_PHASE;
        hipLaunchKernelGGL(mk_fwd, dim3(grid), dim3(NWAVES * 64), LDS_BYTES, stream, a);
        const hipError_t le = hipPeekAtLastError();
        if (le != hipSuccess) { fprintf(stderr, "kernel_launch: launch %d failed: %s\n", li, hipGetErrorName(le)); break; }
    }
}
```

```cpp
#include <hip/hip_runtime.h>
#include <cstdio>
#include <cstdint>
#include <cmath>
namespace pg8 {
#define PG8_LAS __attribute__((address_space(3)))
typedef unsigned short bf16_t;
typedef short bf16x8 __attribute__((ext_vector_type(8)));
typedef float f32x4 __attribute__((ext_vector_type(4)));
typedef unsigned u32x4 __attribute__((ext_vector_type(4)));
constexpr int BM = 256, BK = 64, HALF = 128, HTB = HALF * BK * 2  , STAGE_BYTES = 8 * HTB, NXCD = 8, WGM = 8;

__host__ __device__ __forceinline__ int lds_byte(int r, int c) { const int st = (r >> 4) * 2 + (c >> 5), rr = r & 15, cc = c & 31, ob = rr * 64 + cc * 2; return st * 1024 + (ob ^ (((ob >> 9) & 1) << 5)); }
__host__ __device__ __forceinline__ void stage_rc(int b, int& R, int& C) { const int st = b / 1024, sb = b % 1024, swz = sb ^ (((sb >> 9) & 1) << 5); R = (st >> 1) * 16 + swz / 64; C = (st & 1) * 32 + (swz % 64) / 2; }
__host__ __device__ __forceinline__ int perm32(int rho) { const int n = rho >> 4, i = rho & 15; return 8 * (i >> 2) + 4 * n + (i & 3); }

struct Unit { int pm, pn; };
struct Gemm { const bf16_t* A; const bf16_t* Bt; int K, lda, ldb; };

struct StaticOrder {
    int nM, nN, nwg, G, c;
    __host__ __device__ void init(int M, int N, int G_, int c_) { nM = M / BM; nN = N / BM; nwg = nM * nN; G = G_; c = c_; }
    __host__ __device__ bool next(int i, Unit& u) const {
        const long L = (long)i * G + c; if (L >= nwg) return false;
        int wgid = (int)L; { const int q = nwg / NXCD, r = nwg % NXCD, xcd = wgid % NXCD, off = wgid / NXCD; wgid = (xcd < r ? xcd * (q + 1) : r * (q + 1) + (xcd - r) * q) + off; }
        const int nig = WGM * nN, gid = wgid / nig, fm = gid * WGM, gsz = (nM - fm) < WGM ? (nM - fm) : WGM;
        u.pm = fm + ((wgid % nig) % gsz); u.pn = (wgid % nig) / gsz; return true;
    }
    __device__ __forceinline__ void a_ready(const Unit&) const {}
    __device__ __forceinline__ void done(const Unit&) const {}
};

__device__ __forceinline__ unsigned cvt_pk_bf16(float lo, float hi) { unsigned r; asm volatile("v_cvt_pk_bf16_f32 %0, %1, %2" : "=v"(r) : "v"(lo), "v"(hi)); return r; }
typedef float f32x2 __attribute__((ext_vector_type(2)));
__device__ __forceinline__ float xshfl(float v, int m, int lane) { return __builtin_bit_cast(float, __builtin_amdgcn_ds_bpermute((lane ^ m) << 2, __builtin_bit_cast(int, v))); }
__device__ __forceinline__ u32x4 pack8(const f32x4 a, const f32x4 b) { u32x4 w; w.x = cvt_pk_bf16(a[0], a[1]); w.y = cvt_pk_bf16(a[2], a[3]); w.z = cvt_pk_bf16(b[0], b[1]); w.w = cvt_pk_bf16(b[2], b[3]); return w; }
__device__ __forceinline__ unsigned short bf16_1(float v) { return (unsigned short)(cvt_pk_bf16(v, 0.f) & 0xffffu); }


struct EpiQKV {
    static constexpr bool PERM = true, AFTER_DRAIN = false;
    bf16_t *U, *Q, *Kb, *V, *MKB, *MVT; float *ksum; const float *ropeC, *ropeS;
    float *o_kp, *o_vp, *o_poolp, *o_mk, *o_mv; float qscale;
    __device__ __forceinline__ void operator()(const f32x4 (&acc)[2][2][4][2], const Unit& u, int wr, int wc, int fr, int fq) const {
        const int pm = u.pm, pn = u.pn;
        if (pm >= 65) {
            const int isv = (pn - 8) >> 2, ct = (pn - 8) & 3;
#pragma unroll
            for (int ai = 0; ai < 2; ++ai)
#pragma unroll
                for (int m = 0; m < 4; ++m) { const int mrow = (pm - 65) * 256 + ai * 128 + wr * 64 + m * 16 + fr;
#pragma unroll
                    for (int bj = 0; bj < 2; ++bj) { const int cl = bj * 128 + wc * 32 + 8 * fq, col = ct * 256 + cl; const f32x4 v0 = acc[ai][bj][m][0], v1 = acc[ai][bj][m][1];
                        float* o = (isv ? o_mv : o_mk) + (size_t)mrow * 1024 + col; *(f32x4*)o = v0; *(f32x4*)(o + 4) = v1;
                        if (!isv) { *(u32x4*)(MKB + (size_t)mrow * 1024 + col) = pack8(v0, v1); }
                        else { const int b = mrow >> 8, key = mrow & 255; bf16_t* t = MVT + ((size_t)(b * 4 + ct) * 256 + cl) * 256 + key;
                            t[0 * 256] = bf16_1(v0[0]); t[1 * 256] = bf16_1(v0[1]); t[2 * 256] = bf16_1(v0[2]); t[3 * 256] = bf16_1(v0[3]);
                            t[4 * 256] = bf16_1(v1[0]); t[5 * 256] = bf16_1(v1[1]); t[6 * 256] = bf16_1(v1[2]); t[7 * 256] = bf16_1(v1[3]); } } }
            return;
        }
        const int kind = pn >> 1, half = pn & 1;
        if (kind == 0) {
#pragma unroll
            for (int ai = 0; ai < 2; ++ai)
#pragma unroll
                for (int m = 0; m < 4; ++m) { const int row = pm * 256 + ai * 128 + wr * 64 + m * 16 + fr;
#pragma unroll
                    for (int bj = 0; bj < 2; ++bj) { const int col = half * 256 + bj * 128 + wc * 32 + 8 * fq; const f32x4 v0 = acc[ai][bj][m][0], v1 = acc[ai][bj][m][1];
                        *(u32x4*)(U + (size_t)row * 512 + col) = pack8(v0, v1);
                        { const int pos = row & 2047; if (pos >= 2033) { float* o = o_poolp + ((size_t)((row >> 11) * 15 + pos - 2033) * 512 + col); *(f32x4*)o = v0; *(f32x4*)(o + 4) = v1; } } } }
        } else if (kind == 3) {
#pragma unroll
            for (int ai = 0; ai < 2; ++ai)
#pragma unroll
                for (int m = 0; m < 4; ++m) { const int row = pm * 256 + ai * 128 + wr * 64 + m * 16 + fr;
#pragma unroll
                    for (int bj = 0; bj < 2; ++bj) { const int col = half * 256 + bj * 128 + wc * 32 + 8 * fq; const f32x4 v0 = acc[ai][bj][m][0], v1 = acc[ai][bj][m][1];
                        *(u32x4*)(V + (size_t)row * 512 + col) = pack8(v0, v1);
                        { float* o = o_vp + (size_t)row * 512 + col; *(f32x4*)o = v0; *(f32x4*)(o + 4) = v1; } } }
        } else {
            const int head = half * 4 + wc, i0 = 8 * fq, col1 = head * 64 + i0, col2 = col1 + 32;
            f32x4 cs1a = {0.f, 0.f, 0.f, 0.f}, cs1b = cs1a, cs2a = cs1a, cs2b = cs1a;
#pragma unroll
            for (int ai = 0; ai < 2; ++ai)
#pragma unroll
                for (int m = 0; m < 4; ++m) { const int row = pm * 256 + ai * 128 + wr * 64 + m * 16 + fr; const int pos = row & 2047;
                    const f32x4 c0 = *(const f32x4*)(ropeC + pos * 32 + i0), c1 = *(const f32x4*)(ropeC + pos * 32 + i0 + 4), s0 = *(const f32x4*)(ropeS + pos * 32 + i0), s1 = *(const f32x4*)(ropeS + pos * 32 + i0 + 4);
                    const f32x4 x1a = acc[ai][0][m][0], x1b = acc[ai][0][m][1], x2a = acc[ai][1][m][0], x2b = acc[ai][1][m][1];
                    const f32x4 o1a = x1a * c0 - x2a * s0, o1b = x1b * c1 - x2b * s1, o2a = x2a * c0 + x1a * s0, o2b = x2b * c1 + x1b * s1;
                    if (kind == 1) {
                        *(u32x4*)(Q + (size_t)row * 512 + col1) = pack8(o1a * qscale, o1b * qscale); *(u32x4*)(Q + (size_t)row * 512 + col2) = pack8(o2a * qscale, o2b * qscale);
                    } else {
                        *(u32x4*)(Kb + (size_t)row * 512 + col1) = pack8(o1a, o1b); *(u32x4*)(Kb + (size_t)row * 512 + col2) = pack8(o2a, o2b);
                        { float* o = o_kp + (size_t)row * 512; *(f32x4*)(o + col1) = o1a; *(f32x4*)(o + col1 + 4) = o1b; *(f32x4*)(o + col2) = o2a; *(f32x4*)(o + col2 + 4) = o2b;
                            cs1a += o1a; cs1b += o1b; cs2a += o2a; cs2b += o2b; }
                    } }
            if (kind == 2) {
                float cs[16] = {cs1a[0], cs1a[1], cs1a[2], cs1a[3], cs1b[0], cs1b[1], cs1b[2], cs1b[3], cs2a[0], cs2a[1], cs2a[2], cs2a[3], cs2b[0], cs2b[1], cs2b[2], cs2b[3]};
#pragma unroll
                for (int j = 0; j < 16; ++j) { float v = cs[j]; v += xshfl(v, 1, fr + 16 * fq); v += xshfl(v, 2, fr + 16 * fq); v += xshfl(v, 4, fr + 16 * fq); v += xshfl(v, 8, fr + 16 * fq); cs[j] = v; }
                if (fr == 0) { float* kp = ksum + (size_t)pm * 512;
#pragma unroll
                    for (int j = 0; j < 8; ++j) { unsafeAtomicAdd(kp + col1 + j, cs[j]); unsafeAtomicAdd(kp + col2 + j, cs[8 + j]); } }
            }
        }
    }
};

struct EpiRes {
    static constexpr bool PERM = true, AFTER_DRAIN = false;
    const float* base; float* out; bf16_t* XG; const float* gain; float* rowss;
    __device__ __forceinline__ void operator()(const f32x4 (&acc)[2][2][4][2], const Unit& u, int wr, int wc, int fr, int fq) const {
#pragma unroll
        for (int ai = 0; ai < 2; ++ai)
#pragma unroll
            for (int m = 0; m < 4; ++m) { const int row = u.pm * 256 + ai * 128 + wr * 64 + m * 16 + fr;
                const float* bp = base + (size_t)row * 1024; float* op = out + (size_t)row * 1024;
                float ss = 0.f;
#pragma unroll
                for (int bj = 0; bj < 2; ++bj) { const int col = u.pn * 256 + bj * 128 + wc * 32 + 8 * fq;
                    const f32x4 x0 = *(const f32x4*)(bp + col) + acc[ai][bj][m][0], x1 = *(const f32x4*)(bp + col + 4) + acc[ai][bj][m][1];
                    *(f32x4*)(op + col) = x0; *(f32x4*)(op + col + 4) = x1;
                    ss += (x0[0] * x0[0] + x0[1] * x0[1]) + (x0[2] * x0[2] + x0[3] * x0[3]) + (x1[0] * x1[0] + x1[1] * x1[1]) + (x1[2] * x1[2] + x1[3] * x1[3]);
                    if (XG) { const f32x4 g0 = *(const f32x4*)(gain + col), g1 = *(const f32x4*)(gain + col + 4); *(u32x4*)(XG + (size_t)row * 1024 + col) = pack8(x0 * g0, x1 * g1); } }
                ss += xshfl(ss, 16, fr + 16 * fq); ss += xshfl(ss, 32, fr + 16 * fq);
                if (fq == 0) unsafeAtomicAdd(rowss + row, ss);
            }
    }
};
template <int ACT> struct EpiScale {
    static constexpr bool PERM = true, AFTER_DRAIN = false;
    bf16_t* O; int ldc; const float* rowss; float sc;
    __device__ __forceinline__ void operator()(const f32x4 (&acc)[2][2][4][2], const Unit& u, int wr, int wc, int fr, int fq) const {
#pragma unroll
        for (int ai = 0; ai < 2; ++ai)
#pragma unroll
            for (int m = 0; m < 4; ++m) { const int row = u.pm * 256 + ai * 128 + wr * 64 + m * 16 + fr;
                const float r = __builtin_amdgcn_rsqf(rowss[row] * (1.0f / 1024.0f) + 1e-6f) * sc;
#pragma unroll
                for (int bj = 0; bj < 2; ++bj) { const int col = u.pn * 256 + bj * 128 + wc * 32 + 8 * fq; f32x4 v0 = acc[ai][bj][m][0] * r, v1 = acc[ai][bj][m][1] * r;
                    if (ACT == 1) { v0 = __builtin_elementwise_max(v0, (f32x4){0.f, 0.f, 0.f, 0.f}); v1 = __builtin_elementwise_max(v1, (f32x4){0.f, 0.f, 0.f, 0.f}); v0 = v0 * v0; v1 = v1 * v1; }
                    *(u32x4*)(O + (size_t)row * ldc + col) = pack8(v0, v1); } }
    }
};
struct EpiTile {
    static constexpr bool PERM = true, AFTER_DRAIN = false;
    bf16_t* O; int ldc;
    __device__ __forceinline__ void operator()(const f32x4 (&acc)[2][2][4][2], const Unit&, int wr, int wc, int fr, int fq) const {
#pragma unroll
        for (int ai = 0; ai < 2; ++ai)
#pragma unroll
            for (int m = 0; m < 4; ++m) { const int row = ai * 128 + wr * 64 + m * 16 + fr;
#pragma unroll
                for (int bj = 0; bj < 2; ++bj) { const int col = bj * 128 + wc * 32 + 8 * fq; *(u32x4*)(O + (size_t)row * ldc + col) = pack8(acc[ai][bj][m][0], acc[ai][bj][m][1]); } }
    }
};
struct EpiSoftmaxP {
    static constexpr bool PERM = true, AFTER_DRAIN = true;
    bf16_t* P;
    __device__ __forceinline__ void fused(f32x4 (&acc)[2][2][4][2], const Unit&, int wr, int wc, int fr, int fq, PG8_LAS unsigned char* lds, int, int) const {
        PG8_LAS float* MX = (PG8_LAS float*)lds; PG8_LAS float* SM = (PG8_LAS float*)(lds + 4096);
#ifdef SOFTMAX_TRIVIAL
        if (fq == 0) MX[fr] = acc[0][0][0][0][0]; return;
#endif
#pragma unroll
        for (int ai = 0; ai < 2; ++ai)
#pragma unroll
            for (int m = 0; m < 4; ++m) { float mx = -INFINITY;
#pragma unroll
                for (int bj = 0; bj < 2; ++bj)
#pragma unroll
                    for (int n = 0; n < 2; ++n) { const f32x4 x = acc[ai][bj][m][n]; mx = __builtin_fmaxf(mx, __builtin_fmaxf(__builtin_fmaxf(x[0], x[1]), __builtin_fmaxf(x[2], x[3]))); }
                mx = __builtin_fmaxf(mx, xshfl(mx, 16, fr + 16 * fq)); mx = __builtin_fmaxf(mx, xshfl(mx, 32, fr + 16 * fq));
                if (fq == 0) MX[(ai * 128 + wr * 64 + m * 16 + fr) * 4 + wc] = mx; }
        asm volatile("s_waitcnt lgkmcnt(0)" ::: "memory"); __builtin_amdgcn_s_barrier(); asm volatile("" ::: "memory");
#pragma unroll
        for (int ai = 0; ai < 2; ++ai)
#pragma unroll
            for (int m = 0; m < 4; ++m) { const int r = ai * 128 + wr * 64 + m * 16 + fr; const f32x4 mv = *(const PG8_LAS f32x4*)(MX + r * 4);
                const float rm = __builtin_fmaxf(__builtin_fmaxf(mv[0], mv[1]), __builtin_fmaxf(mv[2], mv[3])); float s = 0.f;
#pragma unroll
                for (int bj = 0; bj < 2; ++bj)
#pragma unroll
                    for (int n = 0; n < 2; ++n) { f32x4 x = acc[ai][bj][m][n]; x[0] = __builtin_amdgcn_exp2f(x[0] - rm); x[1] = __builtin_amdgcn_exp2f(x[1] - rm); x[2] = __builtin_amdgcn_exp2f(x[2] - rm); x[3] = __builtin_amdgcn_exp2f(x[3] - rm);
                        s += (x[0] + x[1]) + (x[2] + x[3]); acc[ai][bj][m][n] = x; }
                s += xshfl(s, 16, fr + 16 * fq); s += xshfl(s, 32, fr + 16 * fq);
                if (fq == 0) SM[r * 4 + wc] = s; }
        asm volatile("s_waitcnt lgkmcnt(0)" ::: "memory"); __builtin_amdgcn_s_barrier(); asm volatile("" ::: "memory");
#pragma unroll
        for (int ai = 0; ai < 2; ++ai)
#pragma unroll
            for (int m = 0; m < 4; ++m) { const int r = ai * 128 + wr * 64 + m * 16 + fr; const f32x4 sv = *(const PG8_LAS f32x4*)(SM + r * 4);
                const float inv = 1.0f / ((sv[0] + sv[1]) + (sv[2] + sv[3]));
#pragma unroll
                for (int bj = 0; bj < 2; ++bj) { const int col = bj * 128 + wc * 32 + 8 * fq; *(u32x4*)(P + (size_t)r * 256 + col) = pack8(acc[ai][bj][m][0] * inv, acc[ai][bj][m][1] * inv); } }
    }
};
struct OneUnitAt {
    int pm, pn;
    __device__ __forceinline__ bool next(int i, Unit& u) const { if (i) return false; u.pm = pm; u.pn = pn; return true; }
    __device__ __forceinline__ void a_ready(const Unit&) const {}
    __device__ __forceinline__ void done(const Unit&) const {}
};
struct OneUnit {
    __device__ __forceinline__ bool next(int i, Unit& u) const { if (i) return false; u.pm = 0; u.pn = 0; return true; }
    __device__ __forceinline__ void a_ready(const Unit&) const {}
    __device__ __forceinline__ void done(const Unit&) const {}
};
struct SchedP1 {
    StaticOrder S1; int G, c;
    __device__ __forceinline__ void init(int G_, int c_) { S1.init(65 * 256, 2048, G_, c_); G = G_; c = c_; }
    __device__ __forceinline__ bool next(int i, Unit& u) const { if (S1.next(i, u)) return true; const long L = (long)i * G + c - 520; if (L < 0 || L >= 64) return false; u.pm = 65 + (int)(L & 7); u.pn = 8 + (int)(L >> 3); return true; }
    __device__ __forceinline__ void a_ready(const Unit&) const {}
    __device__ __forceinline__ void done(const Unit&) const {}
};

template <class Epi, class Sched, bool ALIGN_EPI = false, bool SP2 = false>
__device__ __forceinline__ void gemm_phase(PG8_LAS unsigned char* lds, const Gemm g, const Sched& S, const Epi& E, const int wid_in) {
    int lane_ = __builtin_amdgcn_mbcnt_hi(~0u, __builtin_amdgcn_mbcnt_lo(~0u, 0u)); asm volatile("" : "+v"(lane_));
    int wid_ = wid_in; asm volatile("" : "+s"(wid_));
    const int wid = wid_, lane = lane_, tid = wid * 64 + lane, wr = wid >> 2, wc = wid & 3, fr = lane & 15, fq = lane >> 4;
    const int K = g.K, nt = K / BK;
    unsigned voffA[2], voffB[2];
#pragma unroll
    for (int i = 0; i < 2; ++i) { int R, C; stage_rc(tid * 16 + i * 8192, R, C); const int Rb = Epi::PERM ? ((R & ~31) + perm32(R & 31)) : R;
        voffA[i] = (unsigned)(R * g.lda + C) * 2u; voffB[i] = (unsigned)(Rb * g.ldb + C) * 2u; }
    const size_t kstep = (size_t)(BK * 2);
    const size_t hstepA = (size_t)HALF * g.lda * 2, hstepB = (size_t)HALF * g.ldb * 2;
    const size_t tstepA = 2 * hstepA, tstepB = 2 * hstepB;
    const unsigned ldsw = (unsigned)wid * 1024u;
    const int aoff = lds_byte(wr * 64 + fr, fq * 8), boff = lds_byte(wc * 32 + fr, fq * 8);
#define PG8_SA(b, h) (((b) * 2 + (h)) * HTB)
#define PG8_SB(b, h) ((4 + (b) * 2 + (h)) * HTB)
#define PG8_STAGE(bufoff, gbase, voff) do { _Pragma("unroll") for (int _i = 0; _i < 2; ++_i) \
        __builtin_amdgcn_global_load_lds((const unsigned*)((const char*)(gbase) + (voff)[_i]), (PG8_LAS unsigned*)(lds + (bufoff) + ldsw + _i * 8192), 16, 0, 0); } while (0)
#define PG8_LDA(dst, b, h) do { _Pragma("unroll") for (int m = 0; m < 4; ++m) _Pragma("unroll") for (int k = 0; k < 2; ++k) dst[m][k] = *(const PG8_LAS bf16x8*)(lds + PG8_SA(b, h) + aoff + m * 2048 + k * 1024); } while (0)
#define PG8_LDB(dst, b, h) do { _Pragma("unroll") for (int n = 0; n < 2; ++n) _Pragma("unroll") for (int k = 0; k < 2; ++k) dst[n][k] = *(const PG8_LAS bf16x8*)(lds + PG8_SB(b, h) + boff + n * 2048 + k * 1024); } while (0)
#define PG8_MMA(ai, bj, At, Bt) do { __builtin_amdgcn_s_setprio(1); _Pragma("unroll") for (int m = 0; m < 4; ++m) _Pragma("unroll") for (int n = 0; n < 2; ++n) _Pragma("unroll") for (int k = 0; k < 2; ++k) \
        acc[ai][bj][m][n] = __builtin_amdgcn_mfma_f32_16x16x32_bf16(Bt[n][k], At[m][k], acc[ai][bj][m][n], 0, 0, 0); __builtin_amdgcn_s_setprio(0); } while (0)
#define PG8_WAIT_V(n) asm volatile("s_waitcnt vmcnt(" #n ")" ::: "memory")
#define PG8_WAIT_L(n) asm volatile("s_waitcnt lgkmcnt(" #n ")" ::: "memory")
#define PG8_BAR __builtin_amdgcn_s_barrier()
#define PG8_SCHED __builtin_amdgcn_sched_barrier(0)
    Unit cur, nxt; int ui = 0;
    if (!S.next(0, cur)) return;
    f32x4 acc[2][2][4][2];
#pragma unroll
    for (int a = 0; a < 2; ++a)
#pragma unroll
        for (int b = 0; b < 2; ++b)
#pragma unroll
            for (int m = 0; m < 4; ++m)
#pragma unroll
                for (int n = 0; n < 2; ++n) acc[a][b][m][n] = (f32x4){0.f, 0.f, 0.f, 0.f};
    bf16x8 At[4][2], B0[2][2], B1[2][2];
    const char* cA = (const char*)g.A + (size_t)cur.pm * tstepA; const char* cB = (const char*)g.Bt + (size_t)cur.pn * tstepB;
    S.a_ready(cur);
    if constexpr (SP2) {
        PG8_STAGE(PG8_SB(0, 0), cB, voffB); PG8_STAGE(PG8_SB(0, 1), cB + hstepB, voffB); PG8_STAGE(PG8_SA(0, 0), cA, voffA); PG8_STAGE(PG8_SA(0, 1), cA + hstepA, voffA);
        if (wr == 1) PG8_BAR;
        PG8_WAIT_V(2); PG8_BAR;
        PG8_STAGE(PG8_SB(1, 0), cB + kstep, voffB); PG8_STAGE(PG8_SA(1, 0), cA + kstep, voffA); PG8_STAGE(PG8_SB(1, 1), cB + hstepB + kstep, voffB);
        PG8_WAIT_V(6); PG8_BAR;
    } else {
        PG8_STAGE(PG8_SB(0, 0), cB, voffB); PG8_STAGE(PG8_SA(0, 0), cA, voffA); PG8_STAGE(PG8_SB(0, 1), cB + hstepB, voffB); PG8_STAGE(PG8_SA(0, 1), cA + hstepA, voffA);
        if (wr == 1) PG8_BAR;
        PG8_WAIT_V(4); PG8_BAR;
        PG8_STAGE(PG8_SB(1, 0), cB + kstep, voffB); PG8_STAGE(PG8_SA(1, 0), cA + kstep, voffA); PG8_STAGE(PG8_SB(1, 1), cB + hstepB + kstep, voffB);
        PG8_WAIT_V(6); PG8_BAR;
    }
    for (;;) {
        const bool has_next = S.next(ui + 1, nxt);
        const char* nA = has_next ? (const char*)g.A + (size_t)nxt.pm * tstepA : cA; const char* nB = has_next ? (const char*)g.Bt + (size_t)nxt.pn * tstepB : cB;
        for (int t = 0; t < nt; t += 2) {
            const bool last = (t == nt - 2);
            const char* a1 = cA + (size_t)(t + 1) * kstep;
            const char* a2 = last ? nA : cA + (size_t)(t + 2) * kstep; const char* b2 = last ? nB : cB + (size_t)(t + 2) * kstep;
            const char* a3 = a2 + kstep; const char* b3 = b2 + kstep;
            if (last && has_next) S.a_ready(nxt);
            if constexpr (SP2) {
            PG8_LDB(B0, 0, 0); PG8_LDB(B1, 0, 1); PG8_SCHED; PG8_LDA(At, 0, 0); PG8_STAGE(PG8_SA(1, 1), a1 + hstepA, voffA);
            PG8_WAIT_V(8); PG8_WAIT_L(0); PG8_BAR; PG8_MMA(0, 0, At, B0); PG8_MMA(0, 1, At, B1); PG8_BAR; PG8_SCHED;
            PG8_LDA(At, 0, 1); PG8_STAGE(PG8_SB(0, 0), b2, voffB); PG8_STAGE(PG8_SB(0, 1), b2 + hstepB, voffB); PG8_STAGE(PG8_SA(0, 0), a2, voffA);
            PG8_WAIT_V(8); PG8_WAIT_L(0); PG8_BAR; PG8_MMA(1, 0, At, B0); PG8_MMA(1, 1, At, B1); PG8_BAR; PG8_SCHED;
            PG8_LDB(B0, 1, 0); PG8_LDB(B1, 1, 1); PG8_SCHED; PG8_LDA(At, 1, 0); PG8_STAGE(PG8_SA(0, 1), a2 + hstepA, voffA);
            PG8_WAIT_V(8); PG8_WAIT_L(0); PG8_BAR; PG8_MMA(0, 0, At, B0); PG8_MMA(0, 1, At, B1); PG8_BAR; PG8_SCHED;
            PG8_LDA(At, 1, 1); PG8_STAGE(PG8_SB(1, 0), b3, voffB); PG8_STAGE(PG8_SB(1, 1), b3 + hstepB, voffB); PG8_STAGE(PG8_SA(1, 0), a3, voffA);
            PG8_WAIT_V(8); PG8_WAIT_L(0); PG8_BAR; PG8_MMA(1, 0, At, B0); PG8_MMA(1, 1, At, B1); PG8_BAR; PG8_SCHED;
            } else {
            PG8_LDB(B0, 0, 0); PG8_SCHED; PG8_LDA(At, 0, 0); PG8_STAGE(PG8_SA(1, 1), a1 + hstepA, voffA);
            PG8_WAIT_L(8); PG8_BAR; PG8_WAIT_L(0); PG8_MMA(0, 0, At, B0); PG8_BAR; PG8_SCHED;
            PG8_LDB(B1, 0, 1); PG8_STAGE(PG8_SB(0, 0), b2, voffB);
            PG8_BAR; PG8_WAIT_L(0); PG8_MMA(0, 1, At, B1); PG8_BAR;
            PG8_LDA(At, 0, 1); PG8_STAGE(PG8_SA(0, 0), a2, voffA);
            PG8_BAR; PG8_WAIT_L(0); PG8_MMA(1, 0, At, B0); PG8_BAR; PG8_SCHED;
            PG8_STAGE(PG8_SB(0, 1), b2 + hstepB, voffB);
            PG8_WAIT_V(6); PG8_BAR; PG8_MMA(1, 1, At, B1); PG8_BAR;
            PG8_LDB(B0, 1, 0); PG8_SCHED; PG8_LDA(At, 1, 0); PG8_STAGE(PG8_SA(0, 1), a2 + hstepA, voffA);
            PG8_WAIT_L(8); PG8_BAR; PG8_WAIT_L(0); PG8_MMA(0, 0, At, B0); PG8_BAR; PG8_SCHED;
            PG8_LDB(B1, 1, 1); PG8_STAGE(PG8_SB(1, 0), b3, voffB);
            PG8_BAR; PG8_WAIT_L(0); PG8_MMA(0, 1, At, B1); PG8_BAR;
            PG8_LDA(At, 1, 1); PG8_STAGE(PG8_SA(1, 0), a3, voffA);
            PG8_BAR; PG8_WAIT_L(0); PG8_MMA(1, 0, At, B0); PG8_BAR; PG8_SCHED;
            PG8_STAGE(PG8_SB(1, 1), b3 + hstepB, voffB);
            PG8_WAIT_V(6); PG8_BAR; PG8_MMA(1, 1, At, B1); PG8_BAR;
            }
        }
        if constexpr (ALIGN_EPI) { if (wr == 0) PG8_BAR; }
        if constexpr (!Epi::AFTER_DRAIN) { E(acc, cur, wr, wc, fr, fq); S.done(cur); }
        if (!has_next) break;
#pragma unroll
        for (int a = 0; a < 2; ++a)
#pragma unroll
            for (int b = 0; b < 2; ++b)
#pragma unroll
                for (int m = 0; m < 4; ++m)
#pragma unroll
                    for (int n = 0; n < 2; ++n) acc[a][b][m][n] = (f32x4){0.f, 0.f, 0.f, 0.f};
        cur = nxt; cA = nA; cB = nB; ++ui;
        if constexpr (ALIGN_EPI) { if (wr == 1) PG8_BAR; }
    }
    PG8_WAIT_V(0);
    if constexpr (!ALIGN_EPI) { if (wr == 0) PG8_BAR; }
    PG8_BAR;
    if constexpr (Epi::AFTER_DRAIN) { E.fused(acc, cur, wr, wc, fr, fq, lds, wid, lane); S.done(cur); }
#undef PG8_SA
#undef PG8_SB
#undef PG8_STAGE
#undef PG8_LDA
#undef PG8_LDB
#undef PG8_MMA
#undef PG8_WAIT_V
#undef PG8_WAIT_L
#undef PG8_BAR
#undef PG8_SCHED
}
}

#include <hip/hip_bf16.h>
namespace attn_body {
using bf16=__hip_bfloat16;
using bf16x8=__attribute__((ext_vector_type(8)))short;
using s16x4=__attribute__((ext_vector_type(4)))short;
using f32x16=__attribute__((ext_vector_type(16)))float;
using u32x4=__attribute__((ext_vector_type(4)))unsigned;
constexpr int BATCH=8,NHEAD=8,SEQ=2048,D=64,DM=NHEAD*D;
constexpr int NW=8,QBLK=32,QB=QBLK*NW,KVBLK=64,NQB=SEQ/QB;
constexpr int ATTN_PITCH=DM, ATTN_UNIT_ROWS=QB;
__device__ __forceinline__ int crow(int r,int hi){return (r&3)+8*(r>>2)+4*hi;}
#define SBAR() __builtin_amdgcn_sched_barrier(0)
__device__ __forceinline__ void cmask(f32x16&p0,f32x16&p1,int jb,int qrel,int hi){
  const float NEG=-INFINITY; int kb=64*jb+4*hi;
  #pragma unroll
  for(int r=0;r<16;++r){int kv=kb+(r&3)+8*(r>>2); if(kv>qrel)p0[r]=NEG; if(kv+32>qrel)p1[r]=NEG;}
}

constexpr int NSLOT=3, SLOTB=8192;
constexpr int LDS_K=0, LDS_V=NSLOT*SLOTB, LDS_WS=2*NSLOT*SLOTB, LDS_OST=LDS_WS+NW*64*4, LDS_BYTES=LDS_OST+NW*4096;
constexpr float C2=0.125f*1.4426950408889634f;
__device__ __forceinline__ void glds16(const void*gsrc,unsigned lds_dst){unsigned keep;
  asm volatile("s_mov_b32 %0, m0\n\ts_mov_b32 m0, %2\n\ts_nop 0\n\tglobal_load_lds_dwordx4 %1, off\n\ts_mov_b32 m0, %0":"=&s"(keep):"v"(gsrc),"s"(lds_dst):"memory");}
__device__ __forceinline__ float max3f(float a,float b,float c){float r;asm("v_max3_f32 %0, %1, %2, %3":"=v"(r):"v"(a),"v"(b),"v"(c));return r;}
__device__ __forceinline__ float max2f(float a,float b){float r;asm("v_max_f32_e32 %0, %1, %2":"=v"(r):"v"(a),"v"(b));return r;}
__device__ __forceinline__ float fadd_s(float a,float b){float r;asm("v_add_f32_e32 %0, %1, %2":"=v"(r):"v"(a),"v"(b));return r;}
__device__ __forceinline__ float fsub_s(float a,float b){float r;asm("v_sub_f32_e32 %0, %1, %2":"=v"(r):"v"(a),"v"(b));return r;}
typedef float f32x2_t __attribute__((ext_vector_type(2))); typedef __bf16 bf16x2_t __attribute__((ext_vector_type(2)));
__device__ __forceinline__ unsigned cvtpk_s(float lo,float hi){f32x2_t v={lo,hi};bf16x2_t b=__builtin_convertvector(v,bf16x2_t);return __builtin_bit_cast(unsigned,b);}
#define WAIT_BAR(N) asm volatile("s_waitcnt vmcnt(" #N ") lgkmcnt(0)\n\ts_barrier":::"memory")

__device__ __forceinline__ void qkt(f32x16&p0,f32x16&p1,const char*Kslot,const bf16x8*qr,const f32x16&negm,int r32,int hi){
  const char*kb=Kslot+hi*1024+r32*16;
  #pragma unroll
  for(int d0=0;d0<4;++d0){
    const bf16x8 b0=*reinterpret_cast<const bf16x8*>(kb+d0*2048);
    const bf16x8 b1=*reinterpret_cast<const bf16x8*>(kb+d0*2048+512);
    if(d0==0){p0=__builtin_amdgcn_mfma_f32_32x32x16_bf16(b0,qr[0],negm,0,0,0);p1=__builtin_amdgcn_mfma_f32_32x32x16_bf16(b1,qr[0],negm,0,0,0);}
    else{p0=__builtin_amdgcn_mfma_f32_32x32x16_bf16(b0,qr[d0],p0,0,0,0);p1=__builtin_amdgcn_mfma_f32_32x32x16_bf16(b1,qr[d0],p1,0,0,0);}}
}
typedef __attribute__((address_space(3))) const char* lds_cptr;
typedef short v4i16_t __attribute__((ext_vector_type(4)));
__device__ __forceinline__ void kload8(bf16x8*kf,lds_cptr kp){
  kf[0]=*(const __attribute__((address_space(3))) bf16x8*)(kp);      kf[1]=*(const __attribute__((address_space(3))) bf16x8*)(kp+512);
  kf[2]=*(const __attribute__((address_space(3))) bf16x8*)(kp+2048); kf[3]=*(const __attribute__((address_space(3))) bf16x8*)(kp+2560);
  kf[4]=*(const __attribute__((address_space(3))) bf16x8*)(kp+4096); kf[5]=*(const __attribute__((address_space(3))) bf16x8*)(kp+4608);
  kf[6]=*(const __attribute__((address_space(3))) bf16x8*)(kp+6144); kf[7]=*(const __attribute__((address_space(3))) bf16x8*)(kp+6656);
}
__device__ __forceinline__ void kload2(bf16x8*kf,lds_cptr kp,int j){ kf[2*j]=*(const __attribute__((address_space(3))) bf16x8*)(kp+j*2048); kf[2*j+1]=*(const __attribute__((address_space(3))) bf16x8*)(kp+j*2048+512); }
__device__ __forceinline__ s16x4 vtr(lds_cptr p){ return __builtin_bit_cast(s16x4,__builtin_amdgcn_ds_read_tr16_b64_v4i16((__attribute__((address_space(3))) v4i16_t*)p)); }
__device__ __forceinline__ float rowmax(const f32x16&p0,const f32x16&p1){
  float a=max3f(p0[0],p0[1],p1[0]),b=max3f(p0[2],p0[3],p1[1]);a=max3f(a,p1[2],p1[3]);
  #pragma unroll
  for(int r=4;r<16;r+=4){a=max3f(a,p0[r],p0[r+1]);b=max3f(b,p0[r+2],p0[r+3]);a=max3f(a,p1[r],p1[r+1]);b=max3f(b,p1[r+2],p1[r+3]);}
  const float m=max2f(a,b);
  auto rr=__builtin_amdgcn_permlane32_swap(__float_as_uint(m),__float_as_uint(m),false,false);
  return max2f(__uint_as_float(rr[0]),__uint_as_float(rr[1]));
}
__device__ __forceinline__ void pv(f32x16*o,int vb,bf16x8 pa0,bf16x8 pa1,bf16x8 pa2,bf16x8 pa3){
  #pragma unroll
  for(int d0=0;d0<2;++d0){s16x4 lo[4],hi[4];
    #pragma unroll
    for(int ks=0;ks<4;++ks){
      asm volatile("ds_read_b64_tr_b16 %0,%1 offset:%c2":"=&v"(lo[ks]):"v"(vb),"i"(d0*4096+ks*1024):"memory");
      asm volatile("ds_read_b64_tr_b16 %0,%1 offset:%c2":"=&v"(hi[ks]):"v"(vb),"i"(d0*4096+ks*1024+512):"memory");}
    asm volatile("s_waitcnt lgkmcnt(0)":::"memory");SBAR();
    #define PK(k) (bf16x8){lo[k][0],lo[k][1],lo[k][2],lo[k][3],hi[k][0],hi[k][1],hi[k][2],hi[k][3]}
    o[d0]=__builtin_amdgcn_mfma_f32_32x32x16_bf16(pa0,PK(0),o[d0],0,0,0);
    o[d0]=__builtin_amdgcn_mfma_f32_32x32x16_bf16(pa1,PK(1),o[d0],0,0,0);
    o[d0]=__builtin_amdgcn_mfma_f32_32x32x16_bf16(pa2,PK(2),o[d0],0,0,0);
    o[d0]=__builtin_amdgcn_mfma_f32_32x32x16_bf16(pa3,PK(3),o[d0],0,0,0);
    #undef PK
  }
}

#ifndef ATTN_STORE16
#define ATTN_STORE16(p,v) (*(u32x4*)(p)=(v))
#endif
template<int THRL> __device__ __forceinline__ void attn_unit(int b,int h,int qb,const bf16*Q,const bf16*__restrict__ K,const bf16*__restrict__ V,bf16*O,int opitch,const float*__restrict__ KS,char*shm,const int wid){
  int lane_=__builtin_amdgcn_mbcnt_hi(~0u,__builtin_amdgcn_mbcnt_lo(~0u,0u)); asm volatile("":"+v"(lane_)); const int lane=lane_,r32=lane&31,hi=lane>>5;
  const long rowbase=(long)b*SEQ; const int q0=qb*QB;
  const bf16*Qw=Q+(rowbase+q0+wid*QBLK)*DM+h*D;
  const bf16*Kh=K+rowbase*DM+h*D,*Vh=V+rowbase*DM+h*D;
  const unsigned lds0=(unsigned)(uintptr_t)shm;
  float*wsf=(float*)(shm+LDS_WS)+wid*64;
  const bf16*ksrc=Kh+(long)lane*DM+wid*8;
  const bf16*vsrc=Vh+(long)(16*(wid&3)+(lane>>2))*DM+(wid>>2)*32+(lane&3)*8;
  const unsigned kdst=lds0+LDS_K+wid*1024, vdst=lds0+LDS_V+wid*1024;
  #define DMA_K(t,slot) glds16(ksrc+(long)(t)*KVBLK*DM,(unsigned)__builtin_amdgcn_readfirstlane(kdst+(slot)))
  #define DMA_V(t,slot) glds16(vsrc+(long)(t)*KVBLK*DM,(unsigned)__builtin_amdgcn_readfirstlane(vdst+(slot)))
  const int vb0=(int)(lds0+LDS_V)+((lane>>4)&1)*32+(lane&3)*8+(4*hi+((lane&15)>>2))*64;
  const char*Kbase=shm+LDS_K; bf16x8 kf[8];
  const lds_cptr shm3=(lds_cptr)shm; const lds_cptr kp0=shm3+LDS_K+hi*1024+r32*16; const lds_cptr vp0=shm3+LDS_V+((lane>>4)&1)*32+(lane&3)*8+(4*hi+((lane&15)>>2))*64;
  const int NT=(q0+QB)/KVBLK;
  DMA_K(0,0);DMA_V(0,0);DMA_K(1,SLOTB);
  bf16x8 qr[4];
  #pragma unroll
  for(int d0=0;d0<4;++d0)qr[d0]=*reinterpret_cast<const bf16x8*>(&Qw[(long)r32*DM+d0*16+hi*8]);
  unsigned selmask=(1u<<qb)-1u;
  if(qb>3){
    float sc[7];
    #pragma unroll
    for(int n=0;n<7;++n){ sc[n]=-INFINITY;
      if(n<qb){ const float*kp=KS+((long)(b*8+n)*DM+h*D+hi*8); float a=0.f;
        #pragma unroll
        for(int d0=0;d0<4;++d0){ const float4 k0=*reinterpret_cast<const float4*>(kp+d0*16),k1=*reinterpret_cast<const float4*>(kp+d0*16+4);
          #define QF(j) __uint_as_float(((unsigned)(unsigned short)qr[d0][j])<<16)
          a+=QF(0)*k0.x+QF(1)*k0.y+QF(2)*k0.z+QF(3)*k0.w+QF(4)*k1.x+QF(5)*k1.y+QF(6)*k1.z+QF(7)*k1.w;
          #undef QF
        }
        { auto rr=__builtin_amdgcn_permlane32_swap(__float_as_uint(a),__float_as_uint(a),false,false); a=__uint_as_float(rr[0])+__uint_as_float(rr[1]); } sc[n]=a; }
      asm volatile("":::"memory"); }
    selmask=0u;
    #pragma unroll
    for(int n=0;n<7;++n){ int rk=0;
      #pragma unroll
      for(int m2=0;m2<7;++m2){ if(m2!=n) rk+=(sc[m2]>sc[n]||(sc[m2]==sc[n]&&m2<n))?1:0; }
      if(n<qb&&rk<3)selmask|=(1u<<n); }
  }
  float mhat=0.f,l_reg=0.f;f32x16 o[2];o[0]=f32x16{};o[1]=f32x16{};const f32x16 negm=f32x16{};
  const int qrel=wid*QBLK+r32;
  #define CMASK(P0,P1,t) do{const int t_=(t); const int jb_=t_-(NT-4); if(jb_>=0)cmask(P0,P1,jb_,qrel,hi); else if(!((selmask>>(t_>>2))&1u)){ _Pragma("unroll") for(int r_=0;r_<16;++r_){P0[r_]=-INFINITY;P1[r_]=-INFINITY;} } }while(0)
  bool resc=false;
  #define START(P0,P1) do{ const float rm=rowmax(P0,P1); resc=false; \
    { const float dl=__builtin_fmaxf(rm,-100.f); mhat=fadd_s(mhat,dl); \
      _Pragma("unroll") for(int r=0;r<16;++r){P0[r]=fsub_s(P0[r],dl);P1[r]=fsub_s(P1[r],dl);} \
      } \
    _Pragma("unroll") for(int r=0;r<16;++r)P0[r]=__builtin_amdgcn_exp2f(P0[r]); }while(0)
  #define RESC() do{ if(resc){ asm volatile("s_waitcnt lgkmcnt(0)":::"memory"); \
      _Pragma("unroll") for(int d_=0;d_<2;++d_) _Pragma("unroll") for(int r=0;r<16;++r)o[d_][r]*=wsf[crow(r,hi)]; } }while(0)
  f32x16 pA0,pA1,pB0,pB1;
  int sl_prev=0,sl_cur=0,sl_next=SLOTB;
  #define ROT() do{sl_prev=sl_cur;sl_cur=sl_next;sl_next=(sl_next==(NSLOT-1)*SLOTB)?0:sl_next+SLOTB;}while(0)
  DMA_K(2,2*SLOTB);
  WAIT_BAR(3);
  qkt(pA0,pA1,Kbase,qr,negm,r32,hi);asm volatile("s_nop 15\n\ts_nop 7":"+v"(pA0),"+v"(pA1));CMASK(pA0,pA1,0);
  START(pA0,pA1);
  _Pragma("unroll") for(int r=0;r<16;++r)pA1[r]=__builtin_amdgcn_exp2f(pA1[r]);
  WAIT_BAR(0);
  DMA_K(3,0);DMA_V(1,SLOTB);
  ROT();
  kload8(kf,kp0+sl_cur);
  WAIT_BAR(2);
  s16x4 vlo[8],vhi[8]; u32x4 pw0,pw1,pw2,pw3;
  #define PKW(P,B) cvtpk_s(P[B],P[B+1])
  #define PAF(k) __builtin_bit_cast(bf16x8,pw##k)
  #define VFR(i) (bf16x8){vlo[i][0],vlo[i][1],vlo[i][2],vlo[i][3],vhi[i][0],vhi[i][1],vhi[i][2],vhi[i][3]}
  #define PIN(x) asm volatile("":"+v"(x))
  #define MX3(a,b,c) __builtin_fmaxf(__builtin_fmaxf((a),(b)),(c))
  #define GAPA(MF,A0,A1,A2,A3,W0,W1,PW) do{ MF; sacc+=A0; sacc+=A1; sacc+=A2; sacc+=A3; PIN(sacc); W0; W1; PIN(PW); SBAR(); }while(0)
  #define EX(v) __builtin_amdgcn_exp2f(v)
  #define GAPB(MF,X,B) do{ MF; X[B]=EX(X[B]); X[B+1]=EX(X[B+1]); X[B+2]=EX(X[B+2]); X[B+3]=EX(X[B+3]); PIN(X); SBAR(); }while(0)
  #define VRD(i) do{ vlo[i]=vtr(vp_+(((i)>>2)*4096+((i)&3)*1024)); vhi[i]=vtr(vp_+(((i)>>2)*4096+((i)&3)*1024+512)); }while(0)
  #define KRD(G,j) do{ if(G){ kload2(kf,kp0+sl_next,j); SBAR(); } }while(0)
  #define STEP(C0,C1,P0,P1,t,GK,GV,GL) do{ SBAR(); \
    const lds_cptr vp_=vp0+sl_prev; \
    VRD(0); SBAR(); float sacc=(P0[0]+P0[1]); \
    GAPA(C0=__builtin_amdgcn_mfma_f32_32x32x16_bf16(kf[0],qr[0],negm,0,0,0), P0[2],P0[3],P0[4],P0[5],     pw0[0]=PKW(P0,0), pw0[1]=PKW(P0,2), pw0); \
    VRD(4); SBAR(); GAPA(C1=__builtin_amdgcn_mfma_f32_32x32x16_bf16(kf[1],qr[0],negm,0,0,0), P0[6],P0[7],P0[8],P0[9],     pw0[2]=PKW(P0,4), pw0[3]=PKW(P0,6), pw0); \
    VRD(1); SBAR(); GAPA(C0=__builtin_amdgcn_mfma_f32_32x32x16_bf16(kf[2],qr[1],C0,0,0,0),   P0[10],P0[11],P0[12],P0[13], pw1[0]=PKW(P0,8), pw1[1]=PKW(P0,10), pw1); \
    VRD(5); SBAR(); GAPA(C1=__builtin_amdgcn_mfma_f32_32x32x16_bf16(kf[3],qr[1],C1,0,0,0),   P0[14],P0[15],P1[0],P1[1],   pw1[2]=PKW(P0,12),pw1[3]=PKW(P0,14), pw1); \
    VRD(2); SBAR(); GAPA(C0=__builtin_amdgcn_mfma_f32_32x32x16_bf16(kf[4],qr[2],C0,0,0,0),   P1[2],P1[3],P1[4],P1[5],     pw2[0]=PKW(P1,0), pw2[1]=PKW(P1,2), pw2); \
    VRD(6); SBAR(); GAPA(C1=__builtin_amdgcn_mfma_f32_32x32x16_bf16(kf[5],qr[2],C1,0,0,0),   P1[6],P1[7],P1[8],P1[9],     pw2[2]=PKW(P1,4), pw2[3]=PKW(P1,6), pw2); \
    VRD(3); SBAR(); GAPA(C0=__builtin_amdgcn_mfma_f32_32x32x16_bf16(kf[6],qr[3],C0,0,0,0),   P1[10],P1[11],P1[12],P1[13], pw3[0]=PKW(P1,8), pw3[1]=PKW(P1,10), pw3); \
    VRD(7); SBAR(); GAPA(C1=__builtin_amdgcn_mfma_f32_32x32x16_bf16(kf[7],qr[3],C1,0,0,0),   P1[14],P1[15],0.f,0.f,       pw3[2]=PKW(P1,12),pw3[3]=PKW(P1,14), pw3); \
    l_reg+=sacc; \
    if(GK){DMA_K((t)+3,sl_cur);} if(GV){DMA_V((t)+1,sl_next);} \
    _Pragma("unroll") for(int r=0;r<16;++r){C0[r]-=mhat;C1[r]-=mhat;} \
    CMASK(C0,C1,t); \
    { float a=MX3(C0[0],C0[1],C1[0]),b=MX3(C0[2],C0[3],C1[1]); a=MX3(a,C1[2],C1[3]); \
      _Pragma("unroll") for(int r=4;r<16;r+=4){a=MX3(a,C0[r],C0[r+1]);b=MX3(b,C0[r+2],C0[r+3]);a=MX3(a,C1[r],C1[r+1]);b=MX3(b,C1[r+2],C1[r+3]);} \
      float rm=__builtin_fmaxf(a,b); { auto rr=__builtin_amdgcn_permlane32_swap(__float_as_uint(rm),__float_as_uint(rm),false,false); rm=__builtin_fmaxf(__uint_as_float(rr[0]),__uint_as_float(rr[1])); } \
      resc=false; \
      if(__builtin_expect(__any(rm>(float)THRL),0)){ const float dl=__builtin_fmaxf(rm,0.f); mhat+=dl; \
        _Pragma("unroll") for(int r=0;r<16;++r){C0[r]-=dl;C1[r]-=dl;} \
        const float f=__builtin_amdgcn_exp2f(-dl); l_reg*=f; if(hi==0)wsf[r32]=f; resc=true; } } \
    SBAR(); \
    GAPB(o[0]=__builtin_amdgcn_mfma_f32_32x32x16_bf16(PAF(0),VFR(0),o[0],0,0,0), C0,0); \
    GAPB(o[1]=__builtin_amdgcn_mfma_f32_32x32x16_bf16(PAF(0),VFR(4),o[1],0,0,0), C0,4); \
    KRD(GL,0); GAPB(o[0]=__builtin_amdgcn_mfma_f32_32x32x16_bf16(PAF(1),VFR(1),o[0],0,0,0), C0,8); \
    KRD(GL,1); GAPB(o[1]=__builtin_amdgcn_mfma_f32_32x32x16_bf16(PAF(1),VFR(5),o[1],0,0,0), C0,12); \
    KRD(GL,2); GAPB(o[0]=__builtin_amdgcn_mfma_f32_32x32x16_bf16(PAF(2),VFR(2),o[0],0,0,0), C1,0); \
    KRD(GL,3); GAPB(o[1]=__builtin_amdgcn_mfma_f32_32x32x16_bf16(PAF(2),VFR(6),o[1],0,0,0), C1,4); \
    GAPB(o[0]=__builtin_amdgcn_mfma_f32_32x32x16_bf16(PAF(3),VFR(3),o[0],0,0,0), C1,8); \
    GAPB(o[1]=__builtin_amdgcn_mfma_f32_32x32x16_bf16(PAF(3),VFR(7),o[1],0,0,0), C1,12); \
    }while(0)
  int t=1;
  #undef CMASK
  #define CMASK(P0,P1,t) do{ if(!((selmask>>((t)>>2))&1u)){ _Pragma("unroll") for(int r_=0;r_<16;++r_){P0[r_]=-INFINITY;P1[r_]=-INFINITY;} } }while(0)
  for(;t+5<NT;t+=2){
    STEP(pB0,pB1,pA0,pA1,t,true,true,true);     WAIT_BAR(2); RESC(); ROT();
    STEP(pA0,pA1,pB0,pB1,t+1,true,true,true);   WAIT_BAR(2); RESC(); ROT();
  }
  #undef CMASK
  int qrel2=qrel,hi2=hi; asm volatile("":"+v"(qrel2),"+v"(hi2));
  #define CMASK(P0,P1,t) do{const int t_=(t); const int jb_=t_-(NT-4); if(jb_>=0)cmask(P0,P1,jb_,qrel2,hi2); else if(!((selmask>>(t_>>2))&1u)){ _Pragma("unroll") for(int r_=0;r_<16;++r_){P0[r_]=-INFINITY;P1[r_]=-INFINITY;} } }while(0)
  #define ENDW(tt) do{ if((tt)+3<NT){WAIT_BAR(2);} else if((tt)+2<NT){WAIT_BAR(1);} else {WAIT_BAR(0);} }while(0)
  for(;t+1<NT;t+=2){
    STEP(pB0,pB1,pA0,pA1,t,(t+3<NT),(t+1<NT),(t+1<NT));       ENDW(t);   RESC(); ROT();
    STEP(pA0,pA1,pB0,pB1,t+1,(t+4<NT),(t+2<NT),(t+2<NT));     ENDW(t+1); RESC(); ROT();
  }
  STEP(pB0,pB1,pA0,pA1,NT-1,false,false,false); RESC();
  { float sacc=pB0[0]+pB0[1]; _Pragma("unroll") for(int r=2;r<16;++r)sacc+=pB0[r]; _Pragma("unroll") for(int r=0;r<16;++r)sacc+=pB1[r]; l_reg+=sacc;
    pw0=(u32x4){PKW(pB0,0),PKW(pB0,2),PKW(pB0,4),PKW(pB0,6)};pw1=(u32x4){PKW(pB0,8),PKW(pB0,10),PKW(pB0,12),PKW(pB0,14)};pw2=(u32x4){PKW(pB1,0),PKW(pB1,2),PKW(pB1,4),PKW(pB1,6)};pw3=(u32x4){PKW(pB1,8),PKW(pB1,10),PKW(pB1,12),PKW(pB1,14)};
    SBAR(); pv(o,vb0+sl_cur,PAF(0),PAF(1),PAF(2),PAF(3)); }
  #undef PKW
  #undef PAF
  #undef VFR
  #undef PIN
  #undef MX3
  #undef GAPA
  #undef GAPB
  #undef EX
  #undef VRD
  #undef KRD
  #undef STEP
  #undef ENDW
  {auto rr=__builtin_amdgcn_permlane32_swap(__float_as_uint(l_reg),__float_as_uint(l_reg),false,false);l_reg=__uint_as_float(rr[0])+__uint_as_float(rr[1]);}
  if(hi==0)wsf[32+r32]=l_reg;asm volatile("s_waitcnt lgkmcnt(0)":::"memory");
  float rli[16];
  #pragma unroll
  for(int r=0;r<16;++r)rli[r]=__builtin_amdgcn_rcpf(wsf[32+crow(r,hi)]);
  bf16*Ow=O+(rowbase+q0+wid*QBLK)*(long)opitch+h*D;
  { bf16*stg=(bf16*)(shm+LDS_OST)+wid*2048;
    #pragma unroll
    for(int r=0;r<16;++r){const int orow=crow(r,hi);
      #pragma unroll
      for(int d0=0;d0<2;++d0)stg[orow*64+d0*32+r32]=__float2bfloat16(o[d0][r]*rli[r]);}
    asm volatile("s_waitcnt lgkmcnt(0)":::"memory");
    #pragma unroll
    for(int i=0;i<4;++i){const int row=i*8+(lane>>3),ch=lane&7; const u32x4 v=*(const u32x4*)(stg+row*64+ch*8); ATTN_STORE16(Ow+(long)row*opitch+ch*8,v);} }
  asm volatile("s_waitcnt lgkmcnt(0)\n\ts_barrier":::"memory");
  #undef DMA_K
  #undef DMA_V
  #undef CMASK
  #undef START
  #undef RESC
  #undef ROT
}
constexpr int ATTN_LDS_BYTES=LDS_BYTES;
struct AttnTensors { const bf16* Q; const bf16* K; const bf16* V; bf16* O; int opitch; const float* KS; };
#undef SBAR
#undef WAIT_BAR
}
constexpr int NWAVES = 8;
#ifndef MK_N_LAUNCHES
#define MK_N_LAUNCHES 1
#endif
constexpr int N_LAUNCHES = MK_N_LAUNCHES;
constexpr int PER_PHASE = 10;

constexpr int D = 1024, NBATCH = 8, SEQ = 2048, MP = NBATCH * SEQ, NS = 128, MALL = MP + 256, NPAN = MALL / 256;
constexpr int MEMR = 2048, XNROWS = MALL + MEMR;
constexpr int FF = 4096, PW = 512, AW = 512, NH = 8, HD = 64, PST = 15, NPAGES = 16, PAGE = 128;
constexpr float EPS = 1e-6f;
constexpr float CROSS_C2 = 0.0625f * 1.4426950408889634f;
constexpr size_t O_YP = 0, O_YS = O_YP + (size_t)MP * D, O_KP = O_YS + (size_t)NS * D, O_VP = O_KP + (size_t)MP * AW, O_POOLP = O_VP + (size_t)MP * AW,
                 O_MK = O_POOLP + (size_t)NBATCH * PST * PW, O_MV = O_MK + (size_t)MEMR * D, O_KS = O_MV + (size_t)MEMR * D, O_VS = O_KS + (size_t)NS * AW, O_POOLS = O_VS + (size_t)NS * AW,
                 O_END = O_POOLS + (size_t)NS * PST * PW;
static_assert(O_END == 39055360, "output size");

constexpr size_t MiB = 1u << 20;
constexpr size_t WS_CTL = 0, CTL_ZERO_BYTES = 1 * MiB;
constexpr size_t WS_WIN = 2 * MiB;
constexpr size_t WS_WOUT = 10 * MiB, WS_WCQ = 12 * MiB, WS_WCO = 14 * MiB;
constexpr size_t WS_WUP = 16 * MiB;
constexpr size_t WS_WDN = 24 * MiB;
constexpr size_t WS_WPOOL = 32 * MiB;
constexpr size_t WS_ROPE = 33 * MiB;
constexpr size_t WS_SACC = 516 * MiB;
constexpr size_t SA_PS = 0, SA_A1 = 1 * MiB, SA_AQ = SA_A1 + 512 * 1024, SA_A3 = SA_AQ + 512 * 1024, SA_AD = SA_A3 + 512 * 1024, SACC_BYTES = 3 * MiB;
constexpr size_t WS_HBS = 351 * MiB;
constexpr size_t WS_XN = 36 * MiB;
constexpr size_t WS_U = 74 * MiB, WS_Q = 91 * MiB, WS_K = 108 * MiB, WS_V = 125 * MiB;
constexpr size_t WS_MIX = 142 * MiB;
constexpr size_t WS_X1 = 176 * MiB;
constexpr size_t WS_XG = 242 * MiB;
constexpr size_t WS_QC = 276 * MiB;
constexpr size_t WS_OC = 310 * MiB;
constexpr size_t WS_MKB = 343 * MiB;
constexpr size_t WS_MVT = 347 * MiB;
constexpr size_t WS_PB = 352 * MiB;
constexpr size_t WS_HB = 384 * MiB;
constexpr size_t WS_END = 520 * MiB;
constexpr size_t WS_DUMMY = 520 * MiB;
static_assert(WS_XN + (size_t)XNROWS * D * 2 <= WS_U && WS_V + (size_t)MALL * 512 * 2 <= WS_MIX && WS_MIX + (size_t)MALL * D * 2 <= WS_X1 && WS_X1 + (size_t)MALL * D * 4 <= WS_XG &&
              WS_XG + (size_t)MALL * D * 2 <= WS_QC && WS_QC + (size_t)MALL * D * 2 <= WS_OC && WS_OC + (size_t)MALL * D * 2 <= WS_MKB && WS_MKB + 4 * MiB <= WS_MVT && WS_MVT + 4 * MiB <= WS_HBS && WS_HBS + MiB <= WS_PB && WS_HB + (size_t)MALL * FF * 2 <= WS_SACC && WS_SACC + SACC_BYTES <= WS_END, "d_ws map");
constexpr int CW_TMO = 0, CW_CODE = 1;
constexpr int CW_Q2 = 256, CW_Q5 = 512;
constexpr int CW_BAR = 4096;
constexpr int CW_KSUM = 16384;
constexpr int CW_SS1 = 49152, CW_SS2 = CW_SS1 + 16896, CW_SS3 = CW_SS2 + 16896;
constexpr int CW_SSD = CW_SS3 + 16896;
static_assert((CW_SSD + 16896) * 4 <= (int)CTL_ZERO_BYTES && CW_KSUM + 8 * 8 * 512 <= CW_SS1, "CTL words inside the memset region");

constexpr int RING_OFF = 0, RING_BYTES = 131072;
constexpr int LDSCTL_OFF = RING_BYTES, MISC_OFF = LDSCTL_OFF + 320;
constexpr int LDS_BYTES = 147456;
static_assert(MISC_OFF + 128 <= LDS_BYTES, "LDS map");

#define GAS __attribute__((address_space(1)))
#define LAS __attribute__((address_space(3)))
typedef unsigned short bf16;
typedef unsigned v4u __attribute__((ext_vector_type(4)));
typedef unsigned v2u __attribute__((ext_vector_type(2)));
typedef float f32x4 __attribute__((ext_vector_type(4)));
typedef short bf16x8 __attribute__((ext_vector_type(8)));
typedef GAS unsigned gu32;
typedef GAS unsigned long long gu64;
#define RLX_AGENT __ATOMIC_RELAXED, __HIP_MEMORY_SCOPE_AGENT
#define LDS_WAIT() asm volatile("s_waitcnt lgkmcnt(0)" ::: "memory")
#define VM_WAIT() asm volatile("s_waitcnt vmcnt(0)" ::: "memory")
__device__ __forceinline__ unsigned f2bf(float f) { unsigned u = __builtin_bit_cast(unsigned, f); return (u + 0x7fffu + ((u >> 16) & 1u)) >> 16; }
__device__ __forceinline__ unsigned pk2(float lo, float hi) { return f2bf(lo) | (f2bf(hi) << 16); }
__device__ __forceinline__ float bf2f(unsigned short b) { return __uint_as_float(((unsigned)b) << 16); }

#define XB_TMO      128
#define XB_XCNT(j)  (256  + 64 * (j))
#define XB_XSUB(j)  (1280 + 64 * (j))
#define XB_XGEN(j)  (2304 + 64 * (j))
#define XB_TOP      3328
#define XB_TOPGEN   3392
#define XCD_BAR_WORDS 3456
#define XB_SPIN_CAP (1u << 18)

__device__ __forceinline__ unsigned xb_ld(unsigned* p)              { return __hip_atomic_load(p, __ATOMIC_RELAXED, __HIP_MEMORY_SCOPE_AGENT); }
__device__ __forceinline__ unsigned xb_add(unsigned* p, unsigned v) { return __hip_atomic_fetch_add(p, v, __ATOMIC_RELAXED, __HIP_MEMORY_SCOPE_AGENT); }
__device__ __forceinline__ unsigned xb_xcc_id() { return (unsigned)__builtin_amdgcn_s_getreg((3 << 11) | 20) & 0xFu; }
#define XB_SPIN(cond, bar) do { unsigned _sp = 0; while (cond) { __builtin_amdgcn_s_sleep(1); \
    if ((++_sp & 255u) == 0u) { if (xb_ld(&(bar)[XB_TMO])) break; if (_sp > XB_SPIN_CAP) { atomicAdd(&(bar)[XB_TMO], 1u); break; } } } } while (0)

struct XcdBarrier {
    unsigned* bar; unsigned x;
    int wave;
    volatile LAS unsigned* st;
};

__device__ __forceinline__ bool xb_thread0(int wave) { return wave == 0 && __builtin_amdgcn_mbcnt_hi(~0u, __builtin_amdgcn_mbcnt_lo(~0u, 0u)) == 0u; }
__device__ __forceinline__ XcdBarrier xcd_barrier_post(unsigned* bar, volatile LAS unsigned* st, int wave) {
    XcdBarrier b; b.bar = bar; b.x = xb_xcc_id(); b.st = st; b.wave = wave;
    if (xb_thread0(wave)) (void)xb_add(&bar[XB_XCNT(b.x)], 1u);
    return b;
}
__device__ __forceinline__ void xcd_barrier_complete(unsigned* bar, unsigned x, unsigned& nloc, unsigned& nx) {
    const unsigned G = gridDim.x * gridDim.y * gridDim.z;
    unsigned sum, cnt, mine, sp = 0u;
    for (;;) {
        sum = 0u; cnt = 0u; mine = 0u;
#pragma unroll
        for (unsigned j = 0; j < 16; ++j) { const unsigned c = xb_ld(&bar[XB_XCNT(j)]); sum += c; cnt += (c > 0u) ? 1u : 0u; mine = (j == x) ? c : mine; }
        if (sum == G) break;
        __builtin_amdgcn_s_sleep(1);
        if ((++sp & 255u) == 0u) { if (xb_ld(&bar[XB_TMO])) break; if (sp > XB_SPIN_CAP) { atomicAdd(&bar[XB_TMO], 1u); break; } }
    }
    nloc = mine > 0u ? mine : 1u; nx = cnt > 0u ? cnt : 1u;
}

__device__ __forceinline__ void xcd_barrier(const XcdBarrier& b) {
    asm volatile("s_waitcnt vmcnt(0)" ::: "memory");
    __syncthreads();
    if (xb_thread0(b.wave)) {
        unsigned* bar = b.bar;
        __builtin_amdgcn_s_waitcnt(0);
        unsigned nloc = b.st[0], nx = b.st[1];
        if (nloc == 0u) { xcd_barrier_complete(bar, b.x, nloc, nx); b.st[0] = nloc; b.st[1] = nx; }
        const unsigned old = xb_add(&bar[XB_XSUB(b.x)], 1u);
        const unsigned gen = old / nloc;
        if (old + 1u == (gen + 1u) * nloc) {
            __builtin_amdgcn_fence(__ATOMIC_RELEASE, "agent");
            asm volatile("s_waitcnt vmcnt(0)" ::: "memory");
            const unsigned og = xb_add(&bar[XB_TOP], 1u);
            const unsigned tg = og / nx;
            if (og + 1u == (tg + 1u) * nx) xb_add(&bar[XB_TOPGEN], 1u);
            else XB_SPIN(xb_ld(&bar[XB_TOPGEN]) == tg, bar);
            __builtin_amdgcn_fence(__ATOMIC_ACQUIRE, "agent");
            xb_add(&bar[XB_XGEN(b.x)], 1u);
            asm volatile("s_waitcnt vmcnt(0)" ::: "memory");
        } else {
            XB_SPIN(xb_ld(&bar[XB_XGEN(b.x)]) == gen, bar);
            __builtin_amdgcn_fence(__ATOMIC_ACQUIRE, "agent");
            asm volatile("s_waitcnt vmcnt(0)" ::: "memory");
        }
    }
    __syncthreads();
}


struct Args { const void* in[24]; float* out; unsigned char* ws; int ph_lo, ph_hi; };
struct Frame {
    LAS unsigned char* lds;
    volatile LAS unsigned* MISC;
    gu32* ctl;
    int wave;
    int vcu, G;
    float* out;
    unsigned char* ws;
};
#define WSP(T, off) ((T*)(F.ws + (off)))
__device__ __forceinline__ int LANE() { return (int)__builtin_amdgcn_mbcnt_hi(~0u, __builtin_amdgcn_mbcnt_lo(~0u, 0u)); }
#define TID(F) ((F).wave * 64 + LANE())

__device__ __forceinline__ float xshfl(float v, int m, int lane) { return __builtin_bit_cast(float, __builtin_amdgcn_ds_bpermute((lane ^ m) << 2, __builtin_bit_cast(int, v))); }
__device__ __forceinline__ float wave_sum(float v, int lane) {
#pragma unroll
    for (int o = 1; o < 64; o <<= 1) v += xshfl(v, o, lane);
    return v;
}
__device__ __forceinline__ float wave_max(float v, int lane) {
#pragma unroll
    for (int o = 1; o < 64; o <<= 1) v = __builtin_fmaxf(v, xshfl(v, o, lane));
    return v;
}
__device__ __forceinline__ int win_dst_row(int n) { if (n < 512 || n >= 1536) return n; const int t = n & ~255, j = n & 255, hh = j >> 6, p = (j >> 5) & 1, i = j & 31; return t + 128 * p + 32 * hh + i; }
template <bool WINPERM> __device__ __forceinline__ void p0_transpose_item(const float* W, int K, int N, bf16* WT, int row_off, LAS float* scr, int item, int lane) {
    const int nblk = N / 32, kb = item / nblk, nb = item % nblk, k0 = 64 * kb, n0 = 32 * nb;
#pragma unroll 8
    for (int i = 0; i < 32; ++i) { const int kk = 2 * i + (lane >> 5); scr[kk * 33 + (lane & 31)] = W[(size_t)(k0 + kk) * N + n0 + (lane & 31)]; }
    LDS_WAIT(); asm volatile("" ::: "memory");
    const int c = lane & 7;
#pragma unroll
    for (int j = 0; j < 4; ++j) { const int n = (lane >> 3) + 8 * j; const LAS float* s = scr + (8 * c) * 33 + n;
        v4u o; o.x = pk2(s[0 * 33], s[1 * 33]); o.y = pk2(s[2 * 33], s[3 * 33]); o.z = pk2(s[4 * 33], s[5 * 33]); o.w = pk2(s[6 * 33], s[7 * 33]);
        const int drow = WINPERM ? win_dst_row(n0 + n) : (n0 + n);
        *(GAS v4u*)(WT + (size_t)(row_off + drow) * K + k0 + 8 * c) = o; }
    LDS_WAIT(); asm volatile("" ::: "memory");
}
__device__ __forceinline__ void rms_row_to_bf16(int lane, const float* xrow, const float* gain, bf16* orow) {
    const GAS f32x4* xr = (const GAS f32x4*)xrow + lane; const GAS f32x4* gr = (const GAS f32x4*)gain + lane;
    f32x4 v[4]; float s = 0.f;
#pragma unroll
    for (int j = 0; j < 4; ++j) { v[j] = xr[64 * j]; s += (v[j].x * v[j].x + v[j].y * v[j].y) + (v[j].z * v[j].z + v[j].w * v[j].w); }
    const float rstd = 1.f / sqrtf(wave_sum(s, lane) * (1.f / D) + EPS);
    GAS unsigned long long* o8 = (GAS unsigned long long*)orow + lane;
#pragma unroll
    for (int j = 0; j < 4; ++j) { const f32x4 g = gr[64 * j]; o8[64 * j] = (unsigned long long)pk2(v[j].x * rstd * g.x, v[j].y * rstd * g.y) | ((unsigned long long)pk2(v[j].z * rstd * g.z, v[j].w * rstd * g.w) << 32); }
}
__device__ __forceinline__ void p0_prologue(Frame& F, const Args& A) {
    LAS float* scr = (LAS float*)(F.lds + RING_OFF + F.wave * 16384);
    const int gw = F.vcu * NWAVES + F.wave, NGW = F.G * NWAVES;
    bf16* WIN = WSP(bf16, WS_WIN);
    constexpr int I_IN = (D / 64) * (2048 / 32), I_SQ = (D / 64) * (D / 32), I_UP = (D / 64) * (FF / 32), I_DN = (FF / 64) * (D / 32), I_PL = (128 / 64) * (128 / 32);
    constexpr int NITEMS = I_IN + 5 * I_SQ + I_UP + I_DN + 4 * I_PL;
    for (int it = gw; it < NITEMS; it += NGW) {
        int r = it;
        if (r < I_IN) { p0_transpose_item<true>(((const float*)A.in[10]), D, 2048, WIN, 0, scr, r, LANE()); continue; } r -= I_IN;
        if (r < I_SQ) { p0_transpose_item<false>(((const float*)A.in[17]), D, D, WIN, 2048, scr, r, LANE()); continue; } r -= I_SQ;
        if (r < I_SQ) { p0_transpose_item<false>(((const float*)A.in[18]), D, D, WIN, 3072, scr, r, LANE()); continue; } r -= I_SQ;
        if (r < I_SQ) { p0_transpose_item<false>(((const float*)A.in[13]), D, D, WSP(bf16, WS_WOUT), 0, scr, r, LANE()); continue; } r -= I_SQ;
        if (r < I_SQ) { p0_transpose_item<false>(((const float*)A.in[16]), D, D, WSP(bf16, WS_WCQ), 0, scr, r, LANE()); continue; } r -= I_SQ;
        if (r < I_SQ) { p0_transpose_item<false>(((const float*)A.in[19]), D, D, WSP(bf16, WS_WCO), 0, scr, r, LANE()); continue; } r -= I_SQ;
        if (r < I_UP) { p0_transpose_item<false>(((const float*)A.in[21]), D, FF, WSP(bf16, WS_WUP), 0, scr, r, LANE()); continue; } r -= I_UP;
        if (r < I_DN) { p0_transpose_item<false>(((const float*)A.in[22]), FF, D, WSP(bf16, WS_WDN), 0, scr, r, LANE()); continue; } r -= I_DN;
        { const int g = r / I_PL; p0_transpose_item<false>(((const float*)A.in[11]) + (size_t)g * 128 * 128, 128, 128, WSP(bf16, WS_WPOOL) + (size_t)g * 128 * 128, 0, scr, r % I_PL, LANE()); }
    }
    bf16* XN = WSP(bf16, WS_XN);
    for (int m = gw; m < XNROWS; m += NGW) {
        if (m < MP) rms_row_to_bf16(LANE(), ((const float*)A.in[0]) + (size_t)m * D, ((const float*)A.in[9]), XN + (size_t)m * D);
        else if (m < MP + NS) rms_row_to_bf16(LANE(), ((const float*)A.in[1]) + (size_t)(m - MP) * D, ((const float*)A.in[9]), XN + (size_t)m * D);
        else if (m < MALL) { GAS unsigned long long* o8 = (GAS unsigned long long*)(XN + (size_t)m * D) + LANE(); o8[0] = 0ull; o8[64] = 0ull; o8[128] = 0ull; o8[192] = 0ull; }
        else rms_row_to_bf16(LANE(), ((const float*)A.in[8]) + (size_t)(m - MALL) * D, ((const float*)A.in[15]), XN + (size_t)m * D);
    }
    { float* rc = WSP(float, WS_ROPE); float* rs = rc + 2049 * 32; const int gt = F.vcu * (NWAVES * 64) + TID(F), NT = F.G * NWAVES * 64;
      for (int e = gt; e < 2049 * 32; e += NT) { const int pos = e >> 5, i = e & 31; const float invf = exp2f(-(float)i * (13.287712379549449f / 32.0f)); const double a = (double)pos * (double)invf; const double kq = __builtin_rint(a * 0.15915494309189535); const float rr = (float)(a - kq * 6.283185307179586); rc[e] = cosf(rr); rs[e] = sinf(rr); }
      { GAS f32x4* z = (GAS f32x4*)WSP(float, WS_SACC); for (int e = gt; e < (int)(SACC_BYTES / 16); e += NT) z[e] = (f32x4){0.f, 0.f, 0.f, 0.f}; }
      const GAS f32x4* sp = (const GAS f32x4*)((const float*)A.in[6]); GAS f32x4* po = (GAS f32x4*)(F.out + O_POOLS);
      for (int e = gt; e < NS * 14 * (PW / 4); e += NT) { const int s = e / (14 * 128), r = (e / 128) % 14, c = e & 127; po[(s * 15 + r) * 128 + c] = sp[(s * 15 + r + 1) * 128 + c]; } }
}
constexpr int POOL_LD = 136;
__device__ __forceinline__ void pool_mma_store(Frame& F, const Args& A, int row0, int g) {
    const LAS unsigned char* DB = F.lds + RING_OFF + 40960;
    const int fr = LANE() & 15, fq = LANE() >> 4, w = F.wave;
    const bf16* WP = WSP(bf16, WS_WPOOL) + (size_t)g * 128 * 128;
    f32x4 acc[8]; bf16x8 bw[4][8];
#pragma unroll
    for (int ks = 0; ks < 4; ++ks)
#pragma unroll
        for (int nb = 0; nb < 8; ++nb) bw[ks][nb] = *(const GAS bf16x8*)(WP + (size_t)(nb * 16 + fr) * 128 + ks * 32 + 8 * fq);
#pragma unroll
    for (int nb = 0; nb < 8; ++nb) acc[nb] = (f32x4){0.f, 0.f, 0.f, 0.f};
#pragma unroll
    for (int ks = 0; ks < 4; ++ks) {
        const bf16x8 a = *(const LAS bf16x8*)(DB + ((16 * w + fr) * POOL_LD + ks * 32 + 8 * fq) * 2);
#pragma unroll
        for (int nb = 0; nb < 8; ++nb) acc[nb] = __builtin_amdgcn_mfma_f32_16x16x32_bf16(bw[ks][nb], a, acc[nb], 0, 0, 0);
    }
    bf16* MIX = WSP(bf16, WS_MIX);
#pragma unroll
    for (int nb = 0; nb < 8; ++nb) { const int col = g * 128 + nb * 16 + 4 * fq; const f32x4 sp = *(const GAS f32x4*)(((const float*)A.in[12]) + col); const f32x4 v = acc[nb] * sp;
        v2u o; o.x = pk2(v[0], v[1]); o.y = pk2(v[2], v[3]); *(GAS v2u*)(MIX + (size_t)(row0 + 16 * w + fr) * D + col) = o; }
}
__device__ __forceinline__ void pool_unit(Frame& F, const Args& A, int L) {
    LAS unsigned short* UB = (LAS unsigned short*)(F.lds + RING_OFF);
    LAS unsigned short* DB = (LAS unsigned short*)(F.lds + RING_OFF + 40960);
    const int c = TID(F) & 127, strip = TID(F) >> 7;
    if (L < 512) {
        const int pnl = L >> 2, g = L & 3, r0 = pnl * 128, w = 2 << g; const bool first = (r0 & (SEQ - 1)) == 0;
        const bf16* U = WSP(bf16, WS_U);
        for (int e = TID(F); e < 144 * 16; e += NWAVES * 64) { const int rr = e >> 4, ch = e & 15; v4u v = {0u, 0u, 0u, 0u};
            if (!(first && rr < 16)) v = *(const GAS v4u*)(U + (size_t)(r0 - 16 + rr) * PW + g * 128 + ch * 8);
            *(LAS v4u*)(UB + rr * POOL_LD + ch * 8) = v; }
        LDS_WAIT(); __syncthreads();
        const int rs = strip * 32; float s = 0.f;
        for (int j = 1; j < w; ++j) s += bf2f(UB[(16 + rs - j) * POOL_LD + c]);
        const int pos0 = (r0 & (SEQ - 1)) + rs; const float invw = 1.0f / (float)w;
        for (int r = 0; r < 32; ++r) { const float uv = bf2f(UB[(16 + rs + r) * POOL_LD + c]); s += uv; const int pos = pos0 + r;
            const float inv = (pos + 1 >= w) ? invw : 1.0f / (float)(pos + 1);
            DB[(rs + r) * POOL_LD + c] = (unsigned short)f2bf(s * inv - uv); s -= bf2f(UB[(16 + rs + r - w + 1) * POOL_LD + c]); }
        LDS_WAIT(); __syncthreads();
        pool_mma_store(F, A, r0, g);
    } else {
        const int g = L - 512, w = 2 << g; const float invw = 1.0f / (float)w;
        const float* ps = WSP(float, WS_SACC + SA_PS);
        for (int r = 0; r < 32; ++r) { const int smp = strip * 32 + r; const float uv = ps[(size_t)smp * 2048 + g * 128 + c]; float s = uv;
            F.out[O_POOLS + (size_t)(smp * 15 + 14) * PW + g * 128 + c] = uv;
            for (int j = 1; j < w; ++j) s += ((const float*)A.in[6])[(size_t)(smp * 15 + 15 - j) * PW + g * 128 + c];
            DB[smp * POOL_LD + c] = (unsigned short)f2bf(s * invw - uv); }
        LDS_WAIT(); __syncthreads();
        pool_mma_store(F, A, MP, g);
    }
    LDS_WAIT(); __syncthreads();
}
__device__ __forceinline__ void sample_moba(Frame& F, const Args& A, int b) {
    int lane_ = LANE(); asm volatile("" : "+v"(lane_)); const int h = F.wave, lane = lane_, sub = lane & 15, rw = lane >> 4;
    LAS float* LG = (LAS float*)(F.lds + RING_OFF + h * 8192);
    const int* pt = ((const int*)A.in[7]) + b * NPAGES;
    const float* ps = WSP(float, WS_SACC + SA_PS) + (size_t)b * 2048;
    f32x4 qv, kn, vn;
    { const int i4 = 4 * (sub & 7); const float* rc = WSP(float, WS_ROPE) + 2048 * 32 + i4; const f32x4 c = *(const GAS f32x4*)rc, sn = *(const GAS f32x4*)(rc + 2049 * 32);
      const f32x4 q1 = *(const GAS f32x4*)(ps + 512 + h * 64 + i4), q2 = *(const GAS f32x4*)(ps + 512 + h * 64 + 32 + i4), k1 = *(const GAS f32x4*)(ps + 1024 + h * 64 + i4), k2 = *(const GAS f32x4*)(ps + 1024 + h * 64 + 32 + i4);
      qv = (sub < 8) ? (q1 * c - q2 * sn) : (q2 * c + q1 * sn); kn = (sub < 8) ? (k1 * c - k2 * sn) : (k2 * c + k1 * sn); vn = *(const GAS f32x4*)(ps + 1536 + h * 64 + 4 * sub);
      if (rw == 0) { *(GAS f32x4*)(F.out + O_KS + (size_t)b * 512 + h * 64 + 4 * sub) = kn; *(GAS f32x4*)(F.out + O_VS + (size_t)b * 512 + h * 64 + 4 * sub) = vn; }
      qv = qv * 0.125f; }
    LAS float* BS = (LAS float*)(F.lds + RING_OFF + 65536 + h * 64);
#pragma unroll 1
    for (int n = 0; n < 8; ++n) {
        float sacc = 0.f;
#pragma unroll 1
        for (int pg = 0; pg < 2; ++pg) { const int page = __builtin_amdgcn_readfirstlane(pt[2 * n + pg]);
            const float* base = ((const float*)A.in[2]) + ((size_t)page * PAGE * NH + h) * HD + 4 * sub;
#pragma unroll 1
            for (int g8 = 0; g8 < 4; ++g8) { f32x4 kv[8];
#pragma unroll
                for (int u = 0; u < 8; ++u) kv[u] = __builtin_nontemporal_load((const GAS f32x4*)(base + (size_t)(4 * (g8 * 8 + u) + rw) * (NH * HD)));
#pragma unroll
                for (int u = 0; u < 8; ++u) { float p = (kv[u][0] * qv[0] + kv[u][1] * qv[1]) + (kv[u][2] * qv[2] + kv[u][3] * qv[3]);
                    p += xshfl(p, 1, lane); p += xshfl(p, 2, lane); p += xshfl(p, 4, lane); p += xshfl(p, 8, lane);
                    if (sub == 0) LG[n * 256 + pg * 128 + 4 * (g8 * 8 + u) + rw] = p; sacc += p; } } }
        sacc += xshfl(sacc, 16, lane); sacc += xshfl(sacc, 32, lane); if (lane == 0) BS[n] = sacc;
    }
    LDS_WAIT();
    float bsum[8];
#pragma unroll
    for (int n = 0; n < 8; ++n) bsum[n] = BS[n];
    unsigned sel = 0u;
#pragma unroll
    for (int n = 0; n < 8; ++n) { int rk = 0;
#pragma unroll
        for (int m2 = 0; m2 < 8; ++m2) if (m2 != n) rk += (bsum[m2] > bsum[n] || (bsum[m2] == bsum[n] && m2 < n)) ? 1 : 0;
        if (rk < 3) sel |= 1u << n; }
    sel = __builtin_amdgcn_readfirstlane(sel);
    float pown = (kn[0] * qv[0] + kn[1] * qv[1]) + (kn[2] * qv[2] + kn[3] * qv[3]);
    pown += xshfl(pown, 1, lane); pown += xshfl(pown, 2, lane); pown += xshfl(pown, 4, lane); pown += xshfl(pown, 8, lane);
    LDS_WAIT();
    float mx = pown;
#pragma unroll
    for (int n = 0; n < 8; ++n) if ((sel >> n) & 1u) { const f32x4 l4 = *(const LAS f32x4*)(LG + n * 256 + 4 * lane); mx = __builtin_fmaxf(mx, __builtin_fmaxf(__builtin_fmaxf(l4[0], l4[1]), __builtin_fmaxf(l4[2], l4[3]))); }
    mx = wave_max(mx, lane);
    f32x4 oacc = {0.f, 0.f, 0.f, 0.f}; float lsum = 0.f;
#pragma unroll 1
    for (int n = 0; n < 8; ++n) if ((sel >> n) & 1u) {
#pragma unroll 1
        for (int pg = 0; pg < 2; ++pg) { const int page = __builtin_amdgcn_readfirstlane(pt[2 * n + pg]);
            const float* base = ((const float*)A.in[3]) + ((size_t)page * PAGE * NH + h) * HD + 4 * sub;
            for (int g8 = 0; g8 < 4; ++g8) { f32x4 vv[8];
#pragma unroll
                for (int u = 0; u < 8; ++u) vv[u] = __builtin_nontemporal_load((const GAS f32x4*)(base + (size_t)(4 * (g8 * 8 + u) + rw) * (NH * HD)));
#pragma unroll
                for (int u = 0; u < 8; ++u) { const float e = __expf(LG[n * 256 + pg * 128 + 4 * (g8 * 8 + u) + rw] - mx); lsum += e; oacc += vv[u] * e; } } } }
    { const float e = __expf(pown - mx); if (rw == 0) { lsum += e; oacc += vn * e; } }
    lsum += xshfl(lsum, 16, lane); lsum += xshfl(lsum, 32, lane);
#pragma unroll
    for (int j = 0; j < 4; ++j) { float v = oacc[j]; v += xshfl(v, 16, lane); v += xshfl(v, 32, lane); oacc[j] = v; }
    if (lane < 16) { const float inv = 1.0f / lsum; v2u o; o.x = pk2(oacc[0] * inv, oacc[1] * inv); o.y = pk2(oacc[2] * inv, oacc[3] * inv);
        *(GAS v2u*)(WSP(bf16, WS_MIX) + (size_t)(MP + b) * D + PW + h * 64 + 4 * sub) = o; }
    LDS_WAIT();
}
__device__ __forceinline__ void sample_cross(Frame& F, const Args& A, int b) {
    int lane_ = LANE(); asm volatile("" : "+v"(lane_)); const int lane = lane_, w = F.wave;
    LAS float* LG = (LAS float*)(F.lds + RING_OFF);
    LAS float* PO = (LAS float*)(F.lds + RING_OFF + 4096);
    f32x4 q[4];
#pragma unroll
    for (int hh = 0; hh < 4; ++hh) q[hh] = *(const GAS f32x4*)(WSP(float, WS_SACC + SA_AQ) + (size_t)b * D + hh * 256 + 4 * lane);
    const float* kb = ((const float*)A.in[4]) + (size_t)b * 256 * D;
    for (int k0 = 0; k0 < 32; k0 += 2) { f32x4 kv[2][4];
#pragma unroll
        for (int u = 0; u < 2; ++u)
#pragma unroll
            for (int hh = 0; hh < 4; ++hh) kv[u][hh] = __builtin_nontemporal_load((const GAS f32x4*)(kb + (size_t)(w + 8 * (k0 + u)) * D + hh * 256 + 4 * lane));
#pragma unroll
        for (int u = 0; u < 2; ++u)
#pragma unroll
            for (int hh = 0; hh < 4; ++hh) { float p = (kv[u][hh][0] * q[hh][0] + kv[u][hh][1] * q[hh][1]) + (kv[u][hh][2] * q[hh][2] + kv[u][hh][3] * q[hh][3]); p = wave_sum(p, lane); if (lane == 0) LG[hh * 256 + w + 8 * (k0 + u)] = p; } }
    LDS_WAIT(); __syncthreads();
    if (w < 4) { const f32x4 l4 = *(const LAS f32x4*)(LG + w * 256 + 4 * lane); const float mx = wave_max(__builtin_fmaxf(__builtin_fmaxf(l4[0], l4[1]), __builtin_fmaxf(l4[2], l4[3])), lane);
        f32x4 e; e[0] = __builtin_amdgcn_exp2f(l4[0] - mx); e[1] = __builtin_amdgcn_exp2f(l4[1] - mx); e[2] = __builtin_amdgcn_exp2f(l4[2] - mx); e[3] = __builtin_amdgcn_exp2f(l4[3] - mx);
        const float inv = 1.0f / wave_sum((e[0] + e[1]) + (e[2] + e[3]), lane); *(LAS f32x4*)(LG + w * 256 + 4 * lane) = e * inv; }
    LDS_WAIT(); __syncthreads();
    const float* vb = ((const float*)A.in[5]) + (size_t)b * 256 * D;
    f32x4 oacc[4];
#pragma unroll
    for (int hh = 0; hh < 4; ++hh) oacc[hh] = (f32x4){0.f, 0.f, 0.f, 0.f};
    for (int k0 = 0; k0 < 32; k0 += 2) { f32x4 vv[2][4];
#pragma unroll
        for (int u = 0; u < 2; ++u)
#pragma unroll
            for (int hh = 0; hh < 4; ++hh) vv[u][hh] = __builtin_nontemporal_load((const GAS f32x4*)(vb + (size_t)(w + 8 * (k0 + u)) * D + hh * 256 + 4 * lane));
#pragma unroll
        for (int u = 0; u < 2; ++u)
#pragma unroll
            for (int hh = 0; hh < 4; ++hh) oacc[hh] += vv[u][hh] * LG[hh * 256 + w + 8 * (k0 + u)]; }
#pragma unroll
    for (int hh = 0; hh < 4; ++hh) *(LAS f32x4*)(PO + w * 1024 + hh * 256 + 4 * lane) = oacc[hh];
    LDS_WAIT(); __syncthreads();
    { const int c = 2 * (w * 64 + lane); float a0 = 0.f, a1 = 0.f;
#pragma unroll
      for (int ww = 0; ww < 8; ++ww) { a0 += PO[ww * 1024 + c]; a1 += PO[ww * 1024 + c + 1]; }
      *(GAS unsigned*)(WSP(bf16, WS_OC) + (size_t)(MP + b) * D + c) = pk2(a0, a1); }
    LDS_WAIT(); __syncthreads();
}
__device__ __forceinline__ void cross_unit(Frame& F, int pm, int h) {
    const int b = pm >> 3;
    bf16* PB = WSP(bf16, WS_PB) + (size_t)blockIdx.x * 65536;
    { pg8::Gemm g{WSP(bf16, WS_QC) + (size_t)pm * 256 * D + h * 256, WSP(bf16, WS_MKB) + (size_t)b * 256 * D + h * 256, 256, D, D};
      pg8::EpiSoftmaxP E{PB}; pg8::OneUnit S;
      pg8::gemm_phase<pg8::EpiSoftmaxP, pg8::OneUnit, false, false>(F.lds + RING_OFF, g, S, E, F.wave); }
    VM_WAIT(); __syncthreads(); __builtin_amdgcn_fence(__ATOMIC_ACQUIRE, "agent"); VM_WAIT(); __syncthreads();
    { pg8::Gemm g{PB, WSP(bf16, WS_MVT) + (size_t)(b * 4 + h) * 65536, 256, 256, 256};
      pg8::EpiTile E{WSP(bf16, WS_OC) + (size_t)pm * 256 * D + h * 256, D}; pg8::OneUnit S;
      pg8::gemm_phase<pg8::EpiTile, pg8::OneUnit, false, false>(F.lds + RING_OFF, g, S, E, F.wave); }
    VM_WAIT(); __syncthreads();
}
__device__ __forceinline__ void final_norm(Frame& F, const Args& A) {
    const int gw = F.vcu * NWAVES + F.wave, NGW = F.G * NWAVES; const float* ss3 = (const float*)(F.ctl + CW_SS3); const GAS f32x4* gr = (const GAS f32x4*)((const float*)A.in[23]) + LANE();
    for (int m = gw; m < MP + NS; m += NGW) {
        if (m < MP) { float* row = F.out + O_YP + (size_t)m * D; const float r = 1.0f / sqrtf(ss3[m] * (1.0f / D) + EPS); GAS f32x4* xr = (GAS f32x4*)row + LANE();
#pragma unroll
            for (int j = 0; j < 4; ++j) { const f32x4 v = xr[64 * j], g = gr[64 * j]; xr[64 * j] = v * r * g; } }
        else { const int b = m - MP; const GAS f32x4* x0 = (const GAS f32x4*)(WSP(float, WS_X1) + (size_t)(MP + b) * D) + LANE(); const GAS f32x4* x3 = (const GAS f32x4*)(WSP(float, WS_SACC + SA_AD) + (size_t)b * D) + LANE();
            f32x4 v[4]; float ss = 0.f;
#pragma unroll
            for (int j = 0; j < 4; ++j) { v[j] = x0[64 * j] + x3[64 * j]; ss += (v[j][0] * v[j][0] + v[j][1] * v[j][1]) + (v[j][2] * v[j][2] + v[j][3] * v[j][3]); }
            const float r = 1.0f / sqrtf(wave_sum(ss, LANE()) * (1.0f / D) + EPS); GAS f32x4* yr = (GAS f32x4*)(F.out + O_YS + (size_t)b * D) + LANE();
#pragma unroll
            for (int j = 0; j < 4; ++j) yr[64 * j] = v[j] * r * gr[64 * j]; }
    }
}
enum { SG_STORE = 0, SG_RES = 1, SG_SCALE = 2, SG_RELU2 = 3, SG_ATOMIC = 4 };
struct SGP { float* OUT; bf16* OUTB; const float* base; const float* gain; float* rowss; float sc; };
__device__ __forceinline__ int win_src_col(int c) { if (c < 512 || c >= 1536) return c; const int t = c & ~255, j = c & 255, p = j >> 7, hh = (j >> 5) & 3, i = j & 31; return t + 64 * hh + 32 * p + i; }
template <int EPI, bool WINPERM, int NSPLIT> __device__ __forceinline__ void sample_gemm(Frame& F, const bf16* Ab, int lda, const bf16* Bt, int ldb, int N, int K, const SGP P) {
    static_assert(NSPLIT == 1 || EPI == SG_ATOMIC, "only the atomic epilogue may split K");
    const int nsl = N / 16, ksteps = K / 32 / NSPLIT;
    int lane_ = LANE(); asm volatile("" : "+v"(lane_)); const int lane = lane_, fr = lane & 15, fq = lane >> 4, row = 16 * F.wave + fr;
    for (int v = F.vcu; v < nsl * NSPLIT; v += F.G) { const int sl = v % nsl, sp = v / nsl;
        f32x4 acc = {0.f, 0.f, 0.f, 0.f};
        const bf16* ap = Ab + (size_t)row * lda + 8 * fq + (size_t)sp * ksteps * 32; const bf16* bp = Bt + (size_t)(16 * sl + fr) * ldb + 8 * fq + (size_t)sp * ksteps * 32;
        for (int kb = 0; kb < ksteps; kb += 16) { bf16x8 a[16], b[16];
#pragma unroll
            for (int u = 0; u < 16; ++u) { a[u] = *(const GAS bf16x8*)(ap + (kb + u) * 32); b[u] = *(const GAS bf16x8*)(bp + (kb + u) * 32); }
#pragma unroll
            for (int u = 0; u < 16; ++u) acc = __builtin_amdgcn_mfma_f32_16x16x32_bf16(b[u], a[u], acc, 0, 0, 0); }
        const int col = WINPERM ? win_src_col(16 * sl + 4 * fq) : 16 * sl + 4 * fq;
        if (EPI == SG_STORE) { *(GAS f32x4*)(P.OUT + (size_t)row * N + col) = acc; }
        else if (EPI == SG_ATOMIC) { float* o = P.OUT + (size_t)row * N + col; unsafeAtomicAdd(o, acc[0]); unsafeAtomicAdd(o + 1, acc[1]); unsafeAtomicAdd(o + 2, acc[2]); unsafeAtomicAdd(o + 3, acc[3]); }
        else if (EPI == SG_RES) { const f32x4 x = *(const GAS f32x4*)(P.base + (size_t)row * N + col) + acc; *(GAS f32x4*)(P.OUT + (size_t)row * N + col) = x;
            const f32x4 g = *(const GAS f32x4*)(P.gain + col); v2u o; o.x = pk2(x[0] * g[0], x[1] * g[1]); o.y = pk2(x[2] * g[2], x[3] * g[3]); *(GAS v2u*)(P.OUTB + (size_t)row * N + col) = o;
            float ss = (x[0] * x[0] + x[1] * x[1]) + (x[2] * x[2] + x[3] * x[3]); ss += xshfl(ss, 16, lane); ss += xshfl(ss, 32, lane); if (fq == 0) unsafeAtomicAdd(P.rowss + row, ss); }
        else { const float r = P.sc / sqrtf(P.rowss[row] * (1.0f / D) + EPS); f32x4 hv = acc * r;
            if (EPI == SG_SCALE) { *(GAS f32x4*)(P.OUT + (size_t)row * N + col) = hv; }
            else { hv = __builtin_elementwise_max(hv, (f32x4){0.f, 0.f, 0.f, 0.f}); hv = hv * hv; v2u o; o.x = pk2(hv[0], hv[1]); o.y = pk2(hv[2], hv[3]); *(GAS v2u*)(P.OUTB + (size_t)row * N + col) = o; } }
    }
}
__device__ __forceinline__ int next_task(Frame& F, gu32* head) {
    int slot = 16; asm volatile("" : "+v"(slot));
    __syncthreads();
    if (TID(F) + slot == 16) F.MISC[slot] = __hip_atomic_fetch_add(head, 1u, RLX_AGENT);
    __syncthreads();
    return __builtin_amdgcn_readfirstlane((int)F.MISC[slot]);
}
#ifndef REPMASK
#define REPMASK 0
#endif
#define NREP(k) (1 + ((REPMASK >> (k)) & 1))
#ifndef SKIPMASK
#define SKIPMASK 0
#endif
__global__ void __launch_bounds__(NWAVES * 64, 2) mk_fwd(Args args) {
    const Args& A = args;
    extern __shared__ __attribute__((aligned(16))) unsigned char lds[];
    Frame F;
    F.lds = (LAS unsigned char*)lds;
    F.MISC = (volatile LAS unsigned*)(F.lds + MISC_OFF);
    F.wave = __builtin_amdgcn_readfirstlane((int)(threadIdx.x >> 6));
    F.G = gridDim.x; { const int bx = blockIdx.x; F.vcu = (F.G % 8 == 0) ? (bx % 8) * (F.G / 8) + bx / 8 : bx; }
    F.ws = args.ws; F.out = args.out; F.ctl = (gu32*)(args.ws + WS_CTL);
    for (int u = TID(F); u < (LDS_BYTES - LDSCTL_OFF) / 4; u += NWAVES * 64) ((LAS unsigned*)(F.lds + LDSCTL_OFF))[u] = 0u;
    __syncthreads();
    XcdBarrier bar; bar.bar = (unsigned*)(F.ctl + CW_BAR); bar.x = 0; bar.st = nullptr; bar.wave = F.wave;
    if (N_LAUNCHES != PER_PHASE) bar = xcd_barrier_post((unsigned*)(F.ctl + CW_BAR), F.MISC + 8, F.wave);
#define GRID_BAR(seam) do { if (N_LAUNCHES == PER_PHASE) { if (TID(F) == 0) __hip_atomic_store(F.ctl + CW_TMO, 0xBADBA0u | (unsigned)(seam), RLX_AGENT); } else { xcd_barrier(bar); } } while (0)
    const int lo = args.ph_lo, hi = args.ph_hi;
#define IN(k) (lo <= (k) && (k) < hi)
#define BOTH(k) (IN(k) && IN((k) + 1))
    float* const ss1 = (float*)(F.ctl + CW_SS1); float* const ss2 = (float*)(F.ctl + CW_SS2); float* const ss3 = (float*)(F.ctl + CW_SS3);
    float* const X1 = WSP(float, WS_X1);

    if (IN(0) && !(SKIPMASK & (1 << 0))) { for (int rp = 0; rp < NREP(0); ++rp) p0_prologue(F, A); if (BOTH(0)) GRID_BAR(0); }

    if (IN(1) && !(SKIPMASK & (1 << 1))) {
        sample_gemm<SG_STORE, true, 1>(F, WSP(bf16, WS_XN) + (size_t)MP * D, D, WSP(bf16, WS_WIN), D, 2048, D, SGP{WSP(float, WS_SACC + SA_PS), nullptr, nullptr, nullptr, nullptr, 1.f});
        for (int rp = 0; rp < NREP(1); ++rp) {
        pg8::Gemm g{WSP(bf16, WS_XN), WSP(bf16, WS_WIN), D, D, D}; pg8::StaticOrder S; S.init(MP, 2048, F.G, (int)blockIdx.x);
        float* rc = WSP(float, WS_ROPE);
        pg8::EpiQKV E{WSP(bf16, WS_U), WSP(bf16, WS_Q), WSP(bf16, WS_K), WSP(bf16, WS_V), WSP(bf16, WS_MKB), WSP(bf16, WS_MVT), (float*)(F.ctl + CW_KSUM), rc, rc + 2049 * 32,
                      F.out + O_KP, F.out + O_VP, F.out + O_POOLP, F.out + O_MK, F.out + O_MV, attn_body::C2};
        pg8::gemm_phase<pg8::EpiQKV, pg8::StaticOrder, true, true>(F.lds + RING_OFF, g, S, E, F.wave);
        }
        if (BOTH(1)) GRID_BAR(1);
    }

    if (IN(2) && !(SKIPMASK & (1 << 2))) {
        const attn_body::AttnTensors AT{(const attn_body::bf16*)WSP(bf16, WS_Q), (const attn_body::bf16*)WSP(bf16, WS_K), (const attn_body::bf16*)WSP(bf16, WS_V), (attn_body::bf16*)(WSP(bf16, WS_MIX) + PW), D, (const float*)(F.ctl + CW_KSUM)};
        for (int rp = 0; rp < NREP(10); ++rp)
        for (;;) { const int t = next_task(F, F.ctl + rp * 1024 + CW_Q2); if (t >= NS) break; sample_moba(F, A, t); }
        for (int rp = 0; rp < NREP(11); ++rp)
        for (;;) { const int i = next_task(F, F.ctl + rp * 1024 + CW_Q2 + 64); if (i >= 64) break;
            pg8::Gemm g{WSP(bf16, WS_XN), WSP(bf16, WS_WIN), D, D, D}; pg8::OneUnitAt S{65 + (i & 7), 8 + (i >> 3)};
            float* rc = WSP(float, WS_ROPE);
            pg8::EpiQKV E{WSP(bf16, WS_U), WSP(bf16, WS_Q), WSP(bf16, WS_K), WSP(bf16, WS_V), WSP(bf16, WS_MKB), WSP(bf16, WS_MVT), (float*)(F.ctl + CW_KSUM), rc, rc + 2049 * 32,
                          F.out + O_KP, F.out + O_VP, F.out + O_POOLP, F.out + O_MK, F.out + O_MV, attn_body::C2};
            pg8::gemm_phase<pg8::EpiQKV, pg8::OneUnitAt, false, true>(F.lds + RING_OFF, g, S, E, F.wave); }
        for (int rp = 0; rp < NREP(12); ++rp)
        for (;;) { const int i = next_task(F, F.ctl + rp * 1024 + CW_Q2 + 128); if (i >= 512) break; const int qb = 7 - (i >> 6), bh = i & 63;
            attn_body::attn_unit<8>(bh >> 3, bh & 7, qb, AT.Q, AT.K, AT.V, AT.O, AT.opitch, AT.KS, (char*)lds + RING_OFF, F.wave); }
        for (int rp = 0; rp < NREP(13); ++rp)
        for (;;) { const int i = next_task(F, F.ctl + rp * 1024 + CW_Q2 + 192); if (i >= 516) break; pool_unit(F, A, i); }
        if (BOTH(2)) GRID_BAR(2);
    }

    if (IN(3) && !(SKIPMASK & (1 << 3))) {
        sample_gemm<SG_RES, false, 1>(F, WSP(bf16, WS_MIX) + (size_t)MP * D, D, WSP(bf16, WS_WOUT), D, D, D, SGP{X1 + (size_t)MP * D, WSP(bf16, WS_XG) + (size_t)MP * D, ((const float*)A.in[1]), ((const float*)A.in[14]), ss1 + MP, 1.f});
        pg8::Gemm g{WSP(bf16, WS_MIX), WSP(bf16, WS_WOUT), D, D, D}; pg8::StaticOrder S; S.init(MP, D, F.G, (int)blockIdx.x);
        pg8::EpiRes E{((const float*)A.in[0]), X1, WSP(bf16, WS_XG), ((const float*)A.in[14]), ss1};
        pg8::gemm_phase<pg8::EpiRes, pg8::StaticOrder, true, true>(F.lds + RING_OFF, g, S, E, F.wave);
        if (NREP(3) > 1) { pg8::EpiRes E2{((const float*)A.in[0]), WSP(float, WS_DUMMY), WSP(bf16, WS_DUMMY + 64 * MiB), ((const float*)A.in[14]), (float*)(F.ctl + CW_SSD)};
            pg8::gemm_phase<pg8::EpiRes, pg8::StaticOrder, true, true>(F.lds + RING_OFF, g, S, E2, F.wave); }
        if (BOTH(3)) GRID_BAR(3);
    }
    if (IN(4) && !(SKIPMASK & (1 << 4))) {
        sample_gemm<SG_SCALE, false, 1>(F, WSP(bf16, WS_XG) + (size_t)MP * D, D, WSP(bf16, WS_WCQ), D, D, D, SGP{WSP(float, WS_SACC + SA_AQ), nullptr, nullptr, nullptr, ss1 + MP, CROSS_C2});
        for (int rp = 0; rp < NREP(4); ++rp) {
        pg8::Gemm g{WSP(bf16, WS_XG), WSP(bf16, WS_WCQ), D, D, D}; pg8::StaticOrder S; S.init(MP, D, F.G, (int)blockIdx.x);
        pg8::EpiScale<0> E{WSP(bf16, WS_QC), D, ss1, CROSS_C2};
        pg8::gemm_phase<pg8::EpiScale<0>, pg8::StaticOrder, true, true>(F.lds + RING_OFF, g, S, E, F.wave);
        }
        if (BOTH(4)) GRID_BAR(4);
    }
    if (IN(5) && !(SKIPMASK & (1 << 5))) {
        for (int rp = 0; rp < NREP(14); ++rp)
        for (;;) { const int t = next_task(F, F.ctl + rp * 1024 + CW_Q5); if (t >= NS) break; sample_cross(F, A, t); }
        for (int rp = 0; rp < NREP(15); ++rp)
        for (;;) { const int L = next_task(F, F.ctl + rp * 1024 + CW_Q5 + 64); if (L >= 256) break; cross_unit(F, L >> 2, L & 3); }
        if (BOTH(5)) GRID_BAR(5);
    }
    if (IN(6) && !(SKIPMASK & (1 << 6))) {
        sample_gemm<SG_RES, false, 1>(F, WSP(bf16, WS_OC) + (size_t)MP * D, D, WSP(bf16, WS_WCO), D, D, D, SGP{X1 + (size_t)MP * D, WSP(bf16, WS_XG) + (size_t)MP * D, X1 + (size_t)MP * D, ((const float*)A.in[20]), ss2 + MP, 1.f});
        pg8::Gemm g{WSP(bf16, WS_OC), WSP(bf16, WS_WCO), D, D, D}; pg8::StaticOrder S; S.init(MP, D, F.G, (int)blockIdx.x);
        pg8::EpiRes E{X1, X1, WSP(bf16, WS_XG), ((const float*)A.in[20]), ss2};
        pg8::gemm_phase<pg8::EpiRes, pg8::StaticOrder, true, true>(F.lds + RING_OFF, g, S, E, F.wave);
        if (NREP(6) > 1) { pg8::EpiRes E2{X1, WSP(float, WS_DUMMY), WSP(bf16, WS_DUMMY + 64 * MiB), ((const float*)A.in[20]), (float*)(F.ctl + CW_SSD)};
            pg8::gemm_phase<pg8::EpiRes, pg8::StaticOrder, true, true>(F.lds + RING_OFF, g, S, E2, F.wave); }
        if (BOTH(6)) GRID_BAR(6);
    }
    if (IN(7) && !(SKIPMASK & (1 << 7))) {
        sample_gemm<SG_RELU2, false, 1>(F, WSP(bf16, WS_XG) + (size_t)MP * D, D, WSP(bf16, WS_WUP), D, FF, D, SGP{nullptr, WSP(bf16, WS_HBS), nullptr, nullptr, ss2 + MP, 1.f});
        for (int rp = 0; rp < NREP(7); ++rp) {
        pg8::Gemm g{WSP(bf16, WS_XG), WSP(bf16, WS_WUP), D, D, D}; pg8::StaticOrder S; S.init(MP, FF, F.G, (int)blockIdx.x);
        pg8::EpiScale<1> E{WSP(bf16, WS_HB), FF, ss2, 1.0f};
        pg8::gemm_phase<pg8::EpiScale<1>, pg8::StaticOrder, true, true>(F.lds + RING_OFF, g, S, E, F.wave);
        }
        if (BOTH(7)) GRID_BAR(7);
    }
    if (IN(8) && !(SKIPMASK & (1 << 8))) {
        sample_gemm<SG_ATOMIC, false, 4>(F, WSP(bf16, WS_HBS), FF, WSP(bf16, WS_WDN), FF, D, FF, SGP{WSP(float, WS_SACC + SA_AD), nullptr, nullptr, nullptr, nullptr, 1.f});
        pg8::Gemm g{WSP(bf16, WS_HB), WSP(bf16, WS_WDN), FF, FF, FF}; pg8::StaticOrder S; S.init(MP, D, F.G, (int)blockIdx.x);
        pg8::EpiRes E{X1, F.out + O_YP, nullptr, nullptr, ss3};
        pg8::gemm_phase<pg8::EpiRes, pg8::StaticOrder, true, true>(F.lds + RING_OFF, g, S, E, F.wave);
        if (NREP(8) > 1) { pg8::EpiRes E2{X1, WSP(float, WS_DUMMY), nullptr, nullptr, (float*)(F.ctl + CW_SSD)};
            pg8::gemm_phase<pg8::EpiRes, pg8::StaticOrder, true, true>(F.lds + RING_OFF, g, S, E2, F.wave); }
        if (BOTH(8)) GRID_BAR(8);
    }
    if (IN(9) && !(SKIPMASK & (1 << 9))) { final_norm(F, A); }
#undef IN
#undef BOTH
}

extern "C" void kernel_launch(void* const* d_in, const int* in_sizes, int n_in, void* d_out, int out_size, void* d_ws, size_t ws_size, hipStream_t stream) {
    static int grid = 0;
    if (grid == 0) {
        if (n_in != 24 || in_sizes[0] != MP * D || (size_t)out_size != O_END || ws_size < WS_END + (REPMASK ? 96 * MiB : 0)) { fprintf(stderr, "kernel_launch: unexpected shapes: n_in %d in0 %d out %d ws %zu; nothing launched\n", n_in, n_in > 0 ? in_sizes[0] : -1, out_size, ws_size); grid = -1; return; }
        int dev = 0, cus = 0, per_cu = 0;
        if (hipGetDevice(&dev) != hipSuccess || hipDeviceGetAttribute(&cus, hipDeviceAttributeMultiprocessorCount, dev) != hipSuccess) { fprintf(stderr, "kernel_launch: hipGetDevice / hipDeviceGetAttribute failed\n"); grid = -1; return; }
        if (hipFuncSetAttribute((const void*)mk_fwd, hipFuncAttributeMaxDynamicSharedMemorySize, LDS_BYTES) != hipSuccess) { fprintf(stderr, "kernel_launch: hipFuncSetAttribute failed\n"); grid = -1; return; }
        if (hipOccupancyMaxActiveBlocksPerMultiprocessor(&per_cu, (const void*)mk_fwd, NWAVES * 64, LDS_BYTES) != hipSuccess || per_cu < 1) { fprintf(stderr, "kernel_launch: occupancy query reports %d workgroups per CU\n", per_cu); }
        (void)hipGetLastError();
        grid = cus;
        if (grid > 256) grid = 256;
    }
    if (grid < 0) return;
    if (hipMemsetAsync((char*)d_ws + WS_CTL, 0, CTL_ZERO_BYTES, stream) != hipSuccess) { fprintf(stderr, "kernel_launch: hipMemsetAsync failed\n"); return; }
    Args a{};
    for (int i = 0; i < 24; ++i) a.in[i] = d_in[i];
    a.out = (float*)d_out; a.ws = (unsigned char*)d_ws;
    for (int li = 0; li < N_LAUNCHES; ++li) {
        a.ph_lo = (N_LAUNCHES == PER_PHASE) ? li : 0; a.ph_hi = (N_LAUNCHES == PER_PHASE) ? li + 1 : PER_PHASE;
        hipLaunchKernelGGL(mk_fwd, dim3(grid), dim3(NWAVES * 64), LDS_BYTES, stream, a);
        const hipError_t le = hipPeekAtLastError();
        if (le != hipSuccess) { fprintf(stderr, "kernel_launch: launch %d failed: %s\n", li, hipGetErrorName(le)); break; }
    }
}
```

```cpp
#include <hip/hip_runtime.h>
#include <cstdio>
#include <cstdint>
#include <cmath>
namespace pg8 {
#define PG8_LAS __attribute__((address_space(3)))
typedef unsigned short bf16_t;
typedef short bf16x8 __attribute__((ext_vector_type(8)));
typedef float f32x4 __attribute__((ext_vector_type(4)));
typedef unsigned u32x4 __attribute__((ext_vector_type(4)));
constexpr int BM = 256, BK = 64, HALF = 128, HTB = HALF * BK * 2  , STAGE_BYTES = 8 * HTB, NXCD = 8, WGM = 8;

__host__ __device__ __forceinline__ int lds_byte(int r, int c) { const int st = (r >> 4) * 2 + (c >> 5), rr = r & 15, cc = c & 31, ob = rr * 64 + cc * 2; return st * 1024 + (ob ^ (((ob >> 9) & 1) << 5)); }
__host__ __device__ __forceinline__ void stage_rc(int b, int& R, int& C) { const int st = b / 1024, sb = b % 1024, swz = sb ^ (((sb >> 9) & 1) << 5); R = (st >> 1) * 16 + swz / 64; C = (st & 1) * 32 + (swz % 64) / 2; }
__host__ __device__ __forceinline__ int perm32(int rho) { const int n = rho >> 4, i = rho & 15; return 8 * (i >> 2) + 4 * n + (i & 3); }

struct Unit { int pm, pn; };
struct Gemm { const bf16_t* A; const bf16_t* Bt; int K, lda, ldb; };

struct StaticOrder {
    int nM, nN, nwg, G, c;
    __host__ __device__ void init(int M, int N, int G_, int c_) { nM = M / BM; nN = N / BM; nwg = nM * nN; G = G_; c = c_; }
    __host__ __device__ bool next(int i, Unit& u) const {
        const long L = (long)i * G + c; if (L >= nwg) return false;
        int wgid = (int)L; { const int q = nwg / NXCD, r = nwg % NXCD, xcd = wgid % NXCD, off = wgid / NXCD; wgid = (xcd < r ? xcd * (q + 1) : r * (q + 1) + (xcd - r) * q) + off; }
        const int nig = WGM * nN, gid = wgid / nig, fm = gid * WGM, gsz = (nM - fm) < WGM ? (nM - fm) : WGM;
        u.pm = fm + ((wgid % nig) % gsz); u.pn = (wgid % nig) / gsz; return true;
    }
    __device__ __forceinline__ void a_ready(const Unit&) const {}
    __device__ __forceinline__ void done(const Unit&) const {}
};

__device__ __forceinline__ unsigned cvt_pk_bf16(float lo, float hi) { unsigned r; asm volatile("v_cvt_pk_bf16_f32 %0, %1, %2" : "=v"(r) : "v"(lo), "v"(hi)); return r; }
typedef float f32x2 __attribute__((ext_vector_type(2)));
__device__ __forceinline__ float xshfl(float v, int m, int lane) { return __builtin_bit_cast(float, __builtin_amdgcn_ds_bpermute((lane ^ m) << 2, __builtin_bit_cast(int, v))); }
__device__ __forceinline__ u32x4 pack8(const f32x4 a, const f32x4 b) { u32x4 w; w.x = cvt_pk_bf16(a[0], a[1]); w.y = cvt_pk_bf16(a[2], a[3]); w.z = cvt_pk_bf16(b[0], b[1]); w.w = cvt_pk_bf16(b[2], b[3]); return w; }
__device__ __forceinline__ unsigned short bf16_1(float v) { return (unsigned short)(cvt_pk_bf16(v, 0.f) & 0xffffu); }


struct EpiQKV {
    static constexpr bool PERM = true, AFTER_DRAIN = false;
    bf16_t *U, *Q, *Kb, *V, *MKB, *MVT; float *ksum; const float *ropeC, *ropeS;
    float *o_kp, *o_vp, *o_poolp, *o_mk, *o_mv; float qscale;
    __device__ __forceinline__ void operator()(const f32x4 (&acc)[2][2][4][2], const Unit& u, int wr, int wc, int fr, int fq) const {
        const int pm = u.pm, pn = u.pn;
        if (pm >= 65) {
            const int isv = (pn - 8) >> 2, ct = (pn - 8) & 3;
#pragma unroll
            for (int ai = 0; ai < 2; ++ai)
#pragma unroll
                for (int m = 0; m < 4; ++m) { const int mrow = (pm - 65) * 256 + ai * 128 + wr * 64 + m * 16 + fr;
#pragma unroll
                    for (int bj = 0; bj < 2; ++bj) { const int cl = bj * 128 + wc * 32 + 8 * fq, col = ct * 256 + cl; const f32x4 v0 = acc[ai][bj][m][0], v1 = acc[ai][bj][m][1];
                        float* o = (isv ? o_mv : o_mk) + (size_t)mrow * 1024 + col; *(f32x4*)o = v0; *(f32x4*)(o + 4) = v1;
                        if (!isv) { *(u32x4*)(MKB + (size_t)mrow * 1024 + col) = pack8(v0, v1); }
                        else { const int b = mrow >> 8, key = mrow & 255; bf16_t* t = MVT + ((size_t)(b * 4 + ct) * 256 + cl) * 256 + key;
                            t[0 * 256] = bf16_1(v0[0]); t[1 * 256] = bf16_1(v0[1]); t[2 * 256] = bf16_1(v0[2]); t[3 * 256] = bf16_1(v0[3]);
                            t[4 * 256] = bf16_1(v1[0]); t[5 * 256] = bf16_1(v1[1]); t[6 * 256] = bf16_1(v1[2]); t[7 * 256] = bf16_1(v1[3]); } } }
            return;
        }
        const int kind = pn >> 1, half = pn & 1;
        if (kind == 0) {
#pragma unroll
            for (int ai = 0; ai < 2; ++ai)
#pragma unroll
                for (int m = 0; m < 4; ++m) { const int row = pm * 256 + ai * 128 + wr * 64 + m * 16 + fr;
#pragma unroll
                    for (int bj = 0; bj < 2; ++bj) { const int col = half * 256 + bj * 128 + wc * 32 + 8 * fq; const f32x4 v0 = acc[ai][bj][m][0], v1 = acc[ai][bj][m][1];
                        *(u32x4*)(U + (size_t)row * 512 + col) = pack8(v0, v1);
                        { const int pos = row & 2047; if (pos >= 2033) { float* o = o_poolp + ((size_t)((row >> 11) * 15 + pos - 2033) * 512 + col); *(f32x4*)o = v0; *(f32x4*)(o + 4) = v1; } } } }
        } else if (kind == 3) {
#pragma unroll
            for (int ai = 0; ai < 2; ++ai)
#pragma unroll
                for (int m = 0; m < 4; ++m) { const int row = pm * 256 + ai * 128 + wr * 64 + m * 16 + fr;
#pragma unroll
                    for (int bj = 0; bj < 2; ++bj) { const int col = half * 256 + bj * 128 + wc * 32 + 8 * fq; const f32x4 v0 = acc[ai][bj][m][0], v1 = acc[ai][bj][m][1];
                        *(u32x4*)(V + (size_t)row * 512 + col) = pack8(v0, v1);
                        { float* o = o_vp + (size_t)row * 512 + col; *(f32x4*)o = v0; *(f32x4*)(o + 4) = v1; } } }
        } else {
            const int head = half * 4 + wc, i0 = 8 * fq, col1 = head * 64 + i0, col2 = col1 + 32;
            f32x4 cs1a = {0.f, 0.f, 0.f, 0.f}, cs1b = cs1a, cs2a = cs1a, cs2b = cs1a;
#pragma unroll
            for (int ai = 0; ai < 2; ++ai)
#pragma unroll
                for (int m = 0; m < 4; ++m) { const int row = pm * 256 + ai * 128 + wr * 64 + m * 16 + fr; const int pos = row & 2047;
                    const f32x4 c0 = *(const f32x4*)(ropeC + pos * 32 + i0), c1 = *(const f32x4*)(ropeC + pos * 32 + i0 + 4), s0 = *(const f32x4*)(ropeS + pos * 32 + i0), s1 = *(const f32x4*)(ropeS + pos * 32 + i0 + 4);
                    const f32x4 x1a = acc[ai][0][m][0], x1b = acc[ai][0][m][1], x2a = acc[ai][1][m][0], x2b = acc[ai][1][m][1];
                    const f32x4 o1a = x1a * c0 - x2a * s0, o1b = x1b * c1 - x2b * s1, o2a = x2a * c0 + x1a * s0, o2b = x2b * c1 + x1b * s1;
                    if (kind == 1) {
                        *(u32x4*)(Q + (size_t)row * 512 + col1) = pack8(o1a * qscale, o1b * qscale); *(u32x4*)(Q + (size_t)row * 512 + col2) = pack8(o2a * qscale, o2b * qscale);
                    } else {
                        *(u32x4*)(Kb + (size_t)row * 512 + col1) = pack8(o1a, o1b); *(u32x4*)(Kb + (size_t)row * 512 + col2) = pack8(o2a, o2b);
                        { float* o = o_kp + (size_t)row * 512; *(f32x4*)(o + col1) = o1a; *(f32x4*)(o + col1 + 4) = o1b; *(f32x4*)(o + col2) = o2a; *(f32x4*)(o + col2 + 4) = o2b;
                            cs1a += o1a; cs1b += o1b; cs2a += o2a; cs2b += o2b; }
                    } }
            if (kind == 2) {
                float cs[16] = {cs1a[0], cs1a[1], cs1a[2], cs1a[3], cs1b[0], cs1b[1], cs1b[2], cs1b[3], cs2a[0], cs2a[1], cs2a[2], cs2a[3], cs2b[0], cs2b[1], cs2b[2], cs2b[3]};
#pragma unroll
                for (int j = 0; j < 16; ++j) { float v = cs[j]; v += xshfl(v, 1, fr + 16 * fq); v += xshfl(v, 2, fr + 16 * fq); v += xshfl(v, 4, fr + 16 * fq); v += xshfl(v, 8, fr + 16 * fq); cs[j] = v; }
                if (fr == 0) { float* kp = ksum + (size_t)pm * 512;
#pragma unroll
                    for (int j = 0; j < 8; ++j) { unsafeAtomicAdd(kp + col1 + j, cs[j]); unsafeAtomicAdd(kp + col2 + j, cs[8 + j]); } }
            }
        }
    }
};

struct EpiResB {
    static constexpr bool PERM = true, AFTER_DRAIN = false;
    const bf16_t* base; bf16_t* outb; float* outf; float* rowss;
    __device__ __forceinline__ void operator()(const f32x4 (&acc)[2][2][4][2], const Unit& u, int wr, int wc, int fr, int fq) const {
#pragma unroll
        for (int ai = 0; ai < 2; ++ai)
#pragma unroll
            for (int m = 0; m < 4; ++m) { const int row = u.pm * 256 + ai * 128 + wr * 64 + m * 16 + fr;
                float ss = 0.f;
#pragma unroll
                for (int bj = 0; bj < 2; ++bj) { const int col = u.pn * 256 + bj * 128 + wc * 32 + 8 * fq; const u32x4 bv = *(const u32x4*)(base + (size_t)row * 1024 + col);
                    const f32x4 b0 = {__uint_as_float(bv.x << 16), __uint_as_float(bv.x & 0xffff0000u), __uint_as_float(bv.y << 16), __uint_as_float(bv.y & 0xffff0000u)};
                    const f32x4 b1 = {__uint_as_float(bv.z << 16), __uint_as_float(bv.z & 0xffff0000u), __uint_as_float(bv.w << 16), __uint_as_float(bv.w & 0xffff0000u)};
                    const f32x4 x0 = b0 + acc[ai][bj][m][0], x1 = b1 + acc[ai][bj][m][1];
                    ss += (x0[0] * x0[0] + x0[1] * x0[1]) + (x0[2] * x0[2] + x0[3] * x0[3]) + (x1[0] * x1[0] + x1[1] * x1[1]) + (x1[2] * x1[2] + x1[3] * x1[3]);
                    if (outf) { float* op = outf + (size_t)row * 1024 + col; *(f32x4*)op = x0; *(f32x4*)(op + 4) = x1; }
                    else *(u32x4*)(outb + (size_t)row * 1024 + col) = pack8(x0, x1); }
                ss += xshfl(ss, 16, fr + 16 * fq); ss += xshfl(ss, 32, fr + 16 * fq);
                if (fq == 0) unsafeAtomicAdd(rowss + row, ss);
            }
    }
};
template <int ACT> struct EpiScale {
    static constexpr bool PERM = true, AFTER_DRAIN = false;
    bf16_t* O; int ldc; const float* rowss; float sc;
    __device__ __forceinline__ void operator()(const f32x4 (&acc)[2][2][4][2], const Unit& u, int wr, int wc, int fr, int fq) const {
#pragma unroll
        for (int ai = 0; ai < 2; ++ai)
#pragma unroll
            for (int m = 0; m < 4; ++m) { const int row = u.pm * 256 + ai * 128 + wr * 64 + m * 16 + fr;
                const float r = __builtin_amdgcn_rsqf(rowss[row] * (1.0f / 1024.0f) + 1e-6f) * sc;
#pragma unroll
                for (int bj = 0; bj < 2; ++bj) { const int col = u.pn * 256 + bj * 128 + wc * 32 + 8 * fq; f32x4 v0 = acc[ai][bj][m][0] * r, v1 = acc[ai][bj][m][1] * r;
                    if (ACT == 1) { v0 = __builtin_elementwise_max(v0, (f32x4){0.f, 0.f, 0.f, 0.f}); v1 = __builtin_elementwise_max(v1, (f32x4){0.f, 0.f, 0.f, 0.f}); v0 = v0 * v0; v1 = v1 * v1; }
                    *(u32x4*)(O + (size_t)row * ldc + col) = pack8(v0, v1); } }
    }
};
struct EpiTile {
    static constexpr bool PERM = true, AFTER_DRAIN = false;
    bf16_t* O; int ldc;
    __device__ __forceinline__ void operator()(const f32x4 (&acc)[2][2][4][2], const Unit&, int wr, int wc, int fr, int fq) const {
#pragma unroll
        for (int ai = 0; ai < 2; ++ai)
#pragma unroll
            for (int m = 0; m < 4; ++m) { const int row = ai * 128 + wr * 64 + m * 16 + fr;
#pragma unroll
                for (int bj = 0; bj < 2; ++bj) { const int col = bj * 128 + wc * 32 + 8 * fq; *(u32x4*)(O + (size_t)row * ldc + col) = pack8(acc[ai][bj][m][0], acc[ai][bj][m][1]); } }
    }
};
struct EpiSoftmaxP {
    static constexpr bool PERM = true, AFTER_DRAIN = true;
    bf16_t* P;
    __device__ __forceinline__ void fused(f32x4 (&acc)[2][2][4][2], const Unit&, int wr, int wc, int fr, int fq, PG8_LAS unsigned char* lds, int, int) const {
        PG8_LAS float* MX = (PG8_LAS float*)lds; PG8_LAS float* SM = (PG8_LAS float*)(lds + 4096);
#ifdef SOFTMAX_TRIVIAL
        if (fq == 0) MX[fr] = acc[0][0][0][0][0]; return;
#endif
#pragma unroll
        for (int ai = 0; ai < 2; ++ai)
#pragma unroll
            for (int m = 0; m < 4; ++m) { float mx = -INFINITY;
#pragma unroll
                for (int bj = 0; bj < 2; ++bj)
#pragma unroll
                    for (int n = 0; n < 2; ++n) { const f32x4 x = acc[ai][bj][m][n]; mx = __builtin_fmaxf(mx, __builtin_fmaxf(__builtin_fmaxf(x[0], x[1]), __builtin_fmaxf(x[2], x[3]))); }
                mx = __builtin_fmaxf(mx, xshfl(mx, 16, fr + 16 * fq)); mx = __builtin_fmaxf(mx, xshfl(mx, 32, fr + 16 * fq));
                if (fq == 0) MX[(ai * 128 + wr * 64 + m * 16 + fr) * 4 + wc] = mx; }
        asm volatile("s_waitcnt lgkmcnt(0)" ::: "memory"); __builtin_amdgcn_s_barrier(); asm volatile("" ::: "memory");
#pragma unroll
        for (int ai = 0; ai < 2; ++ai)
#pragma unroll
            for (int m = 0; m < 4; ++m) { const int r = ai * 128 + wr * 64 + m * 16 + fr; const f32x4 mv = *(const PG8_LAS f32x4*)(MX + r * 4);
                const float rm = __builtin_fmaxf(__builtin_fmaxf(mv[0], mv[1]), __builtin_fmaxf(mv[2], mv[3])); float s = 0.f;
#pragma unroll
                for (int bj = 0; bj < 2; ++bj)
#pragma unroll
                    for (int n = 0; n < 2; ++n) { f32x4 x = acc[ai][bj][m][n]; x[0] = __builtin_amdgcn_exp2f(x[0] - rm); x[1] = __builtin_amdgcn_exp2f(x[1] - rm); x[2] = __builtin_amdgcn_exp2f(x[2] - rm); x[3] = __builtin_amdgcn_exp2f(x[3] - rm);
                        s += (x[0] + x[1]) + (x[2] + x[3]); acc[ai][bj][m][n] = x; }
                s += xshfl(s, 16, fr + 16 * fq); s += xshfl(s, 32, fr + 16 * fq);
                if (fq == 0) SM[r * 4 + wc] = s; }
        asm volatile("s_waitcnt lgkmcnt(0)" ::: "memory"); __builtin_amdgcn_s_barrier(); asm volatile("" ::: "memory");
#pragma unroll
        for (int ai = 0; ai < 2; ++ai)
#pragma unroll
            for (int m = 0; m < 4; ++m) { const int r = ai * 128 + wr * 64 + m * 16 + fr; const f32x4 sv = *(const PG8_LAS f32x4*)(SM + r * 4);
                const float inv = 1.0f / ((sv[0] + sv[1]) + (sv[2] + sv[3]));
#pragma unroll
                for (int bj = 0; bj < 2; ++bj) { const int col = bj * 128 + wc * 32 + 8 * fq; *(u32x4*)(P + (size_t)r * 256 + col) = pack8(acc[ai][bj][m][0] * inv, acc[ai][bj][m][1] * inv); } }
    }
};
struct OneUnitAt {
    int pm, pn;
    __device__ __forceinline__ bool next(int i, Unit& u) const { if (i) return false; u.pm = pm; u.pn = pn; return true; }
    __device__ __forceinline__ void a_ready(const Unit&) const {}
    __device__ __forceinline__ void done(const Unit&) const {}
};
struct OneUnit {
    __device__ __forceinline__ bool next(int i, Unit& u) const { if (i) return false; u.pm = 0; u.pn = 0; return true; }
    __device__ __forceinline__ void a_ready(const Unit&) const {}
    __device__ __forceinline__ void done(const Unit&) const {}
};
struct SchedP1 {
    StaticOrder S1; int G, c;
    __device__ __forceinline__ void init(int G_, int c_) { S1.init(65 * 256, 2048, G_, c_); G = G_; c = c_; }
    __device__ __forceinline__ bool next(int i, Unit& u) const { if (S1.next(i, u)) return true; const long L = (long)i * G + c - 520; if (L < 0 || L >= 64) return false; u.pm = 65 + (int)(L & 7); u.pn = 8 + (int)(L >> 3); return true; }
    __device__ __forceinline__ void a_ready(const Unit&) const {}
    __device__ __forceinline__ void done(const Unit&) const {}
};

template <class Epi, class Sched, bool ALIGN_EPI = false, bool SP2 = false>
__device__ __forceinline__ void gemm_phase(PG8_LAS unsigned char* lds, const Gemm g, const Sched& S, const Epi& E, const int wid_in) {
    int lane_ = __builtin_amdgcn_mbcnt_hi(~0u, __builtin_amdgcn_mbcnt_lo(~0u, 0u)); asm volatile("" : "+v"(lane_));
    int wid_ = wid_in; asm volatile("" : "+s"(wid_));
    const int wid = wid_, lane = lane_, tid = wid * 64 + lane, wr = wid >> 2, wc = wid & 3, fr = lane & 15, fq = lane >> 4;
    const int K = g.K, nt = K / BK;
    unsigned voffA[2], voffB[2];
#pragma unroll
    for (int i = 0; i < 2; ++i) { int R, C; stage_rc(tid * 16 + i * 8192, R, C); const int Rb = Epi::PERM ? ((R & ~31) + perm32(R & 31)) : R;
        voffA[i] = (unsigned)(R * g.lda + C) * 2u; voffB[i] = (unsigned)(Rb * g.ldb + C) * 2u; }
    const size_t kstep = (size_t)(BK * 2);
    const size_t hstepA = (size_t)HALF * g.lda * 2, hstepB = (size_t)HALF * g.ldb * 2;
    const size_t tstepA = 2 * hstepA, tstepB = 2 * hstepB;
    const unsigned ldsw = (unsigned)wid * 1024u;
    const int aoff = lds_byte(wr * 64 + fr, fq * 8), boff = lds_byte(wc * 32 + fr, fq * 8);
#define PG8_SA(b, h) (((b) * 2 + (h)) * HTB)
#define PG8_SB(b, h) ((4 + (b) * 2 + (h)) * HTB)
#define PG8_STAGE(bufoff, gbase, voff) do { _Pragma("unroll") for (int _i = 0; _i < 2; ++_i) \
        __builtin_amdgcn_global_load_lds((const unsigned*)((const char*)(gbase) + (voff)[_i]), (PG8_LAS unsigned*)(lds + (bufoff) + ldsw + _i * 8192), 16, 0, 0); } while (0)
#define PG8_LDA(dst, b, h) do { _Pragma("unroll") for (int m = 0; m < 4; ++m) _Pragma("unroll") for (int k = 0; k < 2; ++k) dst[m][k] = *(const PG8_LAS bf16x8*)(lds + PG8_SA(b, h) + aoff + m * 2048 + k * 1024); } while (0)
#define PG8_LDB(dst, b, h) do { _Pragma("unroll") for (int n = 0; n < 2; ++n) _Pragma("unroll") for (int k = 0; k < 2; ++k) dst[n][k] = *(const PG8_LAS bf16x8*)(lds + PG8_SB(b, h) + boff + n * 2048 + k * 1024); } while (0)
#define PG8_MMA(ai, bj, At, Bt) do { __builtin_amdgcn_s_setprio(1); _Pragma("unroll") for (int m = 0; m < 4; ++m) _Pragma("unroll") for (int n = 0; n < 2; ++n) _Pragma("unroll") for (int k = 0; k < 2; ++k) \
        acc[ai][bj][m][n] = __builtin_amdgcn_mfma_f32_16x16x32_bf16(Bt[n][k], At[m][k], acc[ai][bj][m][n], 0, 0, 0); __builtin_amdgcn_s_setprio(0); } while (0)
#define PG8_WAIT_V(n) asm volatile("s_waitcnt vmcnt(" #n ")" ::: "memory")
#define PG8_WAIT_L(n) asm volatile("s_waitcnt lgkmcnt(" #n ")" ::: "memory")
#define PG8_BAR __builtin_amdgcn_s_barrier()
#define PG8_SCHED __builtin_amdgcn_sched_barrier(0)
    Unit cur, nxt; int ui = 0;
    if (!S.next(0, cur)) return;
    f32x4 acc[2][2][4][2];
#pragma unroll
    for (int a = 0; a < 2; ++a)
#pragma unroll
        for (int b = 0; b < 2; ++b)
#pragma unroll
            for (int m = 0; m < 4; ++m)
#pragma unroll
                for (int n = 0; n < 2; ++n) acc[a][b][m][n] = (f32x4){0.f, 0.f, 0.f, 0.f};
    bf16x8 At[4][2], B0[2][2], B1[2][2];
    const char* cA = (const char*)g.A + (size_t)cur.pm * tstepA; const char* cB = (const char*)g.Bt + (size_t)cur.pn * tstepB;
    S.a_ready(cur);
    if constexpr (SP2) {
        PG8_STAGE(PG8_SB(0, 0), cB, voffB); PG8_STAGE(PG8_SB(0, 1), cB + hstepB, voffB); PG8_STAGE(PG8_SA(0, 0), cA, voffA); PG8_STAGE(PG8_SA(0, 1), cA + hstepA, voffA);
        if (wr == 1) PG8_BAR;
        PG8_WAIT_V(2); PG8_BAR;
        PG8_STAGE(PG8_SB(1, 0), cB + kstep, voffB); PG8_STAGE(PG8_SA(1, 0), cA + kstep, voffA); PG8_STAGE(PG8_SB(1, 1), cB + hstepB + kstep, voffB);
        PG8_WAIT_V(6); PG8_BAR;
    } else {
        PG8_STAGE(PG8_SB(0, 0), cB, voffB); PG8_STAGE(PG8_SA(0, 0), cA, voffA); PG8_STAGE(PG8_SB(0, 1), cB + hstepB, voffB); PG8_STAGE(PG8_SA(0, 1), cA + hstepA, voffA);
        if (wr == 1) PG8_BAR;
        PG8_WAIT_V(4); PG8_BAR;
        PG8_STAGE(PG8_SB(1, 0), cB + kstep, voffB); PG8_STAGE(PG8_SA(1, 0), cA + kstep, voffA); PG8_STAGE(PG8_SB(1, 1), cB + hstepB + kstep, voffB);
        PG8_WAIT_V(6); PG8_BAR;
    }
    for (;;) {
        const bool has_next = S.next(ui + 1, nxt);
        const char* nA = has_next ? (const char*)g.A + (size_t)nxt.pm * tstepA : cA; const char* nB = has_next ? (const char*)g.Bt + (size_t)nxt.pn * tstepB : cB;
        for (int t = 0; t < nt; t += 2) {
            const bool last = (t == nt - 2);
            const char* a1 = cA + (size_t)(t + 1) * kstep;
            const char* a2 = last ? nA : cA + (size_t)(t + 2) * kstep; const char* b2 = last ? nB : cB + (size_t)(t + 2) * kstep;
            const char* a3 = a2 + kstep; const char* b3 = b2 + kstep;
            if (last && has_next) S.a_ready(nxt);
            if constexpr (SP2) {
            PG8_LDB(B0, 0, 0); PG8_LDB(B1, 0, 1); PG8_SCHED; PG8_LDA(At, 0, 0); PG8_STAGE(PG8_SA(1, 1), a1 + hstepA, voffA);
            PG8_WAIT_V(8); PG8_WAIT_L(0); PG8_BAR; PG8_MMA(0, 0, At, B0); PG8_MMA(0, 1, At, B1); PG8_BAR; PG8_SCHED;
            PG8_LDA(At, 0, 1); PG8_STAGE(PG8_SB(0, 0), b2, voffB); PG8_STAGE(PG8_SB(0, 1), b2 + hstepB, voffB); PG8_STAGE(PG8_SA(0, 0), a2, voffA);
            PG8_WAIT_V(8); PG8_WAIT_L(0); PG8_BAR; PG8_MMA(1, 0, At, B0); PG8_MMA(1, 1, At, B1); PG8_BAR; PG8_SCHED;
            PG8_LDB(B0, 1, 0); PG8_LDB(B1, 1, 1); PG8_SCHED; PG8_LDA(At, 1, 0); PG8_STAGE(PG8_SA(0, 1), a2 + hstepA, voffA);
            PG8_WAIT_V(8); PG8_WAIT_L(0); PG8_BAR; PG8_MMA(0, 0, At, B0); PG8_MMA(0, 1, At, B1); PG8_BAR; PG8_SCHED;
            PG8_LDA(At, 1, 1); PG8_STAGE(PG8_SB(1, 0), b3, voffB); PG8_STAGE(PG8_SB(1, 1), b3 + hstepB, voffB); PG8_STAGE(PG8_SA(1, 0), a3, voffA);
            PG8_WAIT_V(8); PG8_WAIT_L(0); PG8_BAR; PG8_MMA(1, 0, At, B0); PG8_MMA(1, 1, At, B1); PG8_BAR; PG8_SCHED;
            } else {
            PG8_LDB(B0, 0, 0); PG8_SCHED; PG8_LDA(At, 0, 0); PG8_STAGE(PG8_SA(1, 1), a1 + hstepA, voffA);
            PG8_WAIT_L(8); PG8_BAR; PG8_WAIT_L(0); PG8_MMA(0, 0, At, B0); PG8_BAR; PG8_SCHED;
            PG8_LDB(B1, 0, 1); PG8_STAGE(PG8_SB(0, 0), b2, voffB);
            PG8_BAR; PG8_WAIT_L(0); PG8_MMA(0, 1, At, B1); PG8_BAR;
            PG8_LDA(At, 0, 1); PG8_STAGE(PG8_SA(0, 0), a2, voffA);
            PG8_BAR; PG8_WAIT_L(0); PG8_MMA(1, 0, At, B0); PG8_BAR; PG8_SCHED;
            PG8_STAGE(PG8_SB(0, 1), b2 + hstepB, voffB);
            PG8_WAIT_V(6); PG8_BAR; PG8_MMA(1, 1, At, B1); PG8_BAR;
            PG8_LDB(B0, 1, 0); PG8_SCHED; PG8_LDA(At, 1, 0); PG8_STAGE(PG8_SA(0, 1), a2 + hstepA, voffA);
            PG8_WAIT_L(8); PG8_BAR; PG8_WAIT_L(0); PG8_MMA(0, 0, At, B0); PG8_BAR; PG8_SCHED;
            PG8_LDB(B1, 1, 1); PG8_STAGE(PG8_SB(1, 0), b3, voffB);
            PG8_BAR; PG8_WAIT_L(0); PG8_MMA(0, 1, At, B1); PG8_BAR;
            PG8_LDA(At, 1, 1); PG8_STAGE(PG8_SA(1, 0), a3, voffA);
            PG8_BAR; PG8_WAIT_L(0); PG8_MMA(1, 0, At, B0); PG8_BAR; PG8_SCHED;
            PG8_STAGE(PG8_SB(1, 1), b3 + hstepB, voffB);
            PG8_WAIT_V(6); PG8_BAR; PG8_MMA(1, 1, At, B1); PG8_BAR;
            }
        }
        if constexpr (ALIGN_EPI) { if (wr == 0) PG8_BAR; }
        if constexpr (!Epi::AFTER_DRAIN) { E(acc, cur, wr, wc, fr, fq); S.done(cur); }
        if (!has_next) break;
#pragma unroll
        for (int a = 0; a < 2; ++a)
#pragma unroll
            for (int b = 0; b < 2; ++b)
#pragma unroll
                for (int m = 0; m < 4; ++m)
#pragma unroll
                    for (int n = 0; n < 2; ++n) acc[a][b][m][n] = (f32x4){0.f, 0.f, 0.f, 0.f};
        cur = nxt; cA = nA; cB = nB; ++ui;
        if constexpr (ALIGN_EPI) { if (wr == 1) PG8_BAR; }
    }
    PG8_WAIT_V(0);
    if constexpr (!ALIGN_EPI) { if (wr == 0) PG8_BAR; }
    PG8_BAR;
    if constexpr (Epi::AFTER_DRAIN) { E.fused(acc, cur, wr, wc, fr, fq, lds, wid, lane); S.done(cur); }
#undef PG8_SA
#undef PG8_SB
#undef PG8_STAGE
#undef PG8_LDA
#undef PG8_LDB
#undef PG8_MMA
#undef PG8_WAIT_V
#undef PG8_WAIT_L
#undef PG8_BAR
#undef PG8_SCHED
}
}

#include <hip/hip_bf16.h>
namespace attn_body {
using bf16=__hip_bfloat16;
using bf16x8=__attribute__((ext_vector_type(8)))short;
using s16x4=__attribute__((ext_vector_type(4)))short;
using f32x16=__attribute__((ext_vector_type(16)))float;
using u32x4=__attribute__((ext_vector_type(4)))unsigned;
constexpr int BATCH=8,NHEAD=8,SEQ=2048,D=64,DM=NHEAD*D;
constexpr int NW=8,QBLK=32,QB=QBLK*NW,KVBLK=64,NQB=SEQ/QB;
constexpr int ATTN_PITCH=DM, ATTN_UNIT_ROWS=QB;
__device__ __forceinline__ int crow(int r,int hi){return (r&3)+8*(r>>2)+4*hi;}
#define SBAR() __builtin_amdgcn_sched_barrier(0)
__device__ __forceinline__ void cmask(f32x16&p0,f32x16&p1,int jb,int qrel,int hi){
  const float NEG=-INFINITY; int kb=64*jb+4*hi;
  #pragma unroll
  for(int r=0;r<16;++r){int kv=kb+(r&3)+8*(r>>2); if(kv>qrel)p0[r]=NEG; if(kv+32>qrel)p1[r]=NEG;}
}

constexpr int NSLOT=3, SLOTB=8192;
constexpr int LDS_K=0, LDS_V=NSLOT*SLOTB, LDS_WS=2*NSLOT*SLOTB, LDS_OST=LDS_WS+NW*64*4, LDS_BYTES=LDS_OST+NW*4096;
constexpr float C2=0.125f*1.4426950408889634f;
__device__ __forceinline__ void glds16(const void*gsrc,unsigned lds_dst){unsigned keep;
  asm volatile("s_mov_b32 %0, m0\n\ts_mov_b32 m0, %2\n\ts_nop 0\n\tglobal_load_lds_dwordx4 %1, off\n\ts_mov_b32 m0, %0":"=&s"(keep):"v"(gsrc),"s"(lds_dst):"memory");}
__device__ __forceinline__ float max3f(float a,float b,float c){float r;asm("v_max3_f32 %0, %1, %2, %3":"=v"(r):"v"(a),"v"(b),"v"(c));return r;}
__device__ __forceinline__ float max2f(float a,float b){float r;asm("v_max_f32_e32 %0, %1, %2":"=v"(r):"v"(a),"v"(b));return r;}
__device__ __forceinline__ float fadd_s(float a,float b){float r;asm("v_add_f32_e32 %0, %1, %2":"=v"(r):"v"(a),"v"(b));return r;}
__device__ __forceinline__ float fsub_s(float a,float b){float r;asm("v_sub_f32_e32 %0, %1, %2":"=v"(r):"v"(a),"v"(b));return r;}
typedef float f32x2_t __attribute__((ext_vector_type(2))); typedef __bf16 bf16x2_t __attribute__((ext_vector_type(2)));
__device__ __forceinline__ unsigned cvtpk_s(float lo,float hi){f32x2_t v={lo,hi};bf16x2_t b=__builtin_convertvector(v,bf16x2_t);return __builtin_bit_cast(unsigned,b);}
#define WAIT_BAR(N) asm volatile("s_waitcnt vmcnt(" #N ") lgkmcnt(0)\n\ts_barrier":::"memory")

__device__ __forceinline__ void qkt(f32x16&p0,f32x16&p1,const char*Kslot,const bf16x8*qr,const f32x16&negm,int r32,int hi){
  const char*kb=Kslot+hi*1024+r32*16;
  #pragma unroll
  for(int d0=0;d0<4;++d0){
    const bf16x8 b0=*reinterpret_cast<const bf16x8*>(kb+d0*2048);
    const bf16x8 b1=*reinterpret_cast<const bf16x8*>(kb+d0*2048+512);
    if(d0==0){p0=__builtin_amdgcn_mfma_f32_32x32x16_bf16(b0,qr[0],negm,0,0,0);p1=__builtin_amdgcn_mfma_f32_32x32x16_bf16(b1,qr[0],negm,0,0,0);}
    else{p0=__builtin_amdgcn_mfma_f32_32x32x16_bf16(b0,qr[d0],p0,0,0,0);p1=__builtin_amdgcn_mfma_f32_32x32x16_bf16(b1,qr[d0],p1,0,0,0);}}
}
typedef __attribute__((address_space(3))) const char* lds_cptr;
typedef short v4i16_t __attribute__((ext_vector_type(4)));
__device__ __forceinline__ void kload8(bf16x8*kf,lds_cptr kp){
  kf[0]=*(const __attribute__((address_space(3))) bf16x8*)(kp);      kf[1]=*(const __attribute__((address_space(3))) bf16x8*)(kp+512);
  kf[2]=*(const __attribute__((address_space(3))) bf16x8*)(kp+2048); kf[3]=*(const __attribute__((address_space(3))) bf16x8*)(kp+2560);
  kf[4]=*(const __attribute__((address_space(3))) bf16x8*)(kp+4096); kf[5]=*(const __attribute__((address_space(3))) bf16x8*)(kp+4608);
  kf[6]=*(const __attribute__((address_space(3))) bf16x8*)(kp+6144); kf[7]=*(const __attribute__((address_space(3))) bf16x8*)(kp+6656);
}
__device__ __forceinline__ void kload2(bf16x8*kf,lds_cptr kp,int j){ kf[2*j]=*(const __attribute__((address_space(3))) bf16x8*)(kp+j*2048); kf[2*j+1]=*(const __attribute__((address_space(3))) bf16x8*)(kp+j*2048+512); }
__device__ __forceinline__ s16x4 vtr(lds_cptr p){ return __builtin_bit_cast(s16x4,__builtin_amdgcn_ds_read_tr16_b64_v4i16((__attribute__((address_space(3))) v4i16_t*)p)); }
__device__ __forceinline__ float rowmax(const f32x16&p0,const f32x16&p1){
  float a=max3f(p0[0],p0[1],p1[0]),b=max3f(p0[2],p0[3],p1[1]);a=max3f(a,p1[2],p1[3]);
  #pragma unroll
  for(int r=4;r<16;r+=4){a=max3f(a,p0[r],p0[r+1]);b=max3f(b,p0[r+2],p0[r+3]);a=max3f(a,p1[r],p1[r+1]);b=max3f(b,p1[r+2],p1[r+3]);}
  const float m=max2f(a,b);
  auto rr=__builtin_amdgcn_permlane32_swap(__float_as_uint(m),__float_as_uint(m),false,false);
  return max2f(__uint_as_float(rr[0]),__uint_as_float(rr[1]));
}
__device__ __forceinline__ void pv(f32x16*o,int vb,bf16x8 pa0,bf16x8 pa1,bf16x8 pa2,bf16x8 pa3){
  #pragma unroll
  for(int d0=0;d0<2;++d0){s16x4 lo[4],hi[4];
    #pragma unroll
    for(int ks=0;ks<4;++ks){
      asm volatile("ds_read_b64_tr_b16 %0,%1 offset:%c2":"=&v"(lo[ks]):"v"(vb),"i"(d0*4096+ks*1024):"memory");
      asm volatile("ds_read_b64_tr_b16 %0,%1 offset:%c2":"=&v"(hi[ks]):"v"(vb),"i"(d0*4096+ks*1024+512):"memory");}
    asm volatile("s_waitcnt lgkmcnt(0)":::"memory");SBAR();
    #define PK(k) (bf16x8){lo[k][0],lo[k][1],lo[k][2],lo[k][3],hi[k][0],hi[k][1],hi[k][2],hi[k][3]}
    o[d0]=__builtin_amdgcn_mfma_f32_32x32x16_bf16(pa0,PK(0),o[d0],0,0,0);
    o[d0]=__builtin_amdgcn_mfma_f32_32x32x16_bf16(pa1,PK(1),o[d0],0,0,0);
    o[d0]=__builtin_amdgcn_mfma_f32_32x32x16_bf16(pa2,PK(2),o[d0],0,0,0);
    o[d0]=__builtin_amdgcn_mfma_f32_32x32x16_bf16(pa3,PK(3),o[d0],0,0,0);
    #undef PK
  }
}

#ifndef ATTN_STORE16
#define ATTN_STORE16(p,v) (*(u32x4*)(p)=(v))
#endif
template<int THRL> __device__ __forceinline__ void attn_unit(int b,int h,int qb,const bf16*Q,const bf16*__restrict__ K,const bf16*__restrict__ V,bf16*O,int opitch,const float*__restrict__ KS,char*shm,const int wid){
  int lane_=__builtin_amdgcn_mbcnt_hi(~0u,__builtin_amdgcn_mbcnt_lo(~0u,0u)); asm volatile("":"+v"(lane_)); const int lane=lane_,r32=lane&31,hi=lane>>5;
  const long rowbase=(long)b*SEQ; const int q0=qb*QB;
  const bf16*Qw=Q+(rowbase+q0+wid*QBLK)*DM+h*D;
  const bf16*Kh=K+rowbase*DM+h*D,*Vh=V+rowbase*DM+h*D;
  const unsigned lds0=(unsigned)(uintptr_t)shm;
  float*wsf=(float*)(shm+LDS_WS)+wid*64;
  const bf16*ksrc=Kh+(long)lane*DM+wid*8;
  const bf16*vsrc=Vh+(long)(16*(wid&3)+(lane>>2))*DM+(wid>>2)*32+(lane&3)*8;
  const unsigned kdst=lds0+LDS_K+wid*1024, vdst=lds0+LDS_V+wid*1024;
  #define DMA_K(t,slot) glds16(ksrc+(long)(t)*KVBLK*DM,(unsigned)__builtin_amdgcn_readfirstlane(kdst+(slot)))
  #define DMA_V(t,slot) glds16(vsrc+(long)(t)*KVBLK*DM,(unsigned)__builtin_amdgcn_readfirstlane(vdst+(slot)))
  const int vb0=(int)(lds0+LDS_V)+((lane>>4)&1)*32+(lane&3)*8+(4*hi+((lane&15)>>2))*64;
  const char*Kbase=shm+LDS_K; bf16x8 kf[8];
  const lds_cptr shm3=(lds_cptr)shm; const lds_cptr kp0=shm3+LDS_K+hi*1024+r32*16; const lds_cptr vp0=shm3+LDS_V+((lane>>4)&1)*32+(lane&3)*8+(4*hi+((lane&15)>>2))*64;
  const int NT=(q0+QB)/KVBLK;
  DMA_K(0,0);DMA_V(0,0);DMA_K(1,SLOTB);
  bf16x8 qr[4];
  #pragma unroll
  for(int d0=0;d0<4;++d0)qr[d0]=*reinterpret_cast<const bf16x8*>(&Qw[(long)r32*DM+d0*16+hi*8]);
  unsigned selmask=(1u<<qb)-1u;
  if(qb>3){
    float sc[7];
    #pragma unroll
    for(int n=0;n<7;++n){ sc[n]=-INFINITY;
      if(n<qb){ const float*kp=KS+((long)(b*8+n)*DM+h*D+hi*8); float a=0.f;
        #pragma unroll
        for(int d0=0;d0<4;++d0){ const float4 k0=*reinterpret_cast<const float4*>(kp+d0*16),k1=*reinterpret_cast<const float4*>(kp+d0*16+4);
          #define QF(j) __uint_as_float(((unsigned)(unsigned short)qr[d0][j])<<16)
          a+=QF(0)*k0.x+QF(1)*k0.y+QF(2)*k0.z+QF(3)*k0.w+QF(4)*k1.x+QF(5)*k1.y+QF(6)*k1.z+QF(7)*k1.w;
          #undef QF
        }
        { auto rr=__builtin_amdgcn_permlane32_swap(__float_as_uint(a),__float_as_uint(a),false,false); a=__uint_as_float(rr[0])+__uint_as_float(rr[1]); } sc[n]=a; }
      asm volatile("":::"memory"); }
    selmask=0u;
    #pragma unroll
    for(int n=0;n<7;++n){ int rk=0;
      #pragma unroll
      for(int m2=0;m2<7;++m2){ if(m2!=n) rk+=(sc[m2]>sc[n]||(sc[m2]==sc[n]&&m2<n))?1:0; }
      if(n<qb&&rk<3)selmask|=(1u<<n); }
  }
  float mhat=0.f,l_reg=0.f;f32x16 o[2];o[0]=f32x16{};o[1]=f32x16{};const f32x16 negm=f32x16{};
  const int qrel=wid*QBLK+r32;
  #define CMASK(P0,P1,t) do{const int t_=(t); const int jb_=t_-(NT-4); if(jb_>=0)cmask(P0,P1,jb_,qrel,hi); else if(!((selmask>>(t_>>2))&1u)){ _Pragma("unroll") for(int r_=0;r_<16;++r_){P0[r_]=-INFINITY;P1[r_]=-INFINITY;} } }while(0)
  bool resc=false;
  #define START(P0,P1) do{ const float rm=rowmax(P0,P1); resc=false; \
    { const float dl=__builtin_fmaxf(rm,-100.f); mhat=fadd_s(mhat,dl); \
      _Pragma("unroll") for(int r=0;r<16;++r){P0[r]=fsub_s(P0[r],dl);P1[r]=fsub_s(P1[r],dl);} \
      } \
    _Pragma("unroll") for(int r=0;r<16;++r)P0[r]=__builtin_amdgcn_exp2f(P0[r]); }while(0)
  #define RESC() do{ if(resc){ asm volatile("s_waitcnt lgkmcnt(0)":::"memory"); \
      _Pragma("unroll") for(int d_=0;d_<2;++d_) _Pragma("unroll") for(int r=0;r<16;++r)o[d_][r]*=wsf[crow(r,hi)]; } }while(0)
  f32x16 pA0,pA1,pB0,pB1;
  int sl_prev=0,sl_cur=0,sl_next=SLOTB;
  #define ROT() do{sl_prev=sl_cur;sl_cur=sl_next;sl_next=(sl_next==(NSLOT-1)*SLOTB)?0:sl_next+SLOTB;}while(0)
  DMA_K(2,2*SLOTB);
  WAIT_BAR(3);
  qkt(pA0,pA1,Kbase,qr,negm,r32,hi);asm volatile("s_nop 15\n\ts_nop 7":"+v"(pA0),"+v"(pA1));CMASK(pA0,pA1,0);
  START(pA0,pA1);
  _Pragma("unroll") for(int r=0;r<16;++r)pA1[r]=__builtin_amdgcn_exp2f(pA1[r]);
  WAIT_BAR(0);
  DMA_K(3,0);DMA_V(1,SLOTB);
  ROT();
  kload8(kf,kp0+sl_cur);
  WAIT_BAR(2);
  s16x4 vlo[8],vhi[8]; u32x4 pw0,pw1,pw2,pw3;
  #define PKW(P,B) cvtpk_s(P[B],P[B+1])
  #define PAF(k) __builtin_bit_cast(bf16x8,pw##k)
  #define VFR(i) (bf16x8){vlo[i][0],vlo[i][1],vlo[i][2],vlo[i][3],vhi[i][0],vhi[i][1],vhi[i][2],vhi[i][3]}
  #define PIN(x) asm volatile("":"+v"(x))
  #define MX3(a,b,c) __builtin_fmaxf(__builtin_fmaxf((a),(b)),(c))
  #define GAPA(MF,A0,A1,A2,A3,W0,W1,PW) do{ MF; sacc+=A0; sacc+=A1; sacc+=A2; sacc+=A3; PIN(sacc); W0; W1; PIN(PW); SBAR(); }while(0)
  #define EX(v) __builtin_amdgcn_exp2f(v)
  #define GAPB(MF,X,B) do{ MF; X[B]=EX(X[B]); X[B+1]=EX(X[B+1]); X[B+2]=EX(X[B+2]); X[B+3]=EX(X[B+3]); PIN(X); SBAR(); }while(0)
  #define VRD(i) do{ vlo[i]=vtr(vp_+(((i)>>2)*4096+((i)&3)*1024)); vhi[i]=vtr(vp_+(((i)>>2)*4096+((i)&3)*1024+512)); }while(0)
  #define KRD(G,j) do{ if(G){ kload2(kf,kp0+sl_next,j); SBAR(); } }while(0)
  #define STEP(C0,C1,P0,P1,t,GK,GV,GL) do{ SBAR(); \
    const lds_cptr vp_=vp0+sl_prev; \
    VRD(0); SBAR(); float sacc=(P0[0]+P0[1]); \
    GAPA(C0=__builtin_amdgcn_mfma_f32_32x32x16_bf16(kf[0],qr[0],negm,0,0,0), P0[2],P0[3],P0[4],P0[5],     pw0[0]=PKW(P0,0), pw0[1]=PKW(P0,2), pw0); \
    VRD(4); SBAR(); GAPA(C1=__builtin_amdgcn_mfma_f32_32x32x16_bf16(kf[1],qr[0],negm,0,0,0), P0[6],P0[7],P0[8],P0[9],     pw0[2]=PKW(P0,4), pw0[3]=PKW(P0,6), pw0); \
    VRD(1); SBAR(); GAPA(C0=__builtin_amdgcn_mfma_f32_32x32x16_bf16(kf[2],qr[1],C0,0,0,0),   P0[10],P0[11],P0[12],P0[13], pw1[0]=PKW(P0,8), pw1[1]=PKW(P0,10), pw1); \
    VRD(5); SBAR(); GAPA(C1=__builtin_amdgcn_mfma_f32_32x32x16_bf16(kf[3],qr[1],C1,0,0,0),   P0[14],P0[15],P1[0],P1[1],   pw1[2]=PKW(P0,12),pw1[3]=PKW(P0,14), pw1); \
    VRD(2); SBAR(); GAPA(C0=__builtin_amdgcn_mfma_f32_32x32x16_bf16(kf[4],qr[2],C0,0,0,0),   P1[2],P1[3],P1[4],P1[5],     pw2[0]=PKW(P1,0), pw2[1]=PKW(P1,2), pw2); \
    VRD(6); SBAR(); GAPA(C1=__builtin_amdgcn_mfma_f32_32x32x16_bf16(kf[5],qr[2],C1,0,0,0),   P1[6],P1[7],P1[8],P1[9],     pw2[2]=PKW(P1,4), pw2[3]=PKW(P1,6), pw2); \
    VRD(3); SBAR(); GAPA(C0=__builtin_amdgcn_mfma_f32_32x32x16_bf16(kf[6],qr[3],C0,0,0,0),   P1[10],P1[11],P1[12],P1[13], pw3[0]=PKW(P1,8), pw3[1]=PKW(P1,10), pw3); \
    VRD(7); SBAR(); GAPA(C1=__builtin_amdgcn_mfma_f32_32x32x16_bf16(kf[7],qr[3],C1,0,0,0),   P1[14],P1[15],0.f,0.f,       pw3[2]=PKW(P1,12),pw3[3]=PKW(P1,14), pw3); \
    l_reg+=sacc; \
    if(GK){DMA_K((t)+3,sl_cur);} if(GV){DMA_V((t)+1,sl_next);} \
    _Pragma("unroll") for(int r=0;r<16;++r){C0[r]-=mhat;C1[r]-=mhat;} \
    CMASK(C0,C1,t); \
    { float a=MX3(C0[0],C0[1],C1[0]),b=MX3(C0[2],C0[3],C1[1]); a=MX3(a,C1[2],C1[3]); \
      _Pragma("unroll") for(int r=4;r<16;r+=4){a=MX3(a,C0[r],C0[r+1]);b=MX3(b,C0[r+2],C0[r+3]);a=MX3(a,C1[r],C1[r+1]);b=MX3(b,C1[r+2],C1[r+3]);} \
      float rm=__builtin_fmaxf(a,b); { auto rr=__builtin_amdgcn_permlane32_swap(__float_as_uint(rm),__float_as_uint(rm),false,false); rm=__builtin_fmaxf(__uint_as_float(rr[0]),__uint_as_float(rr[1])); } \
      resc=false; \
      if(__builtin_expect(__any(rm>(float)THRL),0)){ const float dl=__builtin_fmaxf(rm,0.f); mhat+=dl; \
        _Pragma("unroll") for(int r=0;r<16;++r){C0[r]-=dl;C1[r]-=dl;} \
        const float f=__builtin_amdgcn_exp2f(-dl); l_reg*=f; if(hi==0)wsf[r32]=f; resc=true; } } \
    SBAR(); \
    GAPB(o[0]=__builtin_amdgcn_mfma_f32_32x32x16_bf16(PAF(0),VFR(0),o[0],0,0,0), C0,0); \
    GAPB(o[1]=__builtin_amdgcn_mfma_f32_32x32x16_bf16(PAF(0),VFR(4),o[1],0,0,0), C0,4); \
    KRD(GL,0); GAPB(o[0]=__builtin_amdgcn_mfma_f32_32x32x16_bf16(PAF(1),VFR(1),o[0],0,0,0), C0,8); \
    KRD(GL,1); GAPB(o[1]=__builtin_amdgcn_mfma_f32_32x32x16_bf16(PAF(1),VFR(5),o[1],0,0,0), C0,12); \
    KRD(GL,2); GAPB(o[0]=__builtin_amdgcn_mfma_f32_32x32x16_bf16(PAF(2),VFR(2),o[0],0,0,0), C1,0); \
    KRD(GL,3); GAPB(o[1]=__builtin_amdgcn_mfma_f32_32x32x16_bf16(PAF(2),VFR(6),o[1],0,0,0), C1,4); \
    GAPB(o[0]=__builtin_amdgcn_mfma_f32_32x32x16_bf16(PAF(3),VFR(3),o[0],0,0,0), C1,8); \
    GAPB(o[1]=__builtin_amdgcn_mfma_f32_32x32x16_bf16(PAF(3),VFR(7),o[1],0,0,0), C1,12); \
    }while(0)
  int t=1;
  #undef CMASK
  #define CMASK(P0,P1,t) do{ if(!((selmask>>((t)>>2))&1u)){ _Pragma("unroll") for(int r_=0;r_<16;++r_){P0[r_]=-INFINITY;P1[r_]=-INFINITY;} } }while(0)
  for(;t+5<NT;t+=2){
    STEP(pB0,pB1,pA0,pA1,t,true,true,true);     WAIT_BAR(2); RESC(); ROT();
    STEP(pA0,pA1,pB0,pB1,t+1,true,true,true);   WAIT_BAR(2); RESC(); ROT();
  }
  #undef CMASK
  int qrel2=qrel,hi2=hi; asm volatile("":"+v"(qrel2),"+v"(hi2));
  #define CMASK(P0,P1,t) do{const int t_=(t); const int jb_=t_-(NT-4); if(jb_>=0)cmask(P0,P1,jb_,qrel2,hi2); else if(!((selmask>>(t_>>2))&1u)){ _Pragma("unroll") for(int r_=0;r_<16;++r_){P0[r_]=-INFINITY;P1[r_]=-INFINITY;} } }while(0)
  #define ENDW(tt) do{ if((tt)+3<NT){WAIT_BAR(2);} else if((tt)+2<NT){WAIT_BAR(1);} else {WAIT_BAR(0);} }while(0)
  for(;t+1<NT;t+=2){
    STEP(pB0,pB1,pA0,pA1,t,(t+3<NT),(t+1<NT),(t+1<NT));       ENDW(t);   RESC(); ROT();
    STEP(pA0,pA1,pB0,pB1,t+1,(t+4<NT),(t+2<NT),(t+2<NT));     ENDW(t+1); RESC(); ROT();
  }
  STEP(pB0,pB1,pA0,pA1,NT-1,false,false,false); RESC();
  { float sacc=pB0[0]+pB0[1]; _Pragma("unroll") for(int r=2;r<16;++r)sacc+=pB0[r]; _Pragma("unroll") for(int r=0;r<16;++r)sacc+=pB1[r]; l_reg+=sacc;
    pw0=(u32x4){PKW(pB0,0),PKW(pB0,2),PKW(pB0,4),PKW(pB0,6)};pw1=(u32x4){PKW(pB0,8),PKW(pB0,10),PKW(pB0,12),PKW(pB0,14)};pw2=(u32x4){PKW(pB1,0),PKW(pB1,2),PKW(pB1,4),PKW(pB1,6)};pw3=(u32x4){PKW(pB1,8),PKW(pB1,10),PKW(pB1,12),PKW(pB1,14)};
    SBAR(); pv(o,vb0+sl_cur,PAF(0),PAF(1),PAF(2),PAF(3)); }
  #undef PKW
  #undef PAF
  #undef VFR
  #undef PIN
  #undef MX3
  #undef GAPA
  #undef GAPB
  #undef EX
  #undef VRD
  #undef KRD
  #undef STEP
  #undef ENDW
  {auto rr=__builtin_amdgcn_permlane32_swap(__float_as_uint(l_reg),__float_as_uint(l_reg),false,false);l_reg=__uint_as_float(rr[0])+__uint_as_float(rr[1]);}
  if(hi==0)wsf[32+r32]=l_reg;asm volatile("s_waitcnt lgkmcnt(0)":::"memory");
  float rli[16];
  #pragma unroll
  for(int r=0;r<16;++r)rli[r]=__builtin_amdgcn_rcpf(wsf[32+crow(r,hi)]);
  bf16*Ow=O+(rowbase+q0+wid*QBLK)*(long)opitch+h*D;
  { bf16*stg=(bf16*)(shm+LDS_OST)+wid*2048;
    #pragma unroll
    for(int r=0;r<16;++r){const int orow=crow(r,hi);
      #pragma unroll
      for(int d0=0;d0<2;++d0)stg[orow*64+d0*32+r32]=__float2bfloat16(o[d0][r]*rli[r]);}
    asm volatile("s_waitcnt lgkmcnt(0)":::"memory");
    #pragma unroll
    for(int i=0;i<4;++i){const int row=i*8+(lane>>3),ch=lane&7; const u32x4 v=*(const u32x4*)(stg+row*64+ch*8); ATTN_STORE16(Ow+(long)row*opitch+ch*8,v);} }
  asm volatile("s_waitcnt lgkmcnt(0)\n\ts_barrier":::"memory");
  #undef DMA_K
  #undef DMA_V
  #undef CMASK
  #undef START
  #undef RESC
  #undef ROT
}
constexpr int ATTN_LDS_BYTES=LDS_BYTES;
struct AttnTensors { const bf16* Q; const bf16* K; const bf16* V; bf16* O; int opitch; const float* KS; };
#undef SBAR
#undef WAIT_BAR
}
constexpr int NWAVES = 8;
#ifndef MK_N_LAUNCHES
#define MK_N_LAUNCHES 1
#endif
constexpr int N_LAUNCHES = MK_N_LAUNCHES;
constexpr int PER_PHASE = 10;

constexpr int D = 1024, NBATCH = 8, SEQ = 2048, MP = NBATCH * SEQ, NS = 128, MALL = MP + 256, NPAN = MALL / 256;
constexpr int MEMR = 2048, XNROWS = MALL + MEMR;
constexpr int FF = 4096, PW = 512, AW = 512, NH = 8, HD = 64, PST = 15, NPAGES = 16, PAGE = 128;
constexpr float EPS = 1e-6f;
constexpr float CROSS_C2 = 0.0625f * 1.4426950408889634f;
constexpr size_t O_YP = 0, O_YS = O_YP + (size_t)MP * D, O_KP = O_YS + (size_t)NS * D, O_VP = O_KP + (size_t)MP * AW, O_POOLP = O_VP + (size_t)MP * AW,
                 O_MK = O_POOLP + (size_t)NBATCH * PST * PW, O_MV = O_MK + (size_t)MEMR * D, O_KS = O_MV + (size_t)MEMR * D, O_VS = O_KS + (size_t)NS * AW, O_POOLS = O_VS + (size_t)NS * AW,
                 O_END = O_POOLS + (size_t)NS * PST * PW;
static_assert(O_END == 39055360, "output size");

constexpr size_t MiB = 1u << 20;
constexpr size_t WS_CTL = 0, CTL_ZERO_BYTES = 1 * MiB;
constexpr size_t WS_WIN = 2 * MiB;
constexpr size_t WS_WOUT = 10 * MiB, WS_WCQ = 12 * MiB, WS_WCO = 14 * MiB;
constexpr size_t WS_WUP = 16 * MiB;
constexpr size_t WS_WDN = 24 * MiB;
constexpr size_t WS_WPOOL = 32 * MiB;
constexpr size_t WS_ROPE = 33 * MiB;
constexpr size_t WS_SACC = 516 * MiB;
constexpr size_t SA_PS = 0, SA_A1 = 1 * MiB, SA_AQ = SA_A1 + 512 * 1024, SA_A3 = SA_AQ + 512 * 1024, SA_AD = SA_A3 + 512 * 1024, SACC_BYTES = 3 * MiB;
constexpr size_t WS_HBS = 351 * MiB;
constexpr size_t WS_XN = 36 * MiB;
constexpr size_t WS_U = 74 * MiB, WS_Q = 91 * MiB, WS_K = 108 * MiB, WS_V = 125 * MiB;
constexpr size_t WS_MIX = 142 * MiB;
constexpr size_t WS_XB = 176 * MiB;
constexpr size_t WS_XG = 242 * MiB;
constexpr size_t WS_QC = 276 * MiB;
constexpr size_t WS_OC = 310 * MiB;
constexpr size_t WS_MKB = 343 * MiB;
constexpr size_t WS_MVT = 347 * MiB;
constexpr size_t WS_PB = 352 * MiB;
constexpr size_t WS_HB = 384 * MiB;
constexpr size_t WS_END = 520 * MiB;
constexpr size_t WS_DUMMY = 520 * MiB;
static_assert(WS_XN + (size_t)XNROWS * D * 2 <= WS_U && WS_V + (size_t)MALL * 512 * 2 <= WS_MIX && WS_MIX + (size_t)MALL * D * 2 <= WS_XB && WS_XB + (size_t)MP * D * 2 <= WS_XG &&
              WS_XG + (size_t)MALL * D * 2 <= WS_QC && WS_QC + (size_t)MALL * D * 2 <= WS_OC && WS_OC + (size_t)MALL * D * 2 <= WS_MKB && WS_MKB + 4 * MiB <= WS_MVT && WS_MVT + 4 * MiB <= WS_HBS && WS_HBS + MiB <= WS_PB && WS_HB + (size_t)MALL * FF * 2 <= WS_SACC && WS_SACC + SACC_BYTES <= WS_END, "d_ws map");
constexpr int CW_TMO = 0, CW_CODE = 1;
constexpr int CW_Q2 = 256, CW_Q5 = 512;
constexpr int CW_BAR = 4096;
constexpr int CW_KSUM = 16384;
constexpr int CW_SS1 = 49152, CW_SS2 = CW_SS1 + 16896, CW_SS3 = CW_SS2 + 16896;
constexpr int CW_SSD = CW_SS3 + 16896;
static_assert((CW_SSD + 16896) * 4 <= (int)CTL_ZERO_BYTES && CW_KSUM + 8 * 8 * 512 <= CW_SS1, "CTL words inside the memset region");

constexpr int RING_OFF = 0, RING_BYTES = 131072;
constexpr int LDSCTL_OFF = RING_BYTES, MISC_OFF = LDSCTL_OFF + 320;
constexpr int LDS_BYTES = 147456;
static_assert(MISC_OFF + 128 <= LDS_BYTES, "LDS map");

#define GAS __attribute__((address_space(1)))
#define LAS __attribute__((address_space(3)))
typedef unsigned short bf16;
typedef unsigned v4u __attribute__((ext_vector_type(4)));
typedef unsigned v2u __attribute__((ext_vector_type(2)));
typedef float f32x4 __attribute__((ext_vector_type(4)));
typedef short bf16x8 __attribute__((ext_vector_type(8)));
typedef GAS unsigned gu32;
typedef GAS unsigned long long gu64;
#define RLX_AGENT __ATOMIC_RELAXED, __HIP_MEMORY_SCOPE_AGENT
#define LDS_WAIT() asm volatile("s_waitcnt lgkmcnt(0)" ::: "memory")
#define VM_WAIT() asm volatile("s_waitcnt vmcnt(0)" ::: "memory")
__device__ __forceinline__ unsigned f2bf(float f) { unsigned u = __builtin_bit_cast(unsigned, f); return (u + 0x7fffu + ((u >> 16) & 1u)) >> 16; }
__device__ __forceinline__ unsigned pk2(float lo, float hi) { return f2bf(lo) | (f2bf(hi) << 16); }
__device__ __forceinline__ float bf2f(unsigned short b) { return __uint_as_float(((unsigned)b) << 16); }

#define XB_TMO      128
#define XB_XCNT(j)  (256  + 64 * (j))
#define XB_XSUB(j)  (1280 + 64 * (j))
#define XB_XGEN(j)  (2304 + 64 * (j))
#define XB_TOP      3328
#define XB_TOPGEN   3392
#define XCD_BAR_WORDS 3456
#define XB_SPIN_CAP (1u << 18)

__device__ __forceinline__ unsigned xb_ld(unsigned* p)              { return __hip_atomic_load(p, __ATOMIC_RELAXED, __HIP_MEMORY_SCOPE_AGENT); }
__device__ __forceinline__ unsigned xb_add(unsigned* p, unsigned v) { return __hip_atomic_fetch_add(p, v, __ATOMIC_RELAXED, __HIP_MEMORY_SCOPE_AGENT); }
__device__ __forceinline__ unsigned xb_xcc_id() { return (unsigned)__builtin_amdgcn_s_getreg((3 << 11) | 20) & 0xFu; }
#define XB_SPIN(cond, bar) do { unsigned _sp = 0; while (cond) { __builtin_amdgcn_s_sleep(1); \
    if ((++_sp & 255u) == 0u) { if (xb_ld(&(bar)[XB_TMO])) break; if (_sp > XB_SPIN_CAP) { atomicAdd(&(bar)[XB_TMO], 1u); break; } } } } while (0)

struct XcdBarrier {
    unsigned* bar; unsigned x;
    int wave;
    volatile LAS unsigned* st;
};

__device__ __forceinline__ bool xb_thread0(int wave) { return wave == 0 && __builtin_amdgcn_mbcnt_hi(~0u, __builtin_amdgcn_mbcnt_lo(~0u, 0u)) == 0u; }
__device__ __forceinline__ XcdBarrier xcd_barrier_post(unsigned* bar, volatile LAS unsigned* st, int wave) {
    XcdBarrier b; b.bar = bar; b.x = xb_xcc_id(); b.st = st; b.wave = wave;
    if (xb_thread0(wave)) (void)xb_add(&bar[XB_XCNT(b.x)], 1u);
    return b;
}
__device__ __forceinline__ void xcd_barrier_complete(unsigned* bar, unsigned x, unsigned& nloc, unsigned& nx) {
    const unsigned G = gridDim.x * gridDim.y * gridDim.z;
    unsigned sum, cnt, mine, sp = 0u;
    for (;;) {
        sum = 0u; cnt = 0u; mine = 0u;
#pragma unroll
        for (unsigned j = 0; j < 16; ++j) { const unsigned c = xb_ld(&bar[XB_XCNT(j)]); sum += c; cnt += (c > 0u) ? 1u : 0u; mine = (j == x) ? c : mine; }
        if (sum == G) break;
        __builtin_amdgcn_s_sleep(1);
        if ((++sp & 255u) == 0u) { if (xb_ld(&bar[XB_TMO])) break; if (sp > XB_SPIN_CAP) { atomicAdd(&bar[XB_TMO], 1u); break; } }
    }
    nloc = mine > 0u ? mine : 1u; nx = cnt > 0u ? cnt : 1u;
}

__device__ __forceinline__ void xcd_barrier(const XcdBarrier& b) {
    asm volatile("s_waitcnt vmcnt(0)" ::: "memory");
    __syncthreads();
    if (xb_thread0(b.wave)) {
        unsigned* bar = b.bar;
        __builtin_amdgcn_s_waitcnt(0);
        unsigned nloc = b.st[0], nx = b.st[1];
        if (nloc == 0u) { xcd_barrier_complete(bar, b.x, nloc, nx); b.st[0] = nloc; b.st[1] = nx; }
        const unsigned old = xb_add(&bar[XB_XSUB(b.x)], 1u);
        const unsigned gen = old / nloc;
        if (old + 1u == (gen + 1u) * nloc) {
            __builtin_amdgcn_fence(__ATOMIC_RELEASE, "agent");
            asm volatile("s_waitcnt vmcnt(0)" ::: "memory");
            const unsigned og = xb_add(&bar[XB_TOP], 1u);
            const unsigned tg = og / nx;
            if (og + 1u == (tg + 1u) * nx) xb_add(&bar[XB_TOPGEN], 1u);
            else XB_SPIN(xb_ld(&bar[XB_TOPGEN]) == tg, bar);
            __builtin_amdgcn_fence(__ATOMIC_ACQUIRE, "agent");
            xb_add(&bar[XB_XGEN(b.x)], 1u);
            asm volatile("s_waitcnt vmcnt(0)" ::: "memory");
        } else {
            XB_SPIN(xb_ld(&bar[XB_XGEN(b.x)]) == gen, bar);
            __builtin_amdgcn_fence(__ATOMIC_ACQUIRE, "agent");
            asm volatile("s_waitcnt vmcnt(0)" ::: "memory");
        }
    }
    __syncthreads();
}


struct Args { const void* in[24]; float* out; unsigned char* ws; int ph_lo, ph_hi; };
struct Frame {
    LAS unsigned char* lds;
    volatile LAS unsigned* MISC;
    gu32* ctl;
    int wave;
    int vcu, G;
    float* out;
    unsigned char* ws;
};
#define WSP(T, off) ((T*)(F.ws + (off)))
__device__ __forceinline__ int LANE() { return (int)__builtin_amdgcn_mbcnt_hi(~0u, __builtin_amdgcn_mbcnt_lo(~0u, 0u)); }
#define TID(F) ((F).wave * 64 + LANE())

__device__ __forceinline__ float xshfl(float v, int m, int lane) { return __builtin_bit_cast(float, __builtin_amdgcn_ds_bpermute((lane ^ m) << 2, __builtin_bit_cast(int, v))); }
__device__ __forceinline__ float wave_sum(float v, int lane) {
#pragma unroll
    for (int o = 1; o < 64; o <<= 1) v += xshfl(v, o, lane);
    return v;
}
__device__ __forceinline__ float wave_max(float v, int lane) {
#pragma unroll
    for (int o = 1; o < 64; o <<= 1) v = __builtin_fmaxf(v, xshfl(v, o, lane));
    return v;
}
__device__ __forceinline__ int win_dst_row(int n) { if (n < 512 || n >= 1536) return n; const int t = n & ~255, j = n & 255, hh = j >> 6, p = (j >> 5) & 1, i = j & 31; return t + 128 * p + 32 * hh + i; }
template <bool WINPERM> __device__ __forceinline__ void p0_transpose_item(const float* W, int K, int N, bf16* WT, int row_off, LAS float* scr, int item, int lane, const float* kgain = nullptr) {
    const int nblk = N / 32, kb = item / nblk, nb = item % nblk, k0 = 64 * kb, n0 = 32 * nb;
    float wv[32];
#pragma unroll
    for (int i = 0; i < 32; ++i) { const int kk = 2 * i + (lane >> 5); wv[i] = W[(size_t)(k0 + kk) * N + n0 + (lane & 31)]; }
    if (kgain) {
#pragma unroll
        for (int i = 0; i < 32; ++i) wv[i] *= kgain[k0 + 2 * i + (lane >> 5)]; }
#pragma unroll
    for (int i = 0; i < 32; ++i) { const int kk = 2 * i + (lane >> 5); scr[kk * 33 + (lane & 31)] = wv[i]; }
    LDS_WAIT(); asm volatile("" ::: "memory");
    const int c = lane & 7;
#pragma unroll
    for (int j = 0; j < 4; ++j) { const int n = (lane >> 3) + 8 * j; const LAS float* s = scr + (8 * c) * 33 + n;
        v4u o; o.x = pk2(s[0 * 33], s[1 * 33]); o.y = pk2(s[2 * 33], s[3 * 33]); o.z = pk2(s[4 * 33], s[5 * 33]); o.w = pk2(s[6 * 33], s[7 * 33]);
        const int drow = WINPERM ? win_dst_row(n0 + n) : (n0 + n);
        *(GAS v4u*)(WT + (size_t)(row_off + drow) * K + k0 + 8 * c) = o; }
    LDS_WAIT(); asm volatile("" ::: "memory");
}
__device__ __forceinline__ void rms_row_to_bf16(int lane, const float* xrow, const float* gain, bf16* orow, bf16* rawrow = nullptr) {
    const GAS f32x4* xr = (const GAS f32x4*)xrow + lane; const GAS f32x4* gr = (const GAS f32x4*)gain + lane;
    f32x4 v[4]; float s = 0.f;
#pragma unroll
    for (int j = 0; j < 4; ++j) { v[j] = xr[64 * j]; s += (v[j].x * v[j].x + v[j].y * v[j].y) + (v[j].z * v[j].z + v[j].w * v[j].w); }
    const float rstd = 1.f / sqrtf(wave_sum(s, lane) * (1.f / D) + EPS);
    GAS unsigned long long* o8 = (GAS unsigned long long*)orow + lane;
    if (rawrow) { GAS unsigned long long* r8 = (GAS unsigned long long*)rawrow + lane;
#pragma unroll
        for (int j = 0; j < 4; ++j) r8[64 * j] = (unsigned long long)pk2(v[j].x, v[j].y) | ((unsigned long long)pk2(v[j].z, v[j].w) << 32); }
#pragma unroll
    for (int j = 0; j < 4; ++j) { const f32x4 g = gr[64 * j]; o8[64 * j] = (unsigned long long)pk2(v[j].x * rstd * g.x, v[j].y * rstd * g.y) | ((unsigned long long)pk2(v[j].z * rstd * g.z, v[j].w * rstd * g.w) << 32); }
}
__device__ __forceinline__ void p0_prologue(Frame& F, const Args& A) {
    LAS float* scr = (LAS float*)(F.lds + RING_OFF + F.wave * 16384);
    const int gw = F.vcu * NWAVES + F.wave, NGW = F.G * NWAVES;
    bf16* WIN = WSP(bf16, WS_WIN);
    constexpr int I_IN = (D / 64) * (2048 / 32), I_SQ = (D / 64) * (D / 32), I_UP = (D / 64) * (FF / 32), I_DN = (FF / 64) * (D / 32), I_PL = (128 / 64) * (128 / 32);
    constexpr int NITEMS = I_IN + 5 * I_SQ + I_UP + I_DN + 4 * I_PL;
    for (int it = gw; it < NITEMS; it += NGW) {
        int r = it;
        if (r < I_IN) { p0_transpose_item<true>(((const float*)A.in[10]), D, 2048, WIN, 0, scr, r, LANE()); continue; } r -= I_IN;
        if (r < I_SQ) { p0_transpose_item<false>(((const float*)A.in[17]), D, D, WIN, 2048, scr, r, LANE()); continue; } r -= I_SQ;
        if (r < I_SQ) { p0_transpose_item<false>(((const float*)A.in[18]), D, D, WIN, 3072, scr, r, LANE()); continue; } r -= I_SQ;
        if (r < I_SQ) { p0_transpose_item<false>(((const float*)A.in[13]), D, D, WSP(bf16, WS_WOUT), 0, scr, r, LANE()); continue; } r -= I_SQ;
        if (r < I_SQ) { p0_transpose_item<false>(((const float*)A.in[16]), D, D, WSP(bf16, WS_WCQ), 0, scr, r, LANE(), ((const float*)A.in[14])); continue; }     r -= I_SQ;
        if (r < I_SQ) { p0_transpose_item<false>(((const float*)A.in[19]), D, D, WSP(bf16, WS_WCO), 0, scr, r, LANE()); continue; } r -= I_SQ;
        if (r < I_UP) { p0_transpose_item<false>(((const float*)A.in[21]), D, FF, WSP(bf16, WS_WUP), 0, scr, r, LANE(), ((const float*)A.in[20])); continue; }     r -= I_UP;
        if (r < I_DN) { p0_transpose_item<false>(((const float*)A.in[22]), FF, D, WSP(bf16, WS_WDN), 0, scr, r, LANE()); continue; } r -= I_DN;
        { const int g = r / I_PL; p0_transpose_item<false>(((const float*)A.in[11]) + (size_t)g * 128 * 128, 128, 128, WSP(bf16, WS_WPOOL) + (size_t)g * 128 * 128, 0, scr, r % I_PL, LANE()); }
    }
    bf16* XN = WSP(bf16, WS_XN);
    for (int m = gw; m < MP; m += 2 * NGW) { const int m2 = m + NGW; const int lane = LANE();
        const GAS f32x4* xa = (const GAS f32x4*)(((const float*)A.in[0]) + (size_t)m * D) + lane; const GAS f32x4* xb = (const GAS f32x4*)(((const float*)A.in[0]) + (size_t)(m2 < MP ? m2 : m) * D) + lane;
        const GAS f32x4* gr = (const GAS f32x4*)((const float*)A.in[9]) + lane;
        f32x4 va[4], vb[4]; float sa = 0.f, sb = 0.f;
#pragma unroll
        for (int j = 0; j < 4; ++j) { va[j] = xa[64 * j]; vb[j] = xb[64 * j]; }
#pragma unroll
        for (int j = 0; j < 4; ++j) { sa += (va[j].x * va[j].x + va[j].y * va[j].y) + (va[j].z * va[j].z + va[j].w * va[j].w); sb += (vb[j].x * vb[j].x + vb[j].y * vb[j].y) + (vb[j].z * vb[j].z + vb[j].w * vb[j].w); }
        const float ra = 1.f / sqrtf(wave_sum(sa, lane) * (1.f / D) + EPS), rb = 1.f / sqrtf(wave_sum(sb, lane) * (1.f / D) + EPS);
        GAS unsigned long long* oa = (GAS unsigned long long*)(XN + (size_t)m * D) + lane; GAS unsigned long long* ra8 = (GAS unsigned long long*)(WSP(bf16, WS_XB) + (size_t)m * D) + lane;
#pragma unroll
        for (int j = 0; j < 4; ++j) { const f32x4 g = gr[64 * j]; oa[64 * j] = (unsigned long long)pk2(va[j].x * ra * g.x, va[j].y * ra * g.y) | ((unsigned long long)pk2(va[j].z * ra * g.z, va[j].w * ra * g.w) << 32);
            ra8[64 * j] = (unsigned long long)pk2(va[j].x, va[j].y) | ((unsigned long long)pk2(va[j].z, va[j].w) << 32); }
        if (m2 < MP) { GAS unsigned long long* ob = (GAS unsigned long long*)(XN + (size_t)m2 * D) + lane; GAS unsigned long long* rb8 = (GAS unsigned long long*)(WSP(bf16, WS_XB) + (size_t)m2 * D) + lane;
#pragma unroll
            for (int j = 0; j < 4; ++j) { const f32x4 g = gr[64 * j]; ob[64 * j] = (unsigned long long)pk2(vb[j].x * rb * g.x, vb[j].y * rb * g.y) | ((unsigned long long)pk2(vb[j].z * rb * g.z, vb[j].w * rb * g.w) << 32);
                rb8[64 * j] = (unsigned long long)pk2(vb[j].x, vb[j].y) | ((unsigned long long)pk2(vb[j].z, vb[j].w) << 32); } }
    }
    for (int m = MP + gw; m < XNROWS; m += NGW) {
        if (m < MP + NS) rms_row_to_bf16(LANE(), ((const float*)A.in[1]) + (size_t)(m - MP) * D, ((const float*)A.in[9]), XN + (size_t)m * D);
        else if (m < MALL) { GAS unsigned long long* o8 = (GAS unsigned long long*)(XN + (size_t)m * D) + LANE(); o8[0] = 0ull; o8[64] = 0ull; o8[128] = 0ull; o8[192] = 0ull; }
        else rms_row_to_bf16(LANE(), ((const float*)A.in[8]) + (size_t)(m - MALL) * D, ((const float*)A.in[15]), XN + (size_t)m * D);
    }
    { float* rc = WSP(float, WS_ROPE); float* rs = rc + 2049 * 32; const int gt = F.vcu * (NWAVES * 64) + TID(F), NT = F.G * NWAVES * 64;
      for (int e = gt; e < 2049 * 32; e += NT) { const int pos = e >> 5, i = e & 31; const float invf = exp2f(-(float)i * (13.287712379549449f / 32.0f)); const double a = (double)pos * (double)invf; const double kq = __builtin_rint(a * 0.15915494309189535); const float rr = (float)(a - kq * 6.283185307179586); rc[e] = cosf(rr); rs[e] = sinf(rr); }
      { GAS f32x4* z = (GAS f32x4*)WSP(float, WS_SACC); for (int e = gt; e < (int)(SACC_BYTES / 16); e += NT) z[e] = (f32x4){0.f, 0.f, 0.f, 0.f}; }
      const GAS f32x4* sp = (const GAS f32x4*)((const float*)A.in[6]); GAS f32x4* po = (GAS f32x4*)(F.out + O_POOLS);
      for (int e = gt; e < NS * 14 * (PW / 4); e += NT) { const int s = e / (14 * 128), r = (e / 128) % 14, c = e & 127; po[(s * 15 + r) * 128 + c] = sp[(s * 15 + r + 1) * 128 + c]; } }
}
constexpr int POOL_LD = 136;
__device__ __forceinline__ void pool_mma_store(Frame& F, const Args& A, int row0, int g) {
    const LAS unsigned char* DB = F.lds + RING_OFF + 40960;
    const int fr = LANE() & 15, fq = LANE() >> 4, w = F.wave;
    const bf16* WP = WSP(bf16, WS_WPOOL) + (size_t)g * 128 * 128;
    f32x4 acc[8]; bf16x8 bw[4][8];
#pragma unroll
    for (int ks = 0; ks < 4; ++ks)
#pragma unroll
        for (int nb = 0; nb < 8; ++nb) bw[ks][nb] = *(const GAS bf16x8*)(WP + (size_t)(nb * 16 + fr) * 128 + ks * 32 + 8 * fq);
#pragma unroll
    for (int nb = 0; nb < 8; ++nb) acc[nb] = (f32x4){0.f, 0.f, 0.f, 0.f};
#pragma unroll
    for (int ks = 0; ks < 4; ++ks) {
        const bf16x8 a = *(const LAS bf16x8*)(DB + ((16 * w + fr) * POOL_LD + ks * 32 + 8 * fq) * 2);
#pragma unroll
        for (int nb = 0; nb < 8; ++nb) acc[nb] = __builtin_amdgcn_mfma_f32_16x16x32_bf16(bw[ks][nb], a, acc[nb], 0, 0, 0);
    }
    bf16* MIX = WSP(bf16, WS_MIX);
#pragma unroll
    for (int nb = 0; nb < 8; ++nb) { const int col = g * 128 + nb * 16 + 4 * fq; const f32x4 sp = *(const GAS f32x4*)(((const float*)A.in[12]) + col); const f32x4 v = acc[nb] * sp;
        v2u o; o.x = pk2(v[0], v[1]); o.y = pk2(v[2], v[3]); *(GAS v2u*)(MIX + (size_t)(row0 + 16 * w + fr) * D + col) = o; }
}
__device__ __forceinline__ void pool_unit(Frame& F, const Args& A, int L) {
    LAS unsigned short* UB = (LAS unsigned short*)(F.lds + RING_OFF);
    LAS unsigned short* DB = (LAS unsigned short*)(F.lds + RING_OFF + 40960);
    const int c = TID(F) & 127, strip = TID(F) >> 7;
    if (L < 512) {
        const int pnl = L >> 2, g = L & 3, r0 = pnl * 128, w = 2 << g; const bool first = (r0 & (SEQ - 1)) == 0;
        const bf16* U = WSP(bf16, WS_U);
        for (int e = TID(F); e < 144 * 16; e += NWAVES * 64) { const int rr = e >> 4, ch = e & 15; v4u v = {0u, 0u, 0u, 0u};
            if (!(first && rr < 16)) v = *(const GAS v4u*)(U + (size_t)(r0 - 16 + rr) * PW + g * 128 + ch * 8);
            *(LAS v4u*)(UB + rr * POOL_LD + ch * 8) = v; }
        LDS_WAIT(); __syncthreads();
        const int rs = strip * 32; float s = 0.f;
        for (int j = 1; j < w; ++j) s += bf2f(UB[(16 + rs - j) * POOL_LD + c]);
        const int pos0 = (r0 & (SEQ - 1)) + rs; const float invw = 1.0f / (float)w;
        for (int r = 0; r < 32; ++r) { const float uv = bf2f(UB[(16 + rs + r) * POOL_LD + c]); s += uv; const int pos = pos0 + r;
            const float inv = (pos + 1 >= w) ? invw : 1.0f / (float)(pos + 1);
            DB[(rs + r) * POOL_LD + c] = (unsigned short)f2bf(s * inv - uv); s -= bf2f(UB[(16 + rs + r - w + 1) * POOL_LD + c]); }
        LDS_WAIT(); __syncthreads();
        pool_mma_store(F, A, r0, g);
    } else {
        const int g = L - 512, w = 2 << g; const float invw = 1.0f / (float)w;
        const float* ps = WSP(float, WS_SACC + SA_PS);
        for (int r = 0; r < 32; ++r) { const int smp = strip * 32 + r; const float uv = ps[(size_t)smp * 2048 + g * 128 + c]; float s = uv;
            F.out[O_POOLS + (size_t)(smp * 15 + 14) * PW + g * 128 + c] = uv;
            for (int j = 1; j < w; ++j) s += ((const float*)A.in[6])[(size_t)(smp * 15 + 15 - j) * PW + g * 128 + c];
            DB[smp * POOL_LD + c] = (unsigned short)f2bf(s * invw - uv); }
        LDS_WAIT(); __syncthreads();
        pool_mma_store(F, A, MP, g);
    }
    LDS_WAIT(); __syncthreads();
}
__device__ __forceinline__ void sample_moba(Frame& F, const Args& A, int b) {
    int lane_ = LANE(); asm volatile("" : "+v"(lane_)); const int h = F.wave, lane = lane_, sub = lane & 15, rw = lane >> 4;
    LAS float* LG = (LAS float*)(F.lds + RING_OFF + h * 8192);
    const int* pt = ((const int*)A.in[7]) + b * NPAGES;
    const float* ps = WSP(float, WS_SACC + SA_PS) + (size_t)b * 2048;
    f32x4 qv, kn, vn;
    { const int i4 = 4 * (sub & 7); const float* rc = WSP(float, WS_ROPE) + 2048 * 32 + i4; const f32x4 c = *(const GAS f32x4*)rc, sn = *(const GAS f32x4*)(rc + 2049 * 32);
      const f32x4 q1 = *(const GAS f32x4*)(ps + 512 + h * 64 + i4), q2 = *(const GAS f32x4*)(ps + 512 + h * 64 + 32 + i4), k1 = *(const GAS f32x4*)(ps + 1024 + h * 64 + i4), k2 = *(const GAS f32x4*)(ps + 1024 + h * 64 + 32 + i4);
      qv = (sub < 8) ? (q1 * c - q2 * sn) : (q2 * c + q1 * sn); kn = (sub < 8) ? (k1 * c - k2 * sn) : (k2 * c + k1 * sn); vn = *(const GAS f32x4*)(ps + 1536 + h * 64 + 4 * sub);
      if (rw == 0) { *(GAS f32x4*)(F.out + O_KS + (size_t)b * 512 + h * 64 + 4 * sub) = kn; *(GAS f32x4*)(F.out + O_VS + (size_t)b * 512 + h * 64 + 4 * sub) = vn; }
      qv = qv * 0.125f; }
    LAS float* BS = (LAS float*)(F.lds + RING_OFF + 65536 + h * 64);
#pragma unroll 1
    for (int n = 0; n < 8; ++n) {
        float sacc = 0.f;
#pragma unroll 1
        for (int pg = 0; pg < 2; ++pg) { const int page = __builtin_amdgcn_readfirstlane(pt[2 * n + pg]);
            const float* base = ((const float*)A.in[2]) + ((size_t)page * PAGE * NH + h) * HD + 4 * sub;
#pragma unroll 1
            for (int g8 = 0; g8 < 4; ++g8) { f32x4 kv[8];
#pragma unroll
                for (int u = 0; u < 8; ++u) kv[u] = __builtin_nontemporal_load((const GAS f32x4*)(base + (size_t)(4 * (g8 * 8 + u) + rw) * (NH * HD)));
#pragma unroll
                for (int u = 0; u < 8; ++u) { float p = (kv[u][0] * qv[0] + kv[u][1] * qv[1]) + (kv[u][2] * qv[2] + kv[u][3] * qv[3]);
                    p += xshfl(p, 1, lane); p += xshfl(p, 2, lane); p += xshfl(p, 4, lane); p += xshfl(p, 8, lane);
                    if (sub == 0) LG[n * 256 + pg * 128 + 4 * (g8 * 8 + u) + rw] = p; sacc += p; } } }
        sacc += xshfl(sacc, 16, lane); sacc += xshfl(sacc, 32, lane); if (lane == 0) BS[n] = sacc;
    }
    LDS_WAIT();
    float bsum[8];
#pragma unroll
    for (int n = 0; n < 8; ++n) bsum[n] = BS[n];
    unsigned sel = 0u;
#pragma unroll
    for (int n = 0; n < 8; ++n) { int rk = 0;
#pragma unroll
        for (int m2 = 0; m2 < 8; ++m2) if (m2 != n) rk += (bsum[m2] > bsum[n] || (bsum[m2] == bsum[n] && m2 < n)) ? 1 : 0;
        if (rk < 3) sel |= 1u << n; }
    sel = __builtin_amdgcn_readfirstlane(sel);
    float pown = (kn[0] * qv[0] + kn[1] * qv[1]) + (kn[2] * qv[2] + kn[3] * qv[3]);
    pown += xshfl(pown, 1, lane); pown += xshfl(pown, 2, lane); pown += xshfl(pown, 4, lane); pown += xshfl(pown, 8, lane);
    LDS_WAIT();
    float mx = pown;
#pragma unroll
    for (int n = 0; n < 8; ++n) if ((sel >> n) & 1u) { const f32x4 l4 = *(const LAS f32x4*)(LG + n * 256 + 4 * lane); mx = __builtin_fmaxf(mx, __builtin_fmaxf(__builtin_fmaxf(l4[0], l4[1]), __builtin_fmaxf(l4[2], l4[3]))); }
    mx = wave_max(mx, lane);
    f32x4 oacc = {0.f, 0.f, 0.f, 0.f}; float lsum = 0.f;
#pragma unroll 1
    for (int n = 0; n < 8; ++n) if ((sel >> n) & 1u) {
#pragma unroll 1
        for (int pg = 0; pg < 2; ++pg) { const int page = __builtin_amdgcn_readfirstlane(pt[2 * n + pg]);
            const float* base = ((const float*)A.in[3]) + ((size_t)page * PAGE * NH + h) * HD + 4 * sub;
            for (int g8 = 0; g8 < 4; ++g8) { f32x4 vv[8];
#pragma unroll
                for (int u = 0; u < 8; ++u) vv[u] = __builtin_nontemporal_load((const GAS f32x4*)(base + (size_t)(4 * (g8 * 8 + u) + rw) * (NH * HD)));
#pragma unroll
                for (int u = 0; u < 8; ++u) { const float e = __expf(LG[n * 256 + pg * 128 + 4 * (g8 * 8 + u) + rw] - mx); lsum += e; oacc += vv[u] * e; } } } }
    { const float e = __expf(pown - mx); if (rw == 0) { lsum += e; oacc += vn * e; } }
    lsum += xshfl(lsum, 16, lane); lsum += xshfl(lsum, 32, lane);
#pragma unroll
    for (int j = 0; j < 4; ++j) { float v = oacc[j]; v += xshfl(v, 16, lane); v += xshfl(v, 32, lane); oacc[j] = v; }
    if (lane < 16) { const float inv = 1.0f / lsum; v2u o; o.x = pk2(oacc[0] * inv, oacc[1] * inv); o.y = pk2(oacc[2] * inv, oacc[3] * inv);
        *(GAS v2u*)(WSP(bf16, WS_MIX) + (size_t)(MP + b) * D + PW + h * 64 + 4 * sub) = o; }
    LDS_WAIT();
}
__device__ __forceinline__ void sample_cross(Frame& F, const Args& A, int b) {
    int lane_ = LANE(); asm volatile("" : "+v"(lane_)); const int lane = lane_, w = F.wave;
    LAS float* LG = (LAS float*)(F.lds + RING_OFF);
    LAS float* PO = (LAS float*)(F.lds + RING_OFF + 4096);
    f32x4 q[4];
#pragma unroll
    for (int hh = 0; hh < 4; ++hh) q[hh] = *(const GAS f32x4*)(WSP(float, WS_SACC + SA_AQ) + (size_t)b * D + hh * 256 + 4 * lane);
    const float* kb = ((const float*)A.in[4]) + (size_t)b * 256 * D;
    for (int k0 = 0; k0 < 32; k0 += 2) { f32x4 kv[2][4];
#pragma unroll
        for (int u = 0; u < 2; ++u)
#pragma unroll
            for (int hh = 0; hh < 4; ++hh) kv[u][hh] = __builtin_nontemporal_load((const GAS f32x4*)(kb + (size_t)(w + 8 * (k0 + u)) * D + hh * 256 + 4 * lane));
#pragma unroll
        for (int u = 0; u < 2; ++u)
#pragma unroll
            for (int hh = 0; hh < 4; ++hh) { float p = (kv[u][hh][0] * q[hh][0] + kv[u][hh][1] * q[hh][1]) + (kv[u][hh][2] * q[hh][2] + kv[u][hh][3] * q[hh][3]); p = wave_sum(p, lane); if (lane == 0) LG[hh * 256 + w + 8 * (k0 + u)] = p; } }
    LDS_WAIT(); __syncthreads();
    if (w < 4) { const f32x4 l4 = *(const LAS f32x4*)(LG + w * 256 + 4 * lane); const float mx = wave_max(__builtin_fmaxf(__builtin_fmaxf(l4[0], l4[1]), __builtin_fmaxf(l4[2], l4[3])), lane);
        f32x4 e; e[0] = __builtin_amdgcn_exp2f(l4[0] - mx); e[1] = __builtin_amdgcn_exp2f(l4[1] - mx); e[2] = __builtin_amdgcn_exp2f(l4[2] - mx); e[3] = __builtin_amdgcn_exp2f(l4[3] - mx);
        const float inv = 1.0f / wave_sum((e[0] + e[1]) + (e[2] + e[3]), lane); *(LAS f32x4*)(LG + w * 256 + 4 * lane) = e * inv; }
    LDS_WAIT(); __syncthreads();
    const float* vb = ((const float*)A.in[5]) + (size_t)b * 256 * D;
    f32x4 oacc[4];
#pragma unroll
    for (int hh = 0; hh < 4; ++hh) oacc[hh] = (f32x4){0.f, 0.f, 0.f, 0.f};
    for (int k0 = 0; k0 < 32; k0 += 2) { f32x4 vv[2][4];
#pragma unroll
        for (int u = 0; u < 2; ++u)
#pragma unroll
            for (int hh = 0; hh < 4; ++hh) vv[u][hh] = __builtin_nontemporal_load((const GAS f32x4*)(vb + (size_t)(w + 8 * (k0 + u)) * D + hh * 256 + 4 * lane));
#pragma unroll
        for (int u = 0; u < 2; ++u)
#pragma unroll
            for (int hh = 0; hh < 4; ++hh) oacc[hh] += vv[u][hh] * LG[hh * 256 + w + 8 * (k0 + u)]; }
#pragma unroll
    for (int hh = 0; hh < 4; ++hh) *(LAS f32x4*)(PO + w * 1024 + hh * 256 + 4 * lane) = oacc[hh];
    LDS_WAIT(); __syncthreads();
    { const int c = 2 * (w * 64 + lane); float a0 = 0.f, a1 = 0.f;
#pragma unroll
      for (int ww = 0; ww < 8; ++ww) { a0 += PO[ww * 1024 + c]; a1 += PO[ww * 1024 + c + 1]; }
      *(GAS unsigned*)(WSP(bf16, WS_OC) + (size_t)(MP + b) * D + c) = pk2(a0, a1); }
    LDS_WAIT(); __syncthreads();
}
__device__ __forceinline__ void cross_unit(Frame& F, int pm, int h) {
    const int b = pm >> 3;
    bf16* PB = WSP(bf16, WS_PB) + (size_t)blockIdx.x * 65536;
    { pg8::Gemm g{WSP(bf16, WS_QC) + (size_t)pm * 256 * D + h * 256, WSP(bf16, WS_MKB) + (size_t)b * 256 * D + h * 256, 256, D, D};
      pg8::EpiSoftmaxP E{PB}; pg8::OneUnit S;
      pg8::gemm_phase<pg8::EpiSoftmaxP, pg8::OneUnit, false, false>(F.lds + RING_OFF, g, S, E, F.wave); }
    VM_WAIT(); __syncthreads(); __builtin_amdgcn_fence(__ATOMIC_ACQUIRE, "agent"); VM_WAIT(); __syncthreads();
    { pg8::Gemm g{PB, WSP(bf16, WS_MVT) + (size_t)(b * 4 + h) * 65536, 256, 256, 256};
      pg8::EpiTile E{WSP(bf16, WS_OC) + (size_t)pm * 256 * D + h * 256, D}; pg8::OneUnit S;
      pg8::gemm_phase<pg8::EpiTile, pg8::OneUnit, false, false>(F.lds + RING_OFF, g, S, E, F.wave); }
    VM_WAIT(); __syncthreads();
}
__device__ __forceinline__ void final_norm(Frame& F, const Args& A) {
    const int gw = F.vcu * NWAVES + F.wave, NGW = F.G * NWAVES; const float* ss3 = (const float*)(F.ctl + CW_SS3); const GAS f32x4* gr = (const GAS f32x4*)((const float*)A.in[23]) + LANE();
    for (int m = gw; m < MP; m += 2 * NGW) { const int m2 = (m + NGW < MP) ? m + NGW : m;
        GAS f32x4* xa = (GAS f32x4*)(F.out + O_YP + (size_t)m * D) + LANE(); GAS f32x4* xb = (GAS f32x4*)(F.out + O_YP + (size_t)m2 * D) + LANE();
        f32x4 va[4], vb[4];
#pragma unroll
        for (int j = 0; j < 4; ++j) { va[j] = xa[64 * j]; vb[j] = xb[64 * j]; }
        const float ra = 1.0f / sqrtf(ss3[m] * (1.0f / D) + EPS), rb = 1.0f / sqrtf(ss3[m2] * (1.0f / D) + EPS);
#pragma unroll
        for (int j = 0; j < 4; ++j) { const f32x4 g = gr[64 * j]; xa[64 * j] = va[j] * ra * g; if (m2 != m) xb[64 * j] = vb[j] * rb * g; } }
    for (int m = MP + gw; m < MP + NS; m += NGW) {
        if (m < MP) { }
        else { const int b = m - MP; const GAS f32x4* x0 = (const GAS f32x4*)(WSP(float, WS_SACC + SA_A1) + (size_t)b * D) + LANE(); const GAS f32x4* x3 = (const GAS f32x4*)(WSP(float, WS_SACC + SA_AD) + (size_t)b * D) + LANE();
            f32x4 v[4]; float ss = 0.f;
#pragma unroll
            for (int j = 0; j < 4; ++j) { v[j] = x0[64 * j] + x3[64 * j]; ss += (v[j][0] * v[j][0] + v[j][1] * v[j][1]) + (v[j][2] * v[j][2] + v[j][3] * v[j][3]); }
            const float r = 1.0f / sqrtf(wave_sum(ss, LANE()) * (1.0f / D) + EPS); GAS f32x4* yr = (GAS f32x4*)(F.out + O_YS + (size_t)b * D) + LANE();
#pragma unroll
            for (int j = 0; j < 4; ++j) yr[64 * j] = v[j] * r * gr[64 * j]; }
    }
}
enum { SG_STORE = 0, SG_RES = 1, SG_SCALE = 2, SG_RELU2 = 3, SG_ATOMIC = 4 };
struct SGP { float* OUT; bf16* OUTB; const float* base; const float* gain; float* rowss; float sc; };
__device__ __forceinline__ int win_src_col(int c) { if (c < 512 || c >= 1536) return c; const int t = c & ~255, j = c & 255, p = j >> 7, hh = (j >> 5) & 3, i = j & 31; return t + 64 * hh + 32 * p + i; }
template <int EPI, bool WINPERM, int NSPLIT> __device__ __forceinline__ void sample_gemm(Frame& F, const bf16* Ab, int lda, const bf16* Bt, int ldb, int N, int K, const SGP P) {
    static_assert(NSPLIT == 1 || EPI == SG_ATOMIC, "only the atomic epilogue may split K");
    const int nsl = N / 16, ksteps = K / 32 / NSPLIT;
    int lane_ = LANE(); asm volatile("" : "+v"(lane_)); const int lane = lane_, fr = lane & 15, fq = lane >> 4, row = 16 * F.wave + fr;
    for (int v = F.vcu; v < nsl * NSPLIT; v += F.G) { const int sl = v % nsl, sp = v / nsl;
        f32x4 acc = {0.f, 0.f, 0.f, 0.f};
        const bf16* ap = Ab + (size_t)row * lda + 8 * fq + (size_t)sp * ksteps * 32; const bf16* bp = Bt + (size_t)(16 * sl + fr) * ldb + 8 * fq + (size_t)sp * ksteps * 32;
        for (int kb = 0; kb < ksteps; kb += 16) { bf16x8 a[16], b[16];
#pragma unroll
            for (int u = 0; u < 16; ++u) { a[u] = *(const GAS bf16x8*)(ap + (kb + u) * 32); b[u] = *(const GAS bf16x8*)(bp + (kb + u) * 32); }
#pragma unroll
            for (int u = 0; u < 16; ++u) acc = __builtin_amdgcn_mfma_f32_16x16x32_bf16(b[u], a[u], acc, 0, 0, 0); }
        const int col = WINPERM ? win_src_col(16 * sl + 4 * fq) : 16 * sl + 4 * fq;
        if (EPI == SG_STORE) { *(GAS f32x4*)(P.OUT + (size_t)row * N + col) = acc; }
        else if (EPI == SG_ATOMIC) { float* o = P.OUT + (size_t)row * N + col; unsafeAtomicAdd(o, acc[0]); unsafeAtomicAdd(o + 1, acc[1]); unsafeAtomicAdd(o + 2, acc[2]); unsafeAtomicAdd(o + 3, acc[3]); }
        else if (EPI == SG_RES) { const f32x4 x = *(const GAS f32x4*)(P.base + (size_t)row * N + col) + acc; *(GAS f32x4*)(P.OUT + (size_t)row * N + col) = x;
            v2u o; o.x = pk2(x[0], x[1]); o.y = pk2(x[2], x[3]); *(GAS v2u*)(P.OUTB + (size_t)row * N + col) = o;
            float ss = (x[0] * x[0] + x[1] * x[1]) + (x[2] * x[2] + x[3] * x[3]); ss += xshfl(ss, 16, lane); ss += xshfl(ss, 32, lane); if (fq == 0) unsafeAtomicAdd(P.rowss + row, ss); }
        else { const float r = P.sc / sqrtf(P.rowss[row] * (1.0f / D) + EPS); f32x4 hv = acc * r;
            if (EPI == SG_SCALE) { *(GAS f32x4*)(P.OUT + (size_t)row * N + col) = hv; }
            else { hv = __builtin_elementwise_max(hv, (f32x4){0.f, 0.f, 0.f, 0.f}); hv = hv * hv; v2u o; o.x = pk2(hv[0], hv[1]); o.y = pk2(hv[2], hv[3]); *(GAS v2u*)(P.OUTB + (size_t)row * N + col) = o; } }
    }
}
__device__ __forceinline__ int next_task(Frame& F, gu32* head) {
    int slot = 16; asm volatile("" : "+v"(slot));
    __syncthreads();
    if (TID(F) + slot == 16) F.MISC[slot] = __hip_atomic_fetch_add(head, 1u, RLX_AGENT);
    __syncthreads();
    return __builtin_amdgcn_readfirstlane((int)F.MISC[slot]);
}
#ifndef REPMASK
#define REPMASK 0
#endif
#define NREP(k) (1 + ((REPMASK >> (k)) & 1))
#ifndef SKIPMASK
#define SKIPMASK 0
#endif
__global__ void __launch_bounds__(NWAVES * 64, 2) mk_fwd(Args args) {
    const Args& A = args;
    extern __shared__ __attribute__((aligned(16))) unsigned char lds[];
    Frame F;
    F.lds = (LAS unsigned char*)lds;
    F.MISC = (volatile LAS unsigned*)(F.lds + MISC_OFF);
    F.wave = __builtin_amdgcn_readfirstlane((int)(threadIdx.x >> 6));
    F.G = gridDim.x; { const int bx = blockIdx.x; F.vcu = (F.G % 8 == 0) ? (bx % 8) * (F.G / 8) + bx / 8 : bx; }
    F.ws = args.ws; F.out = args.out; F.ctl = (gu32*)(args.ws + WS_CTL);
    for (int u = TID(F); u < (LDS_BYTES - LDSCTL_OFF) / 4; u += NWAVES * 64) ((LAS unsigned*)(F.lds + LDSCTL_OFF))[u] = 0u;
    __syncthreads();
    XcdBarrier bar; bar.bar = (unsigned*)(F.ctl + CW_BAR); bar.x = 0; bar.st = nullptr; bar.wave = F.wave;
    if (N_LAUNCHES != PER_PHASE) bar = xcd_barrier_post((unsigned*)(F.ctl + CW_BAR), F.MISC + 8, F.wave);
#define GRID_BAR(seam) do { if (N_LAUNCHES == PER_PHASE) { if (TID(F) == 0) __hip_atomic_store(F.ctl + CW_TMO, 0xBADBA0u | (unsigned)(seam), RLX_AGENT); } else { xcd_barrier(bar); } } while (0)
    const int lo = args.ph_lo, hi = args.ph_hi;
#define IN(k) (lo <= (k) && (k) < hi)
#define BOTH(k) (IN(k) && IN((k) + 1))
    float* const ss1 = (float*)(F.ctl + CW_SS1); float* const ss2 = (float*)(F.ctl + CW_SS2); float* const ss3 = (float*)(F.ctl + CW_SS3);
    float* const X1S = WSP(float, WS_SACC + SA_A1);

    if (IN(0) && !(SKIPMASK & (1 << 0))) { for (int rp = 0; rp < NREP(0); ++rp) p0_prologue(F, A); if (BOTH(0)) GRID_BAR(0); }

    if (IN(1) && !(SKIPMASK & (1 << 1))) {
        sample_gemm<SG_STORE, true, 1>(F, WSP(bf16, WS_XN) + (size_t)MP * D, D, WSP(bf16, WS_WIN), D, 2048, D, SGP{WSP(float, WS_SACC + SA_PS), nullptr, nullptr, nullptr, nullptr, 1.f});
        for (int rp = 0; rp < NREP(1); ++rp) {
        pg8::Gemm g{WSP(bf16, WS_XN), WSP(bf16, WS_WIN), D, D, D}; pg8::StaticOrder S; S.init(MP, 2048, F.G, (int)blockIdx.x);
        float* rc = WSP(float, WS_ROPE);
        pg8::EpiQKV E{WSP(bf16, WS_U), WSP(bf16, WS_Q), WSP(bf16, WS_K), WSP(bf16, WS_V), WSP(bf16, WS_MKB), WSP(bf16, WS_MVT), (float*)(F.ctl + CW_KSUM), rc, rc + 2049 * 32,
                      F.out + O_KP, F.out + O_VP, F.out + O_POOLP, F.out + O_MK, F.out + O_MV, attn_body::C2};
        pg8::gemm_phase<pg8::EpiQKV, pg8::StaticOrder, true, true>(F.lds + RING_OFF, g, S, E, F.wave);
        }
        if (BOTH(1)) GRID_BAR(1);
    }

    if (IN(2) && !(SKIPMASK & (1 << 2))) {
        const attn_body::AttnTensors AT{(const attn_body::bf16*)WSP(bf16, WS_Q), (const attn_body::bf16*)WSP(bf16, WS_K), (const attn_body::bf16*)WSP(bf16, WS_V), (attn_body::bf16*)(WSP(bf16, WS_MIX) + PW), D, (const float*)(F.ctl + CW_KSUM)};
        for (int rp = 0; rp < NREP(10); ++rp)
        for (;;) { const int t = next_task(F, F.ctl + rp * 1024 + CW_Q2); if (t >= NS) break; sample_moba(F, A, t); }
        for (int rp = 0; rp < NREP(11); ++rp)
        for (;;) { const int i = next_task(F, F.ctl + rp * 1024 + CW_Q2 + 64); if (i >= 64) break;
            pg8::Gemm g{WSP(bf16, WS_XN), WSP(bf16, WS_WIN), D, D, D}; pg8::OneUnitAt S{65 + (i & 7), 8 + (i >> 3)};
            float* rc = WSP(float, WS_ROPE);
            pg8::EpiQKV E{WSP(bf16, WS_U), WSP(bf16, WS_Q), WSP(bf16, WS_K), WSP(bf16, WS_V), WSP(bf16, WS_MKB), WSP(bf16, WS_MVT), (float*)(F.ctl + CW_KSUM), rc, rc + 2049 * 32,
                          F.out + O_KP, F.out + O_VP, F.out + O_POOLP, F.out + O_MK, F.out + O_MV, attn_body::C2};
            pg8::gemm_phase<pg8::EpiQKV, pg8::OneUnitAt, false, true>(F.lds + RING_OFF, g, S, E, F.wave); }
        for (int rp = 0; rp < NREP(12); ++rp)
        for (;;) { const int i = next_task(F, F.ctl + rp * 1024 + CW_Q2 + 128); if (i >= 512) break; const int qb = 7 - (i >> 6), bh = i & 63;
            attn_body::attn_unit<8>(bh >> 3, bh & 7, qb, AT.Q, AT.K, AT.V, AT.O, AT.opitch, AT.KS, (char*)lds + RING_OFF, F.wave); }
        for (int rp = 0; rp < NREP(13); ++rp)
        for (;;) { const int i = next_task(F, F.ctl + rp * 1024 + CW_Q2 + 192); if (i >= 516) break; pool_unit(F, A, i); }
        if (BOTH(2)) GRID_BAR(2);
    }

    if (IN(3) && !(SKIPMASK & (1 << 3))) {
        sample_gemm<SG_RES, false, 1>(F, WSP(bf16, WS_MIX) + (size_t)MP * D, D, WSP(bf16, WS_WOUT), D, D, D, SGP{X1S, WSP(bf16, WS_XG) + (size_t)MP * D, ((const float*)A.in[1]), nullptr, ss1 + MP, 1.f});
        pg8::Gemm g{WSP(bf16, WS_MIX), WSP(bf16, WS_WOUT), D, D, D}; pg8::StaticOrder S; S.init(MP, D, F.G, (int)blockIdx.x);
        pg8::EpiResB E{WSP(bf16, WS_XB), WSP(bf16, WS_XG), nullptr, ss1};
        pg8::gemm_phase<pg8::EpiResB, pg8::StaticOrder, true, true>(F.lds + RING_OFF, g, S, E, F.wave);
        if (BOTH(3)) GRID_BAR(3);
    }
    if (IN(4) && !(SKIPMASK & (1 << 4))) {
        sample_gemm<SG_SCALE, false, 1>(F, WSP(bf16, WS_XG) + (size_t)MP * D, D, WSP(bf16, WS_WCQ), D, D, D, SGP{WSP(float, WS_SACC + SA_AQ), nullptr, nullptr, nullptr, ss1 + MP, CROSS_C2});
        for (int rp = 0; rp < NREP(4); ++rp) {
        pg8::Gemm g{WSP(bf16, WS_XG), WSP(bf16, WS_WCQ), D, D, D}; pg8::StaticOrder S; S.init(MP, D, F.G, (int)blockIdx.x);
        pg8::EpiScale<0> E{WSP(bf16, WS_QC), D, ss1, CROSS_C2};
        pg8::gemm_phase<pg8::EpiScale<0>, pg8::StaticOrder, true, true>(F.lds + RING_OFF, g, S, E, F.wave);
        }
        if (BOTH(4)) GRID_BAR(4);
    }
    if (IN(5) && !(SKIPMASK & (1 << 5))) {
        for (int rp = 0; rp < NREP(14); ++rp)
        for (;;) { const int t = next_task(F, F.ctl + rp * 1024 + CW_Q5); if (t >= NS) break; sample_cross(F, A, t); }
        for (int rp = 0; rp < NREP(15); ++rp)
        for (;;) { const int L = next_task(F, F.ctl + rp * 1024 + CW_Q5 + 64); if (L >= 256) break; cross_unit(F, L >> 2, L & 3); }
        if (BOTH(5)) GRID_BAR(5);
    }
    if (IN(6) && !(SKIPMASK & (1 << 6))) {
        sample_gemm<SG_RES, false, 1>(F, WSP(bf16, WS_OC) + (size_t)MP * D, D, WSP(bf16, WS_WCO), D, D, D, SGP{X1S, WSP(bf16, WS_XG) + (size_t)MP * D, X1S, nullptr, ss2 + MP, 1.f});
        pg8::Gemm g{WSP(bf16, WS_OC), WSP(bf16, WS_WCO), D, D, D}; pg8::StaticOrder S; S.init(MP, D, F.G, (int)blockIdx.x);
        pg8::EpiResB E{WSP(bf16, WS_XG), WSP(bf16, WS_XG), nullptr, ss2};
        pg8::gemm_phase<pg8::EpiResB, pg8::StaticOrder, true, true>(F.lds + RING_OFF, g, S, E, F.wave);
        if (BOTH(6)) GRID_BAR(6);
    }
    if (IN(7) && !(SKIPMASK & (1 << 7))) {
        sample_gemm<SG_RELU2, false, 1>(F, WSP(bf16, WS_XG) + (size_t)MP * D, D, WSP(bf16, WS_WUP), D, FF, D, SGP{nullptr, WSP(bf16, WS_HBS), nullptr, nullptr, ss2 + MP, 1.f});
        for (int rp = 0; rp < NREP(7); ++rp) {
        pg8::Gemm g{WSP(bf16, WS_XG), WSP(bf16, WS_WUP), D, D, D}; pg8::StaticOrder S; S.init(MP, FF, F.G, (int)blockIdx.x);
        pg8::EpiScale<1> E{WSP(bf16, WS_HB), FF, ss2, 1.0f};
        pg8::gemm_phase<pg8::EpiScale<1>, pg8::StaticOrder, true, true>(F.lds + RING_OFF, g, S, E, F.wave);
        }
        if (BOTH(7)) GRID_BAR(7);
    }
    if (IN(8) && !(SKIPMASK & (1 << 8))) {
        sample_gemm<SG_ATOMIC, false, 4>(F, WSP(bf16, WS_HBS), FF, WSP(bf16, WS_WDN), FF, D, FF, SGP{WSP(float, WS_SACC + SA_AD), nullptr, nullptr, nullptr, nullptr, 1.f});
        pg8::Gemm g{WSP(bf16, WS_HB), WSP(bf16, WS_WDN), FF, FF, FF}; pg8::StaticOrder S; S.init(MP, D, F.G, (int)blockIdx.x);
        pg8::EpiResB E{WSP(bf16, WS_XG), nullptr, F.out + O_YP, ss3};
        pg8::gemm_phase<pg8::EpiResB, pg8::StaticOrder, true, true>(F.lds + RING_OFF, g, S, E, F.wave);
        if (BOTH(8)) GRID_BAR(8);
    }
    if (IN(9) && !(SKIPMASK & (1 << 9))) { final_norm(F, A); }
#undef IN
#undef BOTH
}

extern "C" void kernel_launch(void* const* d_in, const int* in_sizes, int n_in, void* d_out, int out_size, void* d_ws, size_t ws_size, hipStream_t stream) {
    static int grid = 0;
    if (grid == 0) {
        if (n_in != 24 || in_sizes[0] != MP * D || (size_t)out_size != O_END || ws_size < WS_END) { fprintf(stderr, "kernel_launch: unexpected shapes: n_in %d in0 %d out %d ws %zu; nothing launched\n", n_in, n_in > 0 ? in_sizes[0] : -1, out_size, ws_size); grid = -1; return; }
        int dev = 0, cus = 0, per_cu = 0;
        if (hipGetDevice(&dev) != hipSuccess || hipDeviceGetAttribute(&cus, hipDeviceAttributeMultiprocessorCount, dev) != hipSuccess) { fprintf(stderr, "kernel_launch: hipGetDevice / hipDeviceGetAttribute failed\n"); grid = -1; return; }
        if (hipFuncSetAttribute((const void*)mk_fwd, hipFuncAttributeMaxDynamicSharedMemorySize, LDS_BYTES) != hipSuccess) { fprintf(stderr, "kernel_launch: hipFuncSetAttribute failed\n"); grid = -1; return; }
        if (hipOccupancyMaxActiveBlocksPerMultiprocessor(&per_cu, (const void*)mk_fwd, NWAVES * 64, LDS_BYTES) != hipSuccess || per_cu < 1) { fprintf(stderr, "kernel_launch: occupancy query reports %d workgroups per CU\n", per_cu); }
        (void)hipGetLastError();
        grid = cus;
        if (grid > 256) grid = 256;
    }
    if (grid < 0) return;
    if (hipMemsetAsync((char*)d_ws + WS_CTL, 0, CTL_ZERO_BYTES, stream) != hipSuccess) { fprintf(stderr, "kernel_launch: hipMemsetAsync failed\n"); return; }
    Args a{};
    for (int i = 0; i < 24; ++i) a.in[i] = d_in[i];
    a.out = (float*)d_out; a.ws = (unsigned char*)d_ws;
    for (int li = 0; li < N_LAUNCHES; ++li) {
        a.ph_lo = (N_LAUNCHES == PER_PHASE) ? li : 0; a.ph_hi = (N_LAUNCHES == PER_PHASE) ? li + 1 : PER_PHASE;
        hipLaunchKernelGGL(mk_fwd, dim3(grid), dim3(NWAVES * 64), LDS_BYTES, stream, a);
        const hipError_t le = hipPeekAtLastError();
        if (le != hipSuccess) { fprintf(stderr, "kernel_launch: launch %d failed: %s\n", li, hipGetErrorName(le)); break; }
    }
}
```

```cpp
#include <hip/hip_runtime.h>
#include <cstdio>
#include <cstdint>
#include <cmath>
namespace pg8 {
#define PG8_LAS __attribute__((address_space(3)))
typedef unsigned short bf16_t;
typedef short bf16x8 __attribute__((ext_vector_type(8)));
typedef float f32x4 __attribute__((ext_vector_type(4)));
typedef unsigned u32x4 __attribute__((ext_vector_type(4)));
constexpr int BM = 256, BK = 64, HALF = 128, HTB = HALF * BK * 2  , STAGE_BYTES = 8 * HTB, NXCD = 8, WGM = 8;

__host__ __device__ __forceinline__ int lds_byte(int r, int c) { const int st = (r >> 4) * 2 + (c >> 5), rr = r & 15, cc = c & 31, ob = rr * 64 + cc * 2; return st * 1024 + (ob ^ (((ob >> 9) & 1) << 5)); }
__host__ __device__ __forceinline__ void stage_rc(int b, int& R, int& C) { const int st = b / 1024, sb = b % 1024, swz = sb ^ (((sb >> 9) & 1) << 5); R = (st >> 1) * 16 + swz / 64; C = (st & 1) * 32 + (swz % 64) / 2; }
__host__ __device__ __forceinline__ int perm32(int rho) { const int n = rho >> 4, i = rho & 15; return 8 * (i >> 2) + 4 * n + (i & 3); }

struct Unit { int pm, pn; };
struct Gemm { const bf16_t* A; const bf16_t* Bt; int K, lda, ldb; };

struct StaticOrder {
    int nM, nN, nwg, G, c;
    __host__ __device__ void init(int M, int N, int G_, int c_) { nM = M / BM; nN = N / BM; nwg = nM * nN; G = G_; c = c_; }
    __host__ __device__ bool next(int i, Unit& u) const {
        const long L = (long)i * G + c; if (L >= nwg) return false;
        int wgid = (int)L; { const int q = nwg / NXCD, r = nwg % NXCD, xcd = wgid % NXCD, off = wgid / NXCD; wgid = (xcd < r ? xcd * (q + 1) : r * (q + 1) + (xcd - r) * q) + off; }
        const int nig = WGM * nN, gid = wgid / nig, fm = gid * WGM, gsz = (nM - fm) < WGM ? (nM - fm) : WGM;
        u.pm = fm + ((wgid % nig) % gsz); u.pn = (wgid % nig) / gsz; return true;
    }
    __device__ __forceinline__ void a_ready(const Unit&) const {}
    __device__ __forceinline__ void done(const Unit&) const {}
};

__device__ __forceinline__ unsigned cvt_pk_bf16(float lo, float hi) { unsigned r; asm volatile("v_cvt_pk_bf16_f32 %0, %1, %2" : "=v"(r) : "v"(lo), "v"(hi)); return r; }
typedef float f32x2 __attribute__((ext_vector_type(2)));
__device__ __forceinline__ float xshfl(float v, int m, int lane) { return __builtin_bit_cast(float, __builtin_amdgcn_ds_bpermute((lane ^ m) << 2, __builtin_bit_cast(int, v))); }
__device__ __forceinline__ u32x4 pack8(const f32x4 a, const f32x4 b) { u32x4 w; w.x = cvt_pk_bf16(a[0], a[1]); w.y = cvt_pk_bf16(a[2], a[3]); w.z = cvt_pk_bf16(b[0], b[1]); w.w = cvt_pk_bf16(b[2], b[3]); return w; }
__device__ __forceinline__ unsigned short bf16_1(float v) { return (unsigned short)(cvt_pk_bf16(v, 0.f) & 0xffffu); }


struct EpiQKV {
    static constexpr bool PERM = true, AFTER_DRAIN = false;
    bf16_t *U, *Q, *Kb, *V, *MKB, *MVT; float *ksum; const float *ropeC, *ropeS;
    float *o_kp, *o_vp, *o_poolp, *o_mk, *o_mv; float qscale;
    __device__ __forceinline__ void operator()(const f32x4 (&acc)[2][2][4][2], const Unit& u, int wr, int wc, int fr, int fq) const {
        const int pm = u.pm, pn = u.pn;
        if (pm >= 65) {
            const int isv = (pn - 8) >> 2, ct = (pn - 8) & 3;
#pragma unroll
            for (int ai = 0; ai < 2; ++ai)
#pragma unroll
                for (int m = 0; m < 4; ++m) { const int mrow = (pm - 65) * 256 + ai * 128 + wr * 64 + m * 16 + fr;
#pragma unroll
                    for (int bj = 0; bj < 2; ++bj) { const int cl = bj * 128 + wc * 32 + 8 * fq, col = ct * 256 + cl; const f32x4 v0 = acc[ai][bj][m][0], v1 = acc[ai][bj][m][1];
                        float* o = (isv ? o_mv : o_mk) + (size_t)mrow * 1024 + col; *(f32x4*)o = v0; *(f32x4*)(o + 4) = v1;
                        if (!isv) { *(u32x4*)(MKB + (size_t)mrow * 1024 + col) = pack8(v0, v1); }
                        else { const int b = mrow >> 8, key = mrow & 255; bf16_t* t = MVT + ((size_t)(b * 4 + ct) * 256 + cl) * 256 + key;
                            t[0 * 256] = bf16_1(v0[0]); t[1 * 256] = bf16_1(v0[1]); t[2 * 256] = bf16_1(v0[2]); t[3 * 256] = bf16_1(v0[3]);
                            t[4 * 256] = bf16_1(v1[0]); t[5 * 256] = bf16_1(v1[1]); t[6 * 256] = bf16_1(v1[2]); t[7 * 256] = bf16_1(v1[3]); } } }
            return;
        }
        const int kind = pn >> 1, half = pn & 1;
        if (kind == 0) {
#pragma unroll
            for (int ai = 0; ai < 2; ++ai)
#pragma unroll
                for (int m = 0; m < 4; ++m) { const int row = pm * 256 + ai * 128 + wr * 64 + m * 16 + fr;
#pragma unroll
                    for (int bj = 0; bj < 2; ++bj) { const int col = half * 256 + bj * 128 + wc * 32 + 8 * fq; const f32x4 v0 = acc[ai][bj][m][0], v1 = acc[ai][bj][m][1];
                        *(u32x4*)(U + (size_t)row * 512 + col) = pack8(v0, v1);
                        { const int pos = row & 2047; if (pos >= 2033) { float* o = o_poolp + ((size_t)((row >> 11) * 15 + pos - 2033) * 512 + col); *(f32x4*)o = v0; *(f32x4*)(o + 4) = v1; } } } }
        } else if (kind == 3) {
#pragma unroll
            for (int ai = 0; ai < 2; ++ai)
#pragma unroll
                for (int m = 0; m < 4; ++m) { const int row = pm * 256 + ai * 128 + wr * 64 + m * 16 + fr;
#pragma unroll
                    for (int bj = 0; bj < 2; ++bj) { const int col = half * 256 + bj * 128 + wc * 32 + 8 * fq; const f32x4 v0 = acc[ai][bj][m][0], v1 = acc[ai][bj][m][1];
                        *(u32x4*)(V + (size_t)row * 512 + col) = pack8(v0, v1);
                        { float* o = o_vp + (size_t)row * 512 + col; *(f32x4*)o = v0; *(f32x4*)(o + 4) = v1; } } }
        } else {
            const int head = half * 4 + wc, i0 = 8 * fq, col1 = head * 64 + i0, col2 = col1 + 32;
            f32x4 cs1a = {0.f, 0.f, 0.f, 0.f}, cs1b = cs1a, cs2a = cs1a, cs2b = cs1a;
#pragma unroll
            for (int ai = 0; ai < 2; ++ai)
#pragma unroll
                for (int m = 0; m < 4; ++m) { const int row = pm * 256 + ai * 128 + wr * 64 + m * 16 + fr; const int pos = row & 2047;
                    const f32x4 c0 = *(const f32x4*)(ropeC + pos * 32 + i0), c1 = *(const f32x4*)(ropeC + pos * 32 + i0 + 4), s0 = *(const f32x4*)(ropeS + pos * 32 + i0), s1 = *(const f32x4*)(ropeS + pos * 32 + i0 + 4);
                    const f32x4 x1a = acc[ai][0][m][0], x1b = acc[ai][0][m][1], x2a = acc[ai][1][m][0], x2b = acc[ai][1][m][1];
                    const f32x4 o1a = x1a * c0 - x2a * s0, o1b = x1b * c1 - x2b * s1, o2a = x2a * c0 + x1a * s0, o2b = x2b * c1 + x1b * s1;
                    if (kind == 1) {
                        *(u32x4*)(Q + (size_t)row * 512 + col1) = pack8(o1a * qscale, o1b * qscale); *(u32x4*)(Q + (size_t)row * 512 + col2) = pack8(o2a * qscale, o2b * qscale);
                    } else {
                        *(u32x4*)(Kb + (size_t)row * 512 + col1) = pack8(o1a, o1b); *(u32x4*)(Kb + (size_t)row * 512 + col2) = pack8(o2a, o2b);
                        { float* o = o_kp + (size_t)row * 512; *(f32x4*)(o + col1) = o1a; *(f32x4*)(o + col1 + 4) = o1b; *(f32x4*)(o + col2) = o2a; *(f32x4*)(o + col2 + 4) = o2b;
                            cs1a += o1a; cs1b += o1b; cs2a += o2a; cs2b += o2b; }
                    } }
            if (kind == 2) {
                float cs[16] = {cs1a[0], cs1a[1], cs1a[2], cs1a[3], cs1b[0], cs1b[1], cs1b[2], cs1b[3], cs2a[0], cs2a[1], cs2a[2], cs2a[3], cs2b[0], cs2b[1], cs2b[2], cs2b[3]};
#pragma unroll
                for (int j = 0; j < 16; ++j) { float v = cs[j]; v += xshfl(v, 1, fr + 16 * fq); v += xshfl(v, 2, fr + 16 * fq); v += xshfl(v, 4, fr + 16 * fq); v += xshfl(v, 8, fr + 16 * fq); cs[j] = v; }
                if (fr == 0) { float* kp = ksum + (size_t)pm * 512;
#pragma unroll
                    for (int j = 0; j < 8; ++j) { unsafeAtomicAdd(kp + col1 + j, cs[j]); unsafeAtomicAdd(kp + col2 + j, cs[8 + j]); } }
            }
        }
    }
};

struct EpiResB {
    static constexpr bool PERM = true, AFTER_DRAIN = false;
    const bf16_t* base; bf16_t* outb; float* outf; float* rowss;
    __device__ __forceinline__ void operator()(const f32x4 (&acc)[2][2][4][2], const Unit& u, int wr, int wc, int fr, int fq) const {
#pragma unroll
        for (int ai = 0; ai < 2; ++ai)
#pragma unroll
            for (int m = 0; m < 4; ++m) { const int row = u.pm * 256 + ai * 128 + wr * 64 + m * 16 + fr;
                float ss = 0.f;
#pragma unroll
                for (int bj = 0; bj < 2; ++bj) { const int col = u.pn * 256 + bj * 128 + wc * 32 + 8 * fq; const u32x4 bv = *(const u32x4*)(base + (size_t)row * 1024 + col);
                    const f32x4 b0 = {__uint_as_float(bv.x << 16), __uint_as_float(bv.x & 0xffff0000u), __uint_as_float(bv.y << 16), __uint_as_float(bv.y & 0xffff0000u)};
                    const f32x4 b1 = {__uint_as_float(bv.z << 16), __uint_as_float(bv.z & 0xffff0000u), __uint_as_float(bv.w << 16), __uint_as_float(bv.w & 0xffff0000u)};
                    const f32x4 x0 = b0 + acc[ai][bj][m][0], x1 = b1 + acc[ai][bj][m][1];
                    ss += (x0[0] * x0[0] + x0[1] * x0[1]) + (x0[2] * x0[2] + x0[3] * x0[3]) + (x1[0] * x1[0] + x1[1] * x1[1]) + (x1[2] * x1[2] + x1[3] * x1[3]);
                    if (outf) { float* op = outf + (size_t)row * 1024 + col; *(f32x4*)op = x0; *(f32x4*)(op + 4) = x1; }
                    else *(u32x4*)(outb + (size_t)row * 1024 + col) = pack8(x0, x1); }
                ss += xshfl(ss, 16, fr + 16 * fq); ss += xshfl(ss, 32, fr + 16 * fq);
                if (fq == 0) unsafeAtomicAdd(rowss + row, ss);
            }
    }
};
template <int ACT> struct EpiScale {
    static constexpr bool PERM = true, AFTER_DRAIN = false;
    bf16_t* O; int ldc; const float* rowss; float sc;
    __device__ __forceinline__ void operator()(const f32x4 (&acc)[2][2][4][2], const Unit& u, int wr, int wc, int fr, int fq) const {
#pragma unroll
        for (int ai = 0; ai < 2; ++ai)
#pragma unroll
            for (int m = 0; m < 4; ++m) { const int row = u.pm * 256 + ai * 128 + wr * 64 + m * 16 + fr;
                const float r = __builtin_amdgcn_rsqf(rowss[row] * (1.0f / 1024.0f) + 1e-6f) * sc;
#pragma unroll
                for (int bj = 0; bj < 2; ++bj) { const int col = u.pn * 256 + bj * 128 + wc * 32 + 8 * fq; f32x4 v0 = acc[ai][bj][m][0] * r, v1 = acc[ai][bj][m][1] * r;
                    if (ACT == 1) { v0 = __builtin_elementwise_max(v0, (f32x4){0.f, 0.f, 0.f, 0.f}); v1 = __builtin_elementwise_max(v1, (f32x4){0.f, 0.f, 0.f, 0.f}); v0 = v0 * v0; v1 = v1 * v1; }
                    *(u32x4*)(O + (size_t)row * ldc + col) = pack8(v0, v1); } }
    }
};
struct EpiTile {
    static constexpr bool PERM = true, AFTER_DRAIN = false;
    bf16_t* O; int ldc;
    __device__ __forceinline__ void operator()(const f32x4 (&acc)[2][2][4][2], const Unit&, int wr, int wc, int fr, int fq) const {
#pragma unroll
        for (int ai = 0; ai < 2; ++ai)
#pragma unroll
            for (int m = 0; m < 4; ++m) { const int row = ai * 128 + wr * 64 + m * 16 + fr;
#pragma unroll
                for (int bj = 0; bj < 2; ++bj) { const int col = bj * 128 + wc * 32 + 8 * fq; *(u32x4*)(O + (size_t)row * ldc + col) = pack8(acc[ai][bj][m][0], acc[ai][bj][m][1]); } }
    }
};
struct EpiSoftmaxP {
    static constexpr bool PERM = true, AFTER_DRAIN = true;
    bf16_t* P;
    __device__ __forceinline__ void fused(f32x4 (&acc)[2][2][4][2], const Unit&, int wr, int wc, int fr, int fq, PG8_LAS unsigned char* lds, int, int) const {
        PG8_LAS float* MX = (PG8_LAS float*)lds; PG8_LAS float* SM = (PG8_LAS float*)(lds + 4096);
#ifdef SOFTMAX_TRIVIAL
        if (fq == 0) MX[fr] = acc[0][0][0][0][0]; return;
#endif
#pragma unroll
        for (int ai = 0; ai < 2; ++ai)
#pragma unroll
            for (int m = 0; m < 4; ++m) { float mx = -INFINITY;
#pragma unroll
                for (int bj = 0; bj < 2; ++bj)
#pragma unroll
                    for (int n = 0; n < 2; ++n) { const f32x4 x = acc[ai][bj][m][n]; mx = __builtin_fmaxf(mx, __builtin_fmaxf(__builtin_fmaxf(x[0], x[1]), __builtin_fmaxf(x[2], x[3]))); }
                mx = __builtin_fmaxf(mx, xshfl(mx, 16, fr + 16 * fq)); mx = __builtin_fmaxf(mx, xshfl(mx, 32, fr + 16 * fq));
                if (fq == 0) MX[(ai * 128 + wr * 64 + m * 16 + fr) * 4 + wc] = mx; }
        asm volatile("s_waitcnt lgkmcnt(0)" ::: "memory"); __builtin_amdgcn_s_barrier(); asm volatile("" ::: "memory");
#pragma unroll
        for (int ai = 0; ai < 2; ++ai)
#pragma unroll
            for (int m = 0; m < 4; ++m) { const int r = ai * 128 + wr * 64 + m * 16 + fr; const f32x4 mv = *(const PG8_LAS f32x4*)(MX + r * 4);
                const float rm = __builtin_fmaxf(__builtin_fmaxf(mv[0], mv[1]), __builtin_fmaxf(mv[2], mv[3])); float s = 0.f;
#pragma unroll
                for (int bj = 0; bj < 2; ++bj)
#pragma unroll
                    for (int n = 0; n < 2; ++n) { f32x4 x = acc[ai][bj][m][n]; x[0] = __builtin_amdgcn_exp2f(x[0] - rm); x[1] = __builtin_amdgcn_exp2f(x[1] - rm); x[2] = __builtin_amdgcn_exp2f(x[2] - rm); x[3] = __builtin_amdgcn_exp2f(x[3] - rm);
                        s += (x[0] + x[1]) + (x[2] + x[3]); acc[ai][bj][m][n] = x; }
                s += xshfl(s, 16, fr + 16 * fq); s += xshfl(s, 32, fr + 16 * fq);
                if (fq == 0) SM[r * 4 + wc] = s; }
        asm volatile("s_waitcnt lgkmcnt(0)" ::: "memory"); __builtin_amdgcn_s_barrier(); asm volatile("" ::: "memory");
#pragma unroll
        for (int ai = 0; ai < 2; ++ai)
#pragma unroll
            for (int m = 0; m < 4; ++m) { const int r = ai * 128 + wr * 64 + m * 16 + fr; const f32x4 sv = *(const PG8_LAS f32x4*)(SM + r * 4);
                const float inv = 1.0f / ((sv[0] + sv[1]) + (sv[2] + sv[3]));
#pragma unroll
                for (int bj = 0; bj < 2; ++bj) { const int col = bj * 128 + wc * 32 + 8 * fq; *(u32x4*)(P + (size_t)r * 256 + col) = pack8(acc[ai][bj][m][0] * inv, acc[ai][bj][m][1] * inv); } }
    }
};
struct OneUnitAt {
    int pm, pn;
    __device__ __forceinline__ bool next(int i, Unit& u) const { if (i) return false; u.pm = pm; u.pn = pn; return true; }
    __device__ __forceinline__ void a_ready(const Unit&) const {}
    __device__ __forceinline__ void done(const Unit&) const {}
};
struct OneUnit {
    __device__ __forceinline__ bool next(int i, Unit& u) const { if (i) return false; u.pm = 0; u.pn = 0; return true; }
    __device__ __forceinline__ void a_ready(const Unit&) const {}
    __device__ __forceinline__ void done(const Unit&) const {}
};
struct SchedP1 {
    StaticOrder S1; int G, c;
    __device__ __forceinline__ void init(int G_, int c_) { S1.init(65 * 256, 2048, G_, c_); G = G_; c = c_; }
    __device__ __forceinline__ bool next(int i, Unit& u) const { if (S1.next(i, u)) return true; const long L = (long)i * G + c - 520; if (L < 0 || L >= 64) return false; u.pm = 65 + (int)(L & 7); u.pn = 8 + (int)(L >> 3); return true; }
    __device__ __forceinline__ void a_ready(const Unit&) const {}
    __device__ __forceinline__ void done(const Unit&) const {}
};

template <class Epi, class Sched, bool ALIGN_EPI = false, bool SP2 = false>
__device__ __forceinline__ void gemm_phase(PG8_LAS unsigned char* lds, const Gemm g, const Sched& S, const Epi& E, const int wid_in) {
    int lane_ = __builtin_amdgcn_mbcnt_hi(~0u, __builtin_amdgcn_mbcnt_lo(~0u, 0u)); asm volatile("" : "+v"(lane_));
    int wid_ = wid_in; asm volatile("" : "+s"(wid_));
    const int wid = wid_, lane = lane_, tid = wid * 64 + lane, wr = wid >> 2, wc = wid & 3, fr = lane & 15, fq = lane >> 4;
    const int K = g.K, nt = K / BK;
    unsigned voffA[2], voffB[2];
#pragma unroll
    for (int i = 0; i < 2; ++i) { int R, C; stage_rc(tid * 16 + i * 8192, R, C); const int Rb = Epi::PERM ? ((R & ~31) + perm32(R & 31)) : R;
        voffA[i] = (unsigned)(R * g.lda + C) * 2u; voffB[i] = (unsigned)(Rb * g.ldb + C) * 2u; }
    const size_t kstep = (size_t)(BK * 2);
    const size_t hstepA = (size_t)HALF * g.lda * 2, hstepB = (size_t)HALF * g.ldb * 2;
    const size_t tstepA = 2 * hstepA, tstepB = 2 * hstepB;
    const unsigned ldsw = (unsigned)wid * 1024u;
    const int aoff = lds_byte(wr * 64 + fr, fq * 8), boff = lds_byte(wc * 32 + fr, fq * 8);
#define PG8_SA(b, h) (((b) * 2 + (h)) * HTB)
#define PG8_SB(b, h) ((4 + (b) * 2 + (h)) * HTB)
#define PG8_STAGE(bufoff, gbase, voff) do { _Pragma("unroll") for (int _i = 0; _i < 2; ++_i) \
        __builtin_amdgcn_global_load_lds((const unsigned*)((const char*)(gbase) + (voff)[_i]), (PG8_LAS unsigned*)(lds + (bufoff) + ldsw + _i * 8192), 16, 0, 0); } while (0)
#define PG8_LDA(dst, b, h) do { _Pragma("unroll") for (int m = 0; m < 4; ++m) _Pragma("unroll") for (int k = 0; k < 2; ++k) dst[m][k] = *(const PG8_LAS bf16x8*)(lds + PG8_SA(b, h) + aoff + m * 2048 + k * 1024); } while (0)
#define PG8_LDB(dst, b, h) do { _Pragma("unroll") for (int n = 0; n < 2; ++n) _Pragma("unroll") for (int k = 0; k < 2; ++k) dst[n][k] = *(const PG8_LAS bf16x8*)(lds + PG8_SB(b, h) + boff + n * 2048 + k * 1024); } while (0)
#define PG8_MMA(ai, bj, At, Bt) do { __builtin_amdgcn_s_setprio(1); _Pragma("unroll") for (int m = 0; m < 4; ++m) _Pragma("unroll") for (int n = 0; n < 2; ++n) _Pragma("unroll") for (int k = 0; k < 2; ++k) \
        acc[ai][bj][m][n] = __builtin_amdgcn_mfma_f32_16x16x32_bf16(Bt[n][k], At[m][k], acc[ai][bj][m][n], 0, 0, 0); __builtin_amdgcn_s_setprio(0); } while (0)
#define PG8_WAIT_V(n) asm volatile("s_waitcnt vmcnt(" #n ")" ::: "memory")
#define PG8_WAIT_L(n) asm volatile("s_waitcnt lgkmcnt(" #n ")" ::: "memory")
#define PG8_BAR __builtin_amdgcn_s_barrier()
#define PG8_SCHED __builtin_amdgcn_sched_barrier(0)
    Unit cur, nxt; int ui = 0;
    if (!S.next(0, cur)) return;
    f32x4 acc[2][2][4][2];
#pragma unroll
    for (int a = 0; a < 2; ++a)
#pragma unroll
        for (int b = 0; b < 2; ++b)
#pragma unroll
            for (int m = 0; m < 4; ++m)
#pragma unroll
                for (int n = 0; n < 2; ++n) acc[a][b][m][n] = (f32x4){0.f, 0.f, 0.f, 0.f};
    bf16x8 At[4][2], B0[2][2], B1[2][2];
    const char* cA = (const char*)g.A + (size_t)cur.pm * tstepA; const char* cB = (const char*)g.Bt + (size_t)cur.pn * tstepB;
    S.a_ready(cur);
    if constexpr (SP2) {
        PG8_STAGE(PG8_SB(0, 0), cB, voffB); PG8_STAGE(PG8_SB(0, 1), cB + hstepB, voffB); PG8_STAGE(PG8_SA(0, 0), cA, voffA); PG8_STAGE(PG8_SA(0, 1), cA + hstepA, voffA);
        if (wr == 1) PG8_BAR;
        PG8_WAIT_V(2); PG8_BAR;
        PG8_STAGE(PG8_SB(1, 0), cB + kstep, voffB); PG8_STAGE(PG8_SA(1, 0), cA + kstep, voffA); PG8_STAGE(PG8_SB(1, 1), cB + hstepB + kstep, voffB);
        PG8_WAIT_V(6); PG8_BAR;
    } else {
        PG8_STAGE(PG8_SB(0, 0), cB, voffB); PG8_STAGE(PG8_SA(0, 0), cA, voffA); PG8_STAGE(PG8_SB(0, 1), cB + hstepB, voffB); PG8_STAGE(PG8_SA(0, 1), cA + hstepA, voffA);
        if (wr == 1) PG8_BAR;
        PG8_WAIT_V(4); PG8_BAR;
        PG8_STAGE(PG8_SB(1, 0), cB + kstep, voffB); PG8_STAGE(PG8_SA(1, 0), cA + kstep, voffA); PG8_STAGE(PG8_SB(1, 1), cB + hstepB + kstep, voffB);
        PG8_WAIT_V(6); PG8_BAR;
    }
    for (;;) {
        const bool has_next = S.next(ui + 1, nxt);
        const char* nA = has_next ? (const char*)g.A + (size_t)nxt.pm * tstepA : cA; const char* nB = has_next ? (const char*)g.Bt + (size_t)nxt.pn * tstepB : cB;
        for (int t = 0; t < nt; t += 2) {
            const bool last = (t == nt - 2);
            const char* a1 = cA + (size_t)(t + 1) * kstep;
            const char* a2 = last ? nA : cA + (size_t)(t + 2) * kstep; const char* b2 = last ? nB : cB + (size_t)(t + 2) * kstep;
            const char* a3 = a2 + kstep; const char* b3 = b2 + kstep;
            if (last && has_next) S.a_ready(nxt);
            if constexpr (SP2) {
            PG8_LDB(B0, 0, 0); PG8_LDB(B1, 0, 1); PG8_SCHED; PG8_LDA(At, 0, 0); PG8_STAGE(PG8_SA(1, 1), a1 + hstepA, voffA);
            PG8_WAIT_V(8); PG8_WAIT_L(0); PG8_BAR; PG8_MMA(0, 0, At, B0); PG8_MMA(0, 1, At, B1); PG8_BAR; PG8_SCHED;
            PG8_LDA(At, 0, 1); PG8_STAGE(PG8_SB(0, 0), b2, voffB); PG8_STAGE(PG8_SB(0, 1), b2 + hstepB, voffB); PG8_STAGE(PG8_SA(0, 0), a2, voffA);
            PG8_WAIT_V(8); PG8_WAIT_L(0); PG8_BAR; PG8_MMA(1, 0, At, B0); PG8_MMA(1, 1, At, B1); PG8_BAR; PG8_SCHED;
            PG8_LDB(B0, 1, 0); PG8_LDB(B1, 1, 1); PG8_SCHED; PG8_LDA(At, 1, 0); PG8_STAGE(PG8_SA(0, 1), a2 + hstepA, voffA);
            PG8_WAIT_V(8); PG8_WAIT_L(0); PG8_BAR; PG8_MMA(0, 0, At, B0); PG8_MMA(0, 1, At, B1); PG8_BAR; PG8_SCHED;
            PG8_LDA(At, 1, 1); PG8_STAGE(PG8_SB(1, 0), b3, voffB); PG8_STAGE(PG8_SB(1, 1), b3 + hstepB, voffB); PG8_STAGE(PG8_SA(1, 0), a3, voffA);
            PG8_WAIT_V(8); PG8_WAIT_L(0); PG8_BAR; PG8_MMA(1, 0, At, B0); PG8_MMA(1, 1, At, B1); PG8_BAR; PG8_SCHED;
            } else {
            PG8_LDB(B0, 0, 0); PG8_SCHED; PG8_LDA(At, 0, 0); PG8_STAGE(PG8_SA(1, 1), a1 + hstepA, voffA);
            PG8_WAIT_L(8); PG8_BAR; PG8_WAIT_L(0); PG8_MMA(0, 0, At, B0); PG8_BAR; PG8_SCHED;
            PG8_LDB(B1, 0, 1); PG8_STAGE(PG8_SB(0, 0), b2, voffB);
            PG8_BAR; PG8_WAIT_L(0); PG8_MMA(0, 1, At, B1); PG8_BAR;
            PG8_LDA(At, 0, 1); PG8_STAGE(PG8_SA(0, 0), a2, voffA);
            PG8_BAR; PG8_WAIT_L(0); PG8_MMA(1, 0, At, B0); PG8_BAR; PG8_SCHED;
            PG8_STAGE(PG8_SB(0, 1), b2 + hstepB, voffB);
            PG8_WAIT_V(6); PG8_BAR; PG8_MMA(1, 1, At, B1); PG8_BAR;
            PG8_LDB(B0, 1, 0); PG8_SCHED; PG8_LDA(At, 1, 0); PG8_STAGE(PG8_SA(0, 1), a2 + hstepA, voffA);
            PG8_WAIT_L(8); PG8_BAR; PG8_WAIT_L(0); PG8_MMA(0, 0, At, B0); PG8_BAR; PG8_SCHED;
            PG8_LDB(B1, 1, 1); PG8_STAGE(PG8_SB(1, 0), b3, voffB);
            PG8_BAR; PG8_WAIT_L(0); PG8_MMA(0, 1, At, B1); PG8_BAR;
            PG8_LDA(At, 1, 1); PG8_STAGE(PG8_SA(1, 0), a3, voffA);
            PG8_BAR; PG8_WAIT_L(0); PG8_MMA(1, 0, At, B0); PG8_BAR; PG8_SCHED;
            PG8_STAGE(PG8_SB(1, 1), b3 + hstepB, voffB);
            PG8_WAIT_V(6); PG8_BAR; PG8_MMA(1, 1, At, B1); PG8_BAR;
            }
        }
        if constexpr (ALIGN_EPI) { if (wr == 0) PG8_BAR; }
        if constexpr (!Epi::AFTER_DRAIN) { E(acc, cur, wr, wc, fr, fq); S.done(cur); }
        if (!has_next) break;
#pragma unroll
        for (int a = 0; a < 2; ++a)
#pragma unroll
            for (int b = 0; b < 2; ++b)
#pragma unroll
                for (int m = 0; m < 4; ++m)
#pragma unroll
                    for (int n = 0; n < 2; ++n) acc[a][b][m][n] = (f32x4){0.f, 0.f, 0.f, 0.f};
        cur = nxt; cA = nA; cB = nB; ++ui;
        if constexpr (ALIGN_EPI) { if (wr == 1) PG8_BAR; }
    }
    PG8_WAIT_V(0);
    if constexpr (!ALIGN_EPI) { if (wr == 0) PG8_BAR; }
    PG8_BAR;
    if constexpr (Epi::AFTER_DRAIN) { E.fused(acc, cur, wr, wc, fr, fq, lds, wid, lane); S.done(cur); }
#undef PG8_SA
#undef PG8_SB
#undef PG8_STAGE
#undef PG8_LDA
#undef PG8_LDB
#undef PG8_MMA
#undef PG8_WAIT_V
#undef PG8_WAIT_L
#undef PG8_BAR
#undef PG8_SCHED
}
}

#include <hip/hip_bf16.h>
namespace attn_body {
using bf16=__hip_bfloat16;
using bf16x8=__attribute__((ext_vector_type(8)))short;
using s16x4=__attribute__((ext_vector_type(4)))short;
using f32x16=__attribute__((ext_vector_type(16)))float;
using u32x4=__attribute__((ext_vector_type(4)))unsigned;
constexpr int BATCH=8,NHEAD=8,SEQ=2048,D=64,DM=NHEAD*D;
constexpr int NW=8,QBLK=32,QB=QBLK*NW,KVBLK=64,NQB=SEQ/QB;
constexpr int ATTN_PITCH=DM, ATTN_UNIT_ROWS=QB;
__device__ __forceinline__ int crow(int r,int hi){return (r&3)+8*(r>>2)+4*hi;}
#define SBAR() __builtin_amdgcn_sched_barrier(0)
__device__ __forceinline__ void cmask(f32x16&p0,f32x16&p1,int jb,int qrel,int hi){
  const float NEG=-INFINITY; int kb=64*jb+4*hi;
  #pragma unroll
  for(int r=0;r<16;++r){int kv=kb+(r&3)+8*(r>>2); if(kv>qrel)p0[r]=NEG; if(kv+32>qrel)p1[r]=NEG;}
}

constexpr int NSLOT=3, SLOTB=8192;
constexpr int LDS_K=0, LDS_V=NSLOT*SLOTB, LDS_WS=2*NSLOT*SLOTB, LDS_OST=LDS_WS+NW*64*4, LDS_BYTES=LDS_OST+NW*4096;
constexpr float C2=0.125f*1.4426950408889634f;
__device__ __forceinline__ void glds16(const void*gsrc,unsigned lds_dst){unsigned keep;
  asm volatile("s_mov_b32 %0, m0\n\ts_mov_b32 m0, %2\n\ts_nop 0\n\tglobal_load_lds_dwordx4 %1, off\n\ts_mov_b32 m0, %0":"=&s"(keep):"v"(gsrc),"s"(lds_dst):"memory");}
__device__ __forceinline__ float max3f(float a,float b,float c){float r;asm("v_max3_f32 %0, %1, %2, %3":"=v"(r):"v"(a),"v"(b),"v"(c));return r;}
__device__ __forceinline__ float max2f(float a,float b){float r;asm("v_max_f32_e32 %0, %1, %2":"=v"(r):"v"(a),"v"(b));return r;}
__device__ __forceinline__ float fadd_s(float a,float b){float r;asm("v_add_f32_e32 %0, %1, %2":"=v"(r):"v"(a),"v"(b));return r;}
__device__ __forceinline__ float fsub_s(float a,float b){float r;asm("v_sub_f32_e32 %0, %1, %2":"=v"(r):"v"(a),"v"(b));return r;}
typedef float f32x2_t __attribute__((ext_vector_type(2))); typedef __bf16 bf16x2_t __attribute__((ext_vector_type(2)));
__device__ __forceinline__ unsigned cvtpk_s(float lo,float hi){f32x2_t v={lo,hi};bf16x2_t b=__builtin_convertvector(v,bf16x2_t);return __builtin_bit_cast(unsigned,b);}
#define WAIT_BAR(N) asm volatile("s_waitcnt vmcnt(" #N ") lgkmcnt(0)\n\ts_barrier":::"memory")

__device__ __forceinline__ void qkt(f32x16&p0,f32x16&p1,const char*Kslot,const bf16x8*qr,const f32x16&negm,int r32,int hi){
  const char*kb=Kslot+hi*1024+r32*16;
  #pragma unroll
  for(int d0=0;d0<4;++d0){
    const bf16x8 b0=*reinterpret_cast<const bf16x8*>(kb+d0*2048);
    const bf16x8 b1=*reinterpret_cast<const bf16x8*>(kb+d0*2048+512);
    if(d0==0){p0=__builtin_amdgcn_mfma_f32_32x32x16_bf16(b0,qr[0],negm,0,0,0);p1=__builtin_amdgcn_mfma_f32_32x32x16_bf16(b1,qr[0],negm,0,0,0);}
    else{p0=__builtin_amdgcn_mfma_f32_32x32x16_bf16(b0,qr[d0],p0,0,0,0);p1=__builtin_amdgcn_mfma_f32_32x32x16_bf16(b1,qr[d0],p1,0,0,0);}}
}
typedef __attribute__((address_space(3))) const char* lds_cptr;
typedef short v4i16_t __attribute__((ext_vector_type(4)));
__device__ __forceinline__ void kload8(bf16x8*kf,lds_cptr kp){
  kf[0]=*(const __attribute__((address_space(3))) bf16x8*)(kp);      kf[1]=*(const __attribute__((address_space(3))) bf16x8*)(kp+512);
  kf[2]=*(const __attribute__((address_space(3))) bf16x8*)(kp+2048); kf[3]=*(const __attribute__((address_space(3))) bf16x8*)(kp+2560);
  kf[4]=*(const __attribute__((address_space(3))) bf16x8*)(kp+4096); kf[5]=*(const __attribute__((address_space(3))) bf16x8*)(kp+4608);
  kf[6]=*(const __attribute__((address_space(3))) bf16x8*)(kp+6144); kf[7]=*(const __attribute__((address_space(3))) bf16x8*)(kp+6656);
}
__device__ __forceinline__ void kload2(bf16x8*kf,lds_cptr kp,int j){ kf[2*j]=*(const __attribute__((address_space(3))) bf16x8*)(kp+j*2048); kf[2*j+1]=*(const __attribute__((address_space(3))) bf16x8*)(kp+j*2048+512); }
__device__ __forceinline__ s16x4 vtr(lds_cptr p){ return __builtin_bit_cast(s16x4,__builtin_amdgcn_ds_read_tr16_b64_v4i16((__attribute__((address_space(3))) v4i16_t*)p)); }
__device__ __forceinline__ float rowmax(const f32x16&p0,const f32x16&p1){
  float a=max3f(p0[0],p0[1],p1[0]),b=max3f(p0[2],p0[3],p1[1]);a=max3f(a,p1[2],p1[3]);
  #pragma unroll
  for(int r=4;r<16;r+=4){a=max3f(a,p0[r],p0[r+1]);b=max3f(b,p0[r+2],p0[r+3]);a=max3f(a,p1[r],p1[r+1]);b=max3f(b,p1[r+2],p1[r+3]);}
  const float m=max2f(a,b);
  auto rr=__builtin_amdgcn_permlane32_swap(__float_as_uint(m),__float_as_uint(m),false,false);
  return max2f(__uint_as_float(rr[0]),__uint_as_float(rr[1]));
}
__device__ __forceinline__ void pv(f32x16*o,int vb,bf16x8 pa0,bf16x8 pa1,bf16x8 pa2,bf16x8 pa3){
  #pragma unroll
  for(int d0=0;d0<2;++d0){s16x4 lo[4],hi[4];
    #pragma unroll
    for(int ks=0;ks<4;++ks){
      asm volatile("ds_read_b64_tr_b16 %0,%1 offset:%c2":"=&v"(lo[ks]):"v"(vb),"i"(d0*4096+ks*1024):"memory");
      asm volatile("ds_read_b64_tr_b16 %0,%1 offset:%c2":"=&v"(hi[ks]):"v"(vb),"i"(d0*4096+ks*1024+512):"memory");}
    asm volatile("s_waitcnt lgkmcnt(0)":::"memory");SBAR();
    #define PK(k) (bf16x8){lo[k][0],lo[k][1],lo[k][2],lo[k][3],hi[k][0],hi[k][1],hi[k][2],hi[k][3]}
    o[d0]=__builtin_amdgcn_mfma_f32_32x32x16_bf16(pa0,PK(0),o[d0],0,0,0);
    o[d0]=__builtin_amdgcn_mfma_f32_32x32x16_bf16(pa1,PK(1),o[d0],0,0,0);
    o[d0]=__builtin_amdgcn_mfma_f32_32x32x16_bf16(pa2,PK(2),o[d0],0,0,0);
    o[d0]=__builtin_amdgcn_mfma_f32_32x32x16_bf16(pa3,PK(3),o[d0],0,0,0);
    #undef PK
  }
}

#ifndef ATTN_STORE16
#define ATTN_STORE16(p,v) (*(u32x4*)(p)=(v))
#endif
template<int THRL> __device__ __forceinline__ void attn_unit(int b,int h,int qb,const bf16*Q,const bf16*__restrict__ K,const bf16*__restrict__ V,bf16*O,int opitch,const float*__restrict__ KS,char*shm,const int wid){
  int lane_=__builtin_amdgcn_mbcnt_hi(~0u,__builtin_amdgcn_mbcnt_lo(~0u,0u)); asm volatile("":"+v"(lane_)); const int lane=lane_,r32=lane&31,hi=lane>>5;
  const long rowbase=(long)b*SEQ; const int q0=qb*QB;
  const bf16*Qw=Q+(rowbase+q0+wid*QBLK)*DM+h*D;
  const bf16*Kh=K+rowbase*DM+h*D,*Vh=V+rowbase*DM+h*D;
  const unsigned lds0=(unsigned)(uintptr_t)shm;
  float*wsf=(float*)(shm+LDS_WS)+wid*64;
  const bf16*ksrc=Kh+(long)lane*DM+wid*8;
  const bf16*vsrc=Vh+(long)(16*(wid&3)+(lane>>2))*DM+(wid>>2)*32+(lane&3)*8;
  const unsigned kdst=lds0+LDS_K+wid*1024, vdst=lds0+LDS_V+wid*1024;
  #define DMA_K(t,slot) glds16(ksrc+(long)(t)*KVBLK*DM,(unsigned)__builtin_amdgcn_readfirstlane(kdst+(slot)))
  #define DMA_V(t,slot) glds16(vsrc+(long)(t)*KVBLK*DM,(unsigned)__builtin_amdgcn_readfirstlane(vdst+(slot)))
  const int vb0=(int)(lds0+LDS_V)+((lane>>4)&1)*32+(lane&3)*8+(4*hi+((lane&15)>>2))*64;
  const char*Kbase=shm+LDS_K; bf16x8 kf[8];
  const lds_cptr shm3=(lds_cptr)shm; const lds_cptr kp0=shm3+LDS_K+hi*1024+r32*16; const lds_cptr vp0=shm3+LDS_V+((lane>>4)&1)*32+(lane&3)*8+(4*hi+((lane&15)>>2))*64;
  const int NT=(q0+QB)/KVBLK;
  DMA_K(0,0);DMA_V(0,0);DMA_K(1,SLOTB);
  bf16x8 qr[4];
  #pragma unroll
  for(int d0=0;d0<4;++d0)qr[d0]=*reinterpret_cast<const bf16x8*>(&Qw[(long)r32*DM+d0*16+hi*8]);
  unsigned selmask=(1u<<qb)-1u;
  if(qb>3){
    float sc[7];
    #pragma unroll
    for(int n=0;n<7;++n){ sc[n]=-INFINITY;
      if(n<qb){ const float*kp=KS+((long)(b*8+n)*DM+h*D+hi*8); float a=0.f;
        #pragma unroll
        for(int d0=0;d0<4;++d0){ const float4 k0=*reinterpret_cast<const float4*>(kp+d0*16),k1=*reinterpret_cast<const float4*>(kp+d0*16+4);
          #define QF(j) __uint_as_float(((unsigned)(unsigned short)qr[d0][j])<<16)
          a+=QF(0)*k0.x+QF(1)*k0.y+QF(2)*k0.z+QF(3)*k0.w+QF(4)*k1.x+QF(5)*k1.y+QF(6)*k1.z+QF(7)*k1.w;
          #undef QF
        }
        { auto rr=__builtin_amdgcn_permlane32_swap(__float_as_uint(a),__float_as_uint(a),false,false); a=__uint_as_float(rr[0])+__uint_as_float(rr[1]); } sc[n]=a; }
      asm volatile("":::"memory"); }
    selmask=0u;
    #pragma unroll
    for(int n=0;n<7;++n){ int rk=0;
      #pragma unroll
      for(int m2=0;m2<7;++m2){ if(m2!=n) rk+=(sc[m2]>sc[n]||(sc[m2]==sc[n]&&m2<n))?1:0; }
      if(n<qb&&rk<3)selmask|=(1u<<n); }
  }
  float mhat=0.f,l_reg=0.f;f32x16 o[2];o[0]=f32x16{};o[1]=f32x16{};const f32x16 negm=f32x16{};
  const int qrel=wid*QBLK+r32;
  #define CMASK(P0,P1,t) do{const int t_=(t); const int jb_=t_-(NT-4); if(jb_>=0)cmask(P0,P1,jb_,qrel,hi); else if(!((selmask>>(t_>>2))&1u)){ _Pragma("unroll") for(int r_=0;r_<16;++r_){P0[r_]=-INFINITY;P1[r_]=-INFINITY;} } }while(0)
  bool resc=false;
  #define START(P0,P1) do{ const float rm=rowmax(P0,P1); resc=false; \
    { const float dl=__builtin_fmaxf(rm,-100.f); mhat=fadd_s(mhat,dl); \
      _Pragma("unroll") for(int r=0;r<16;++r){P0[r]=fsub_s(P0[r],dl);P1[r]=fsub_s(P1[r],dl);} \
      } \
    _Pragma("unroll") for(int r=0;r<16;++r)P0[r]=__builtin_amdgcn_exp2f(P0[r]); }while(0)
  #define RESC() do{ if(resc){ asm volatile("s_waitcnt lgkmcnt(0)":::"memory"); \
      _Pragma("unroll") for(int d_=0;d_<2;++d_) _Pragma("unroll") for(int r=0;r<16;++r)o[d_][r]*=wsf[crow(r,hi)]; } }while(0)
  f32x16 pA0,pA1,pB0,pB1;
  int sl_prev=0,sl_cur=0,sl_next=SLOTB;
  #define ROT() do{sl_prev=sl_cur;sl_cur=sl_next;sl_next=(sl_next==(NSLOT-1)*SLOTB)?0:sl_next+SLOTB;}while(0)
  DMA_K(2,2*SLOTB);
  WAIT_BAR(3);
  qkt(pA0,pA1,Kbase,qr,negm,r32,hi);asm volatile("s_nop 15\n\ts_nop 7":"+v"(pA0),"+v"(pA1));CMASK(pA0,pA1,0);
  START(pA0,pA1);
  _Pragma("unroll") for(int r=0;r<16;++r)pA1[r]=__builtin_amdgcn_exp2f(pA1[r]);
  WAIT_BAR(0);
  DMA_K(3,0);DMA_V(1,SLOTB);
  ROT();
  kload8(kf,kp0+sl_cur);
  WAIT_BAR(2);
  s16x4 vlo[8],vhi[8]; u32x4 pw0,pw1,pw2,pw3;
  #define PKW(P,B) cvtpk_s(P[B],P[B+1])
  #define PAF(k) __builtin_bit_cast(bf16x8,pw##k)
  #define VFR(i) (bf16x8){vlo[i][0],vlo[i][1],vlo[i][2],vlo[i][3],vhi[i][0],vhi[i][1],vhi[i][2],vhi[i][3]}
  #define PIN(x) asm volatile("":"+v"(x))
  #define MX3(a,b,c) __builtin_fmaxf(__builtin_fmaxf((a),(b)),(c))
  #define GAPA(MF,A0,A1,A2,A3,W0,W1,PW) do{ MF; sacc+=A0; sacc+=A1; sacc+=A2; sacc+=A3; PIN(sacc); W0; W1; PIN(PW); SBAR(); }while(0)
  #define EX(v) __builtin_amdgcn_exp2f(v)
  #define GAPB(MF,X,B) do{ MF; X[B]=EX(X[B]); X[B+1]=EX(X[B+1]); X[B+2]=EX(X[B+2]); X[B+3]=EX(X[B+3]); PIN(X); SBAR(); }while(0)
  #define VRD(i) do{ vlo[i]=vtr(vp_+(((i)>>2)*4096+((i)&3)*1024)); vhi[i]=vtr(vp_+(((i)>>2)*4096+((i)&3)*1024+512)); }while(0)
  #define KRD(G,j) do{ if(G){ kload2(kf,kp0+sl_next,j); SBAR(); } }while(0)
  #define STEP(C0,C1,P0,P1,t,GK,GV,GL) do{ SBAR(); \
    const lds_cptr vp_=vp0+sl_prev; \
    VRD(0); SBAR(); float sacc=(P0[0]+P0[1]); \
    GAPA(C0=__builtin_amdgcn_mfma_f32_32x32x16_bf16(kf[0],qr[0],negm,0,0,0), P0[2],P0[3],P0[4],P0[5],     pw0[0]=PKW(P0,0), pw0[1]=PKW(P0,2), pw0); \
    VRD(4); SBAR(); GAPA(C1=__builtin_amdgcn_mfma_f32_32x32x16_bf16(kf[1],qr[0],negm,0,0,0), P0[6],P0[7],P0[8],P0[9],     pw0[2]=PKW(P0,4), pw0[3]=PKW(P0,6), pw0); \
    VRD(1); SBAR(); GAPA(C0=__builtin_amdgcn_mfma_f32_32x32x16_bf16(kf[2],qr[1],C0,0,0,0),   P0[10],P0[11],P0[12],P0[13], pw1[0]=PKW(P0,8), pw1[1]=PKW(P0,10), pw1); \
    VRD(5); SBAR(); GAPA(C1=__builtin_amdgcn_mfma_f32_32x32x16_bf16(kf[3],qr[1],C1,0,0,0),   P0[14],P0[15],P1[0],P1[1],   pw1[2]=PKW(P0,12),pw1[3]=PKW(P0,14), pw1); \
    VRD(2); SBAR(); GAPA(C0=__builtin_amdgcn_mfma_f32_32x32x16_bf16(kf[4],qr[2],C0,0,0,0),   P1[2],P1[3],P1[4],P1[5],     pw2[0]=PKW(P1,0), pw2[1]=PKW(P1,2), pw2); \
    VRD(6); SBAR(); GAPA(C1=__builtin_amdgcn_mfma_f32_32x32x16_bf16(kf[5],qr[2],C1,0,0,0),   P1[6],P1[7],P1[8],P1[9],     pw2[2]=PKW(P1,4), pw2[3]=PKW(P1,6), pw2); \
    VRD(3); SBAR(); GAPA(C0=__builtin_amdgcn_mfma_f32_32x32x16_bf16(kf[6],qr[3],C0,0,0,0),   P1[10],P1[11],P1[12],P1[13], pw3[0]=PKW(P1,8), pw3[1]=PKW(P1,10), pw3); \
    VRD(7); SBAR(); GAPA(C1=__builtin_amdgcn_mfma_f32_32x32x16_bf16(kf[7],qr[3],C1,0,0,0),   P1[14],P1[15],0.f,0.f,       pw3[2]=PKW(P1,12),pw3[3]=PKW(P1,14), pw3); \
    l_reg+=sacc; \
    if(GK){DMA_K((t)+3,sl_cur);} if(GV){DMA_V((t)+1,sl_next);} \
    _Pragma("unroll") for(int r=0;r<16;++r){C0[r]-=mhat;C1[r]-=mhat;} \
    CMASK(C0,C1,t); \
    { float a=MX3(C0[0],C0[1],C1[0]),b=MX3(C0[2],C0[3],C1[1]); a=MX3(a,C1[2],C1[3]); \
      _Pragma("unroll") for(int r=4;r<16;r+=4){a=MX3(a,C0[r],C0[r+1]);b=MX3(b,C0[r+2],C0[r+3]);a=MX3(a,C1[r],C1[r+1]);b=MX3(b,C1[r+2],C1[r+3]);} \
      float rm=__builtin_fmaxf(a,b); { auto rr=__builtin_amdgcn_permlane32_swap(__float_as_uint(rm),__float_as_uint(rm),false,false); rm=__builtin_fmaxf(__uint_as_float(rr[0]),__uint_as_float(rr[1])); } \
      resc=false; \
      if(__builtin_expect(__any(rm>(float)THRL),0)){ const float dl=__builtin_fmaxf(rm,0.f); mhat+=dl; \
        _Pragma("unroll") for(int r=0;r<16;++r){C0[r]-=dl;C1[r]-=dl;} \
        const float f=__builtin_amdgcn_exp2f(-dl); l_reg*=f; if(hi==0)wsf[r32]=f; resc=true; } } \
    SBAR(); \
    GAPB(o[0]=__builtin_amdgcn_mfma_f32_32x32x16_bf16(PAF(0),VFR(0),o[0],0,0,0), C0,0); \
    GAPB(o[1]=__builtin_amdgcn_mfma_f32_32x32x16_bf16(PAF(0),VFR(4),o[1],0,0,0), C0,4); \
    KRD(GL,0); GAPB(o[0]=__builtin_amdgcn_mfma_f32_32x32x16_bf16(PAF(1),VFR(1),o[0],0,0,0), C0,8); \
    KRD(GL,1); GAPB(o[1]=__builtin_amdgcn_mfma_f32_32x32x16_bf16(PAF(1),VFR(5),o[1],0,0,0), C0,12); \
    KRD(GL,2); GAPB(o[0]=__builtin_amdgcn_mfma_f32_32x32x16_bf16(PAF(2),VFR(2),o[0],0,0,0), C1,0); \
    KRD(GL,3); GAPB(o[1]=__builtin_amdgcn_mfma_f32_32x32x16_bf16(PAF(2),VFR(6),o[1],0,0,0), C1,4); \
    GAPB(o[0]=__builtin_amdgcn_mfma_f32_32x32x16_bf16(PAF(3),VFR(3),o[0],0,0,0), C1,8); \
    GAPB(o[1]=__builtin_amdgcn_mfma_f32_32x32x16_bf16(PAF(3),VFR(7),o[1],0,0,0), C1,12); \
    }while(0)
  int t=1;
  #undef CMASK
  #define CMASK(P0,P1,t) do{ if(!((selmask>>((t)>>2))&1u)){ _Pragma("unroll") for(int r_=0;r_<16;++r_){P0[r_]=-INFINITY;P1[r_]=-INFINITY;} } }while(0)
  for(;t+5<NT;t+=2){
    STEP(pB0,pB1,pA0,pA1,t,true,true,true);     WAIT_BAR(2); RESC(); ROT();
    STEP(pA0,pA1,pB0,pB1,t+1,true,true,true);   WAIT_BAR(2); RESC(); ROT();
  }
  #undef CMASK
  int qrel2=qrel,hi2=hi; asm volatile("":"+v"(qrel2),"+v"(hi2));
  #define CMASK(P0,P1,t) do{const int t_=(t); const int jb_=t_-(NT-4); if(jb_>=0)cmask(P0,P1,jb_,qrel2,hi2); else if(!((selmask>>(t_>>2))&1u)){ _Pragma("unroll") for(int r_=0;r_<16;++r_){P0[r_]=-INFINITY;P1[r_]=-INFINITY;} } }while(0)
  #define ENDW(tt) do{ if((tt)+3<NT){WAIT_BAR(2);} else if((tt)+2<NT){WAIT_BAR(1);} else {WAIT_BAR(0);} }while(0)
  for(;t+1<NT;t+=2){
    STEP(pB0,pB1,pA0,pA1,t,(t+3<NT),(t+1<NT),(t+1<NT));       ENDW(t);   RESC(); ROT();
    STEP(pA0,pA1,pB0,pB1,t+1,(t+4<NT),(t+2<NT),(t+2<NT));     ENDW(t+1); RESC(); ROT();
  }
  STEP(pB0,pB1,pA0,pA1,NT-1,false,false,false); RESC();
  { float sacc=pB0[0]+pB0[1]; _Pragma("unroll") for(int r=2;r<16;++r)sacc+=pB0[r]; _Pragma("unroll") for(int r=0;r<16;++r)sacc+=pB1[r]; l_reg+=sacc;
    pw0=(u32x4){PKW(pB0,0),PKW(pB0,2),PKW(pB0,4),PKW(pB0,6)};pw1=(u32x4){PKW(pB0,8),PKW(pB0,10),PKW(pB0,12),PKW(pB0,14)};pw2=(u32x4){PKW(pB1,0),PKW(pB1,2),PKW(pB1,4),PKW(pB1,6)};pw3=(u32x4){PKW(pB1,8),PKW(pB1,10),PKW(pB1,12),PKW(pB1,14)};
    SBAR(); pv(o,vb0+sl_cur,PAF(0),PAF(1),PAF(2),PAF(3)); }
  #undef PKW
  #undef PAF
  #undef VFR
  #undef PIN
  #undef MX3
  #undef GAPA
  #undef GAPB
  #undef EX
  #undef VRD
  #undef KRD
  #undef STEP
  #undef ENDW
  {auto rr=__builtin_amdgcn_permlane32_swap(__float_as_uint(l_reg),__float_as_uint(l_reg),false,false);l_reg=__uint_as_float(rr[0])+__uint_as_float(rr[1]);}
  if(hi==0)wsf[32+r32]=l_reg;asm volatile("s_waitcnt lgkmcnt(0)":::"memory");
  float rli[16];
  #pragma unroll
  for(int r=0;r<16;++r)rli[r]=__builtin_amdgcn_rcpf(wsf[32+crow(r,hi)]);
  bf16*Ow=O+(rowbase+q0+wid*QBLK)*(long)opitch+h*D;
  { bf16*stg=(bf16*)(shm+LDS_OST)+wid*2048;
    #pragma unroll
    for(int r=0;r<16;++r){const int orow=crow(r,hi);
      #pragma unroll
      for(int d0=0;d0<2;++d0)stg[orow*64+d0*32+r32]=__float2bfloat16(o[d0][r]*rli[r]);}
    asm volatile("s_waitcnt lgkmcnt(0)":::"memory");
    #pragma unroll
    for(int i=0;i<4;++i){const int row=i*8+(lane>>3),ch=lane&7; const u32x4 v=*(const u32x4*)(stg+row*64+ch*8); ATTN_STORE16(Ow+(long)row*opitch+ch*8,v);} }
  asm volatile("s_waitcnt lgkmcnt(0)\n\ts_barrier":::"memory");
  #undef DMA_K
  #undef DMA_V
  #undef CMASK
  #undef START
  #undef RESC
  #undef ROT
}
constexpr int ATTN_LDS_BYTES=LDS_BYTES;
struct AttnTensors { const bf16* Q; const bf16* K; const bf16* V; bf16* O; int opitch; const float* KS; };
#undef SBAR
#undef WAIT_BAR
}
constexpr int NWAVES = 8;
#ifndef MK_N_LAUNCHES
#define MK_N_LAUNCHES 1
#endif
constexpr int N_LAUNCHES = MK_N_LAUNCHES;
constexpr int PER_PHASE = 10;

constexpr int D = 1024, NBATCH = 8, SEQ = 2048, MP = NBATCH * SEQ, NS = 128, MALL = MP + 256, NPAN = MALL / 256;
constexpr int MEMR = 2048, XNROWS = MALL + MEMR;
constexpr int FF = 4096, PW = 512, AW = 512, NH = 8, HD = 64, PST = 15, NPAGES = 16, PAGE = 128;
constexpr float EPS = 1e-6f;
constexpr float CROSS_C2 = 0.0625f * 1.4426950408889634f;
constexpr size_t O_YP = 0, O_YS = O_YP + (size_t)MP * D, O_KP = O_YS + (size_t)NS * D, O_VP = O_KP + (size_t)MP * AW, O_POOLP = O_VP + (size_t)MP * AW,
                 O_MK = O_POOLP + (size_t)NBATCH * PST * PW, O_MV = O_MK + (size_t)MEMR * D, O_KS = O_MV + (size_t)MEMR * D, O_VS = O_KS + (size_t)NS * AW, O_POOLS = O_VS + (size_t)NS * AW,
                 O_END = O_POOLS + (size_t)NS * PST * PW;
static_assert(O_END == 39055360, "output size");

constexpr size_t MiB = 1u << 20;
constexpr size_t WS_CTL = 0, CTL_ZERO_BYTES = 1 * MiB;
constexpr size_t WS_WIN = 2 * MiB;
constexpr size_t WS_WOUT = 10 * MiB, WS_WCQ = 12 * MiB, WS_WCO = 14 * MiB;
constexpr size_t WS_WUP = 16 * MiB;
constexpr size_t WS_WDN = 24 * MiB;
constexpr size_t WS_WPOOL = 32 * MiB;
constexpr size_t WS_ROPE = 33 * MiB;
constexpr size_t WS_SACC = 516 * MiB;
constexpr size_t SA_PS = 0, SA_A1 = 1 * MiB, SA_AQ = SA_A1 + 512 * 1024, SA_A3 = SA_AQ + 512 * 1024, SA_AD = SA_A3 + 512 * 1024, SACC_BYTES = 3 * MiB;
constexpr size_t WS_HBS = 351 * MiB;
constexpr size_t WS_XN = 36 * MiB;
constexpr size_t WS_U = 74 * MiB, WS_Q = 91 * MiB, WS_K = 108 * MiB, WS_V = 125 * MiB;
constexpr size_t WS_MIX = 142 * MiB;
constexpr size_t WS_XB = 176 * MiB;
constexpr size_t WS_XG = 242 * MiB;
constexpr size_t WS_QC = 276 * MiB;
constexpr size_t WS_OC = 310 * MiB;
constexpr size_t WS_MKB = 343 * MiB;
constexpr size_t WS_MVT = 347 * MiB;
constexpr size_t WS_PB = 352 * MiB;
constexpr size_t WS_HB = 384 * MiB;
constexpr size_t WS_END = 520 * MiB;
constexpr size_t WS_DUMMY = 520 * MiB;
static_assert(WS_XN + (size_t)XNROWS * D * 2 <= WS_U && WS_V + (size_t)MALL * 512 * 2 <= WS_MIX && WS_MIX + (size_t)MALL * D * 2 <= WS_XB && WS_XB + (size_t)MP * D * 2 <= WS_XG &&
              WS_XG + (size_t)MALL * D * 2 <= WS_QC && WS_QC + (size_t)MALL * D * 2 <= WS_OC && WS_OC + (size_t)MALL * D * 2 <= WS_MKB && WS_MKB + 4 * MiB <= WS_MVT && WS_MVT + 4 * MiB <= WS_HBS && WS_HBS + MiB <= WS_PB && WS_HB + (size_t)MALL * FF * 2 <= WS_SACC && WS_SACC + SACC_BYTES <= WS_END, "d_ws map");
constexpr int CW_TMO = 0, CW_CODE = 1;
constexpr int CW_Q2 = 256, CW_Q5 = 512;
constexpr int CW_BAR = 4096;
constexpr int CW_KSUM = 16384;
constexpr int CW_SS1 = 49152, CW_SS2 = CW_SS1 + 16896, CW_SS3 = CW_SS2 + 16896;
constexpr int CW_SSD = CW_SS3 + 16896;
static_assert((CW_SSD + 16896) * 4 <= (int)CTL_ZERO_BYTES && CW_KSUM + 8 * 8 * 512 <= CW_SS1, "CTL words inside the memset region");

constexpr int RING_OFF = 0, RING_BYTES = 131072;
constexpr int LDSCTL_OFF = RING_BYTES, MISC_OFF = LDSCTL_OFF + 320;
constexpr int LDS_BYTES = 147456;
static_assert(MISC_OFF + 128 <= LDS_BYTES, "LDS map");

#define GAS __attribute__((address_space(1)))
#define LAS __attribute__((address_space(3)))
typedef unsigned short bf16;
typedef unsigned v4u __attribute__((ext_vector_type(4)));
typedef unsigned v2u __attribute__((ext_vector_type(2)));
typedef float f32x4 __attribute__((ext_vector_type(4)));
typedef short bf16x8 __attribute__((ext_vector_type(8)));
typedef GAS unsigned gu32;
typedef GAS unsigned long long gu64;
#define RLX_AGENT __ATOMIC_RELAXED, __HIP_MEMORY_SCOPE_AGENT
#define LDS_WAIT() asm volatile("s_waitcnt lgkmcnt(0)" ::: "memory")
#define VM_WAIT() asm volatile("s_waitcnt vmcnt(0)" ::: "memory")
__device__ __forceinline__ unsigned f2bf(float f) { unsigned u = __builtin_bit_cast(unsigned, f); return (u + 0x7fffu + ((u >> 16) & 1u)) >> 16; }
__device__ __forceinline__ unsigned pk2(float lo, float hi) { return f2bf(lo) | (f2bf(hi) << 16); }
__device__ __forceinline__ float bf2f(unsigned short b) { return __uint_as_float(((unsigned)b) << 16); }

#define XB_TMO      128
#define XB_XCNT(j)  (256  + 64 * (j))
#define XB_XSUB(j)  (1280 + 64 * (j))
#define XB_XGEN(j)  (2304 + 64 * (j))
#define XB_TOP      3328
#define XB_TOPGEN   3392
#define XCD_BAR_WORDS 3456
#define XB_SPIN_CAP (1u << 18)

__device__ __forceinline__ unsigned xb_ld(unsigned* p)              { return __hip_atomic_load(p, __ATOMIC_RELAXED, __HIP_MEMORY_SCOPE_AGENT); }
__device__ __forceinline__ unsigned xb_add(unsigned* p, unsigned v) { return __hip_atomic_fetch_add(p, v, __ATOMIC_RELAXED, __HIP_MEMORY_SCOPE_AGENT); }
__device__ __forceinline__ unsigned xb_xcc_id() { return (unsigned)__builtin_amdgcn_s_getreg((3 << 11) | 20) & 0xFu; }
#define XB_SPIN(cond, bar) do { unsigned _sp = 0; while (cond) { __builtin_amdgcn_s_sleep(1); \
    if ((++_sp & 255u) == 0u) { if (xb_ld(&(bar)[XB_TMO])) break; if (_sp > XB_SPIN_CAP) { atomicAdd(&(bar)[XB_TMO], 1u); break; } } } } while (0)

struct XcdBarrier {
    unsigned* bar; unsigned x;
    int wave;
    volatile LAS unsigned* st;
};

__device__ __forceinline__ bool xb_thread0(int wave) { return wave == 0 && __builtin_amdgcn_mbcnt_hi(~0u, __builtin_amdgcn_mbcnt_lo(~0u, 0u)) == 0u; }
__device__ __forceinline__ XcdBarrier xcd_barrier_post(unsigned* bar, volatile LAS unsigned* st, int wave) {
    XcdBarrier b; b.bar = bar; b.x = xb_xcc_id(); b.st = st; b.wave = wave;
    if (xb_thread0(wave)) (void)xb_add(&bar[XB_XCNT(b.x)], 1u);
    return b;
}
__device__ __forceinline__ void xcd_barrier_complete(unsigned* bar, unsigned x, unsigned& nloc, unsigned& nx) {
    const unsigned G = gridDim.x * gridDim.y * gridDim.z;
    unsigned sum, cnt, mine, sp = 0u;
    for (;;) {
        sum = 0u; cnt = 0u; mine = 0u;
#pragma unroll
        for (unsigned j = 0; j < 16; ++j) { const unsigned c = xb_ld(&bar[XB_XCNT(j)]); sum += c; cnt += (c > 0u) ? 1u : 0u; mine = (j == x) ? c : mine; }
        if (sum == G) break;
        __builtin_amdgcn_s_sleep(1);
        if ((++sp & 255u) == 0u) { if (xb_ld(&bar[XB_TMO])) break; if (sp > XB_SPIN_CAP) { atomicAdd(&bar[XB_TMO], 1u); break; } }
    }
    nloc = mine > 0u ? mine : 1u; nx = cnt > 0u ? cnt : 1u;
}

__device__ __forceinline__ void xcd_barrier(const XcdBarrier& b) {
    asm volatile("s_waitcnt vmcnt(0)" ::: "memory");
    __syncthreads();
    if (xb_thread0(b.wave)) {
        unsigned* bar = b.bar;
        __builtin_amdgcn_s_waitcnt(0);
        unsigned nloc = b.st[0], nx = b.st[1];
        if (nloc == 0u) { xcd_barrier_complete(bar, b.x, nloc, nx); b.st[0] = nloc; b.st[1] = nx; }
        const unsigned old = xb_add(&bar[XB_XSUB(b.x)], 1u);
        const unsigned gen = old / nloc;
        if (old + 1u == (gen + 1u) * nloc) {
            __builtin_amdgcn_fence(__ATOMIC_RELEASE, "agent");
            asm volatile("s_waitcnt vmcnt(0)" ::: "memory");
            const unsigned og = xb_add(&bar[XB_TOP], 1u);
            const unsigned tg = og / nx;
            if (og + 1u == (tg + 1u) * nx) xb_add(&bar[XB_TOPGEN], 1u);
            else XB_SPIN(xb_ld(&bar[XB_TOPGEN]) == tg, bar);
            __builtin_amdgcn_fence(__ATOMIC_ACQUIRE, "agent");
            xb_add(&bar[XB_XGEN(b.x)], 1u);
            asm volatile("s_waitcnt vmcnt(0)" ::: "memory");
        } else {
            XB_SPIN(xb_ld(&bar[XB_XGEN(b.x)]) == gen, bar);
            __builtin_amdgcn_fence(__ATOMIC_ACQUIRE, "agent");
            asm volatile("s_waitcnt vmcnt(0)" ::: "memory");
        }
    }
    __syncthreads();
}


struct Args { const void* in[24]; float* out; unsigned char* ws; int ph_lo, ph_hi; };
struct Frame {
    LAS unsigned char* lds;
    volatile LAS unsigned* MISC;
    gu32* ctl;
    int wave;
    int vcu, G;
    float* out;
    unsigned char* ws;
};
#define WSP(T, off) ((T*)(F.ws + (off)))
__device__ __forceinline__ int LANE() { return (int)__builtin_amdgcn_mbcnt_hi(~0u, __builtin_amdgcn_mbcnt_lo(~0u, 0u)); }
#define TID(F) ((F).wave * 64 + LANE())

__device__ __forceinline__ float xshfl(float v, int m, int lane) { return __builtin_bit_cast(float, __builtin_amdgcn_ds_bpermute((lane ^ m) << 2, __builtin_bit_cast(int, v))); }
__device__ __forceinline__ float wave_sum(float v, int lane) {
#pragma unroll
    for (int o = 1; o < 64; o <<= 1) v += xshfl(v, o, lane);
    return v;
}
__device__ __forceinline__ float wave_max(float v, int lane) {
#pragma unroll
    for (int o = 1; o < 64; o <<= 1) v = __builtin_fmaxf(v, xshfl(v, o, lane));
    return v;
}
__device__ __forceinline__ int win_dst_row(int n) { if (n < 512 || n >= 1536) return n; const int t = n & ~255, j = n & 255, hh = j >> 6, p = (j >> 5) & 1, i = j & 31; return t + 128 * p + 32 * hh + i; }
template <bool WINPERM> __device__ __forceinline__ void p0_transpose_item(const float* W, int K, int N, bf16* WT, int row_off, LAS float* scr, int item, int lane, const float* kgain = nullptr) {
    const int nblk = N / 32, kb = item / nblk, nb = item % nblk, k0 = 64 * kb, n0 = 32 * nb;
    float wv[32];
#pragma unroll
    for (int i = 0; i < 32; ++i) { const int kk = 2 * i + (lane >> 5); wv[i] = W[(size_t)(k0 + kk) * N + n0 + (lane & 31)]; }
    if (kgain) {
#pragma unroll
        for (int i = 0; i < 32; ++i) wv[i] *= kgain[k0 + 2 * i + (lane >> 5)]; }
#pragma unroll
    for (int i = 0; i < 32; ++i) { const int kk = 2 * i + (lane >> 5); scr[kk * 33 + (lane & 31)] = wv[i]; }
    LDS_WAIT(); asm volatile("" ::: "memory");
    const int c = lane & 7;
#pragma unroll
    for (int j = 0; j < 4; ++j) { const int n = (lane >> 3) + 8 * j; const LAS float* s = scr + (8 * c) * 33 + n;
        v4u o; o.x = pk2(s[0 * 33], s[1 * 33]); o.y = pk2(s[2 * 33], s[3 * 33]); o.z = pk2(s[4 * 33], s[5 * 33]); o.w = pk2(s[6 * 33], s[7 * 33]);
        const int drow = WINPERM ? win_dst_row(n0 + n) : (n0 + n);
        *(GAS v4u*)(WT + (size_t)(row_off + drow) * K + k0 + 8 * c) = o; }
    LDS_WAIT(); asm volatile("" ::: "memory");
}
__device__ __forceinline__ void rms_row_to_bf16(int lane, const float* xrow, const float* gain, bf16* orow, bf16* rawrow = nullptr) {
    const GAS f32x4* xr = (const GAS f32x4*)xrow + lane; const GAS f32x4* gr = (const GAS f32x4*)gain + lane;
    f32x4 v[4]; float s = 0.f;
#pragma unroll
    for (int j = 0; j < 4; ++j) { v[j] = xr[64 * j]; s += (v[j].x * v[j].x + v[j].y * v[j].y) + (v[j].z * v[j].z + v[j].w * v[j].w); }
    const float rstd = 1.f / sqrtf(wave_sum(s, lane) * (1.f / D) + EPS);
    GAS unsigned long long* o8 = (GAS unsigned long long*)orow + lane;
    if (rawrow) { GAS unsigned long long* r8 = (GAS unsigned long long*)rawrow + lane;
#pragma unroll
        for (int j = 0; j < 4; ++j) r8[64 * j] = (unsigned long long)pk2(v[j].x, v[j].y) | ((unsigned long long)pk2(v[j].z, v[j].w) << 32); }
#pragma unroll
    for (int j = 0; j < 4; ++j) { const f32x4 g = gr[64 * j]; o8[64 * j] = (unsigned long long)pk2(v[j].x * rstd * g.x, v[j].y * rstd * g.y) | ((unsigned long long)pk2(v[j].z * rstd * g.z, v[j].w * rstd * g.w) << 32); }
}
__device__ __forceinline__ void p0_prologue(Frame& F, const Args& A) {
    LAS float* scr = (LAS float*)(F.lds + RING_OFF + F.wave * 16384);
    const int gw = F.vcu * NWAVES + F.wave, NGW = F.G * NWAVES;
    bf16* WIN = WSP(bf16, WS_WIN);
    constexpr int I_IN = (D / 64) * (2048 / 32), I_SQ = (D / 64) * (D / 32), I_UP = (D / 64) * (FF / 32), I_DN = (FF / 64) * (D / 32), I_PL = (128 / 64) * (128 / 32);
    constexpr int NITEMS = I_IN + 5 * I_SQ + I_UP + I_DN + 4 * I_PL;
    for (int it = gw; it < NITEMS; it += NGW) {
        int r = it;
        if (r < I_IN) { p0_transpose_item<true>(((const float*)A.in[10]), D, 2048, WIN, 0, scr, r, LANE()); continue; } r -= I_IN;
        if (r < I_SQ) { p0_transpose_item<false>(((const float*)A.in[17]), D, D, WIN, 2048, scr, r, LANE()); continue; } r -= I_SQ;
        if (r < I_SQ) { p0_transpose_item<false>(((const float*)A.in[18]), D, D, WIN, 3072, scr, r, LANE()); continue; } r -= I_SQ;
        if (r < I_SQ) { p0_transpose_item<false>(((const float*)A.in[13]), D, D, WSP(bf16, WS_WOUT), 0, scr, r, LANE()); continue; } r -= I_SQ;
        if (r < I_SQ) { p0_transpose_item<false>(((const float*)A.in[16]), D, D, WSP(bf16, WS_WCQ), 0, scr, r, LANE(), ((const float*)A.in[14])); continue; }     r -= I_SQ;
        if (r < I_SQ) { p0_transpose_item<false>(((const float*)A.in[19]), D, D, WSP(bf16, WS_WCO), 0, scr, r, LANE()); continue; } r -= I_SQ;
        if (r < I_UP) { p0_transpose_item<false>(((const float*)A.in[21]), D, FF, WSP(bf16, WS_WUP), 0, scr, r, LANE(), ((const float*)A.in[20])); continue; }     r -= I_UP;
        if (r < I_DN) { p0_transpose_item<false>(((const float*)A.in[22]), FF, D, WSP(bf16, WS_WDN), 0, scr, r, LANE()); continue; } r -= I_DN;
        { const int g = r / I_PL; p0_transpose_item<false>(((const float*)A.in[11]) + (size_t)g * 128 * 128, 128, 128, WSP(bf16, WS_WPOOL) + (size_t)g * 128 * 128, 0, scr, r % I_PL, LANE()); }
    }
    bf16* XN = WSP(bf16, WS_XN);
    for (int m = gw; m < MP; m += 2 * NGW) { const int m2 = m + NGW; const int lane = LANE();
        const GAS f32x4* xa = (const GAS f32x4*)(((const float*)A.in[0]) + (size_t)m * D) + lane; const GAS f32x4* xb = (const GAS f32x4*)(((const float*)A.in[0]) + (size_t)(m2 < MP ? m2 : m) * D) + lane;
        const GAS f32x4* gr = (const GAS f32x4*)((const float*)A.in[9]) + lane;
        f32x4 va[4], vb[4]; float sa = 0.f, sb = 0.f;
#pragma unroll
        for (int j = 0; j < 4; ++j) { va[j] = xa[64 * j]; vb[j] = xb[64 * j]; }
#pragma unroll
        for (int j = 0; j < 4; ++j) { sa += (va[j].x * va[j].x + va[j].y * va[j].y) + (va[j].z * va[j].z + va[j].w * va[j].w); sb += (vb[j].x * vb[j].x + vb[j].y * vb[j].y) + (vb[j].z * vb[j].z + vb[j].w * vb[j].w); }
        const float ra = 1.f / sqrtf(wave_sum(sa, lane) * (1.f / D) + EPS), rb = 1.f / sqrtf(wave_sum(sb, lane) * (1.f / D) + EPS);
        GAS unsigned long long* oa = (GAS unsigned long long*)(XN + (size_t)m * D) + lane; GAS unsigned long long* ra8 = (GAS unsigned long long*)(WSP(bf16, WS_XB) + (size_t)m * D) + lane;
#pragma unroll
        for (int j = 0; j < 4; ++j) { const f32x4 g = gr[64 * j]; oa[64 * j] = (unsigned long long)pk2(va[j].x * ra * g.x, va[j].y * ra * g.y) | ((unsigned long long)pk2(va[j].z * ra * g.z, va[j].w * ra * g.w) << 32);
            ra8[64 * j] = (unsigned long long)pk2(va[j].x, va[j].y) | ((unsigned long long)pk2(va[j].z, va[j].w) << 32); }
        if (m2 < MP) { GAS unsigned long long* ob = (GAS unsigned long long*)(XN + (size_t)m2 * D) + lane; GAS unsigned long long* rb8 = (GAS unsigned long long*)(WSP(bf16, WS_XB) + (size_t)m2 * D) + lane;
#pragma unroll
            for (int j = 0; j < 4; ++j) { const f32x4 g = gr[64 * j]; ob[64 * j] = (unsigned long long)pk2(vb[j].x * rb * g.x, vb[j].y * rb * g.y) | ((unsigned long long)pk2(vb[j].z * rb * g.z, vb[j].w * rb * g.w) << 32);
                rb8[64 * j] = (unsigned long long)pk2(vb[j].x, vb[j].y) | ((unsigned long long)pk2(vb[j].z, vb[j].w) << 32); } }
    }
    for (int m = MP + gw; m < XNROWS; m += NGW) {
        if (m < MP + NS) rms_row_to_bf16(LANE(), ((const float*)A.in[1]) + (size_t)(m - MP) * D, ((const float*)A.in[9]), XN + (size_t)m * D);
        else if (m < MALL) { GAS unsigned long long* o8 = (GAS unsigned long long*)(XN + (size_t)m * D) + LANE(); o8[0] = 0ull; o8[64] = 0ull; o8[128] = 0ull; o8[192] = 0ull; }
        else rms_row_to_bf16(LANE(), ((const float*)A.in[8]) + (size_t)(m - MALL) * D, ((const float*)A.in[15]), XN + (size_t)m * D);
    }
    { float* rc = WSP(float, WS_ROPE); float* rs = rc + 2049 * 32; const int gt = F.vcu * (NWAVES * 64) + TID(F), NT = F.G * NWAVES * 64;
      for (int e = gt; e < 2049 * 32; e += NT) { const int pos = e >> 5, i = e & 31; const float invf = exp2f(-(float)i * (13.287712379549449f / 32.0f)); const double a = (double)pos * (double)invf; const double kq = __builtin_rint(a * 0.15915494309189535); const float rr = (float)(a - kq * 6.283185307179586); rc[e] = cosf(rr); rs[e] = sinf(rr); }
      { GAS f32x4* z = (GAS f32x4*)WSP(float, WS_SACC); for (int e = gt; e < (int)(SACC_BYTES / 16); e += NT) z[e] = (f32x4){0.f, 0.f, 0.f, 0.f}; }
      const GAS f32x4* sp = (const GAS f32x4*)((const float*)A.in[6]); GAS f32x4* po = (GAS f32x4*)(F.out + O_POOLS);
      for (int e = gt; e < NS * 14 * (PW / 4); e += NT) { const int s = e / (14 * 128), r = (e / 128) % 14, c = e & 127; po[(s * 15 + r) * 128 + c] = sp[(s * 15 + r + 1) * 128 + c]; } }
}
constexpr int POOL_LD = 136;
__device__ __forceinline__ void pool_mma_store(Frame& F, const Args& A, int row0, int g) {
    const LAS unsigned char* DB = F.lds + RING_OFF + 40960;
    const int fr = LANE() & 15, fq = LANE() >> 4, w = F.wave;
    const bf16* WP = WSP(bf16, WS_WPOOL) + (size_t)g * 128 * 128;
    f32x4 acc[8]; bf16x8 bw[4][8];
#pragma unroll
    for (int ks = 0; ks < 4; ++ks)
#pragma unroll
        for (int nb = 0; nb < 8; ++nb) bw[ks][nb] = *(const GAS bf16x8*)(WP + (size_t)(nb * 16 + fr) * 128 + ks * 32 + 8 * fq);
#pragma unroll
    for (int nb = 0; nb < 8; ++nb) acc[nb] = (f32x4){0.f, 0.f, 0.f, 0.f};
#pragma unroll
    for (int ks = 0; ks < 4; ++ks) {
        const bf16x8 a = *(const LAS bf16x8*)(DB + ((16 * w + fr) * POOL_LD + ks * 32 + 8 * fq) * 2);
#pragma unroll
        for (int nb = 0; nb < 8; ++nb) acc[nb] = __builtin_amdgcn_mfma_f32_16x16x32_bf16(bw[ks][nb], a, acc[nb], 0, 0, 0);
    }
    bf16* MIX = WSP(bf16, WS_MIX);
#pragma unroll
    for (int nb = 0; nb < 8; ++nb) { const int col = g * 128 + nb * 16 + 4 * fq; const f32x4 sp = *(const GAS f32x4*)(((const float*)A.in[12]) + col); const f32x4 v = acc[nb] * sp;
        v2u o; o.x = pk2(v[0], v[1]); o.y = pk2(v[2], v[3]); *(GAS v2u*)(MIX + (size_t)(row0 + 16 * w + fr) * D + col) = o; }
}
__device__ __forceinline__ void pool_unit(Frame& F, const Args& A, int L) {
    LAS unsigned short* UB = (LAS unsigned short*)(F.lds + RING_OFF);
    LAS unsigned short* DB = (LAS unsigned short*)(F.lds + RING_OFF + 40960);
    const int c = TID(F) & 127, strip = TID(F) >> 7;
    if (L < 512) {
        const int pnl = L >> 2, g = L & 3, r0 = pnl * 128, w = 2 << g; const bool first = (r0 & (SEQ - 1)) == 0;
        const bf16* U = WSP(bf16, WS_U);
        for (int e = TID(F); e < 144 * 16; e += NWAVES * 64) { const int rr = e >> 4, ch = e & 15; v4u v = {0u, 0u, 0u, 0u};
            if (!(first && rr < 16)) v = *(const GAS v4u*)(U + (size_t)(r0 - 16 + rr) * PW + g * 128 + ch * 8);
            *(LAS v4u*)(UB + rr * POOL_LD + ch * 8) = v; }
        LDS_WAIT(); __syncthreads();
        const int rs = strip * 32; float s = 0.f;
        for (int j = 1; j < w; ++j) s += bf2f(UB[(16 + rs - j) * POOL_LD + c]);
        const int pos0 = (r0 & (SEQ - 1)) + rs; const float invw = 1.0f / (float)w;
        for (int r = 0; r < 32; ++r) { const float uv = bf2f(UB[(16 + rs + r) * POOL_LD + c]); s += uv; const int pos = pos0 + r;
            const float inv = (pos + 1 >= w) ? invw : 1.0f / (float)(pos + 1);
            DB[(rs + r) * POOL_LD + c] = (unsigned short)f2bf(s * inv - uv); s -= bf2f(UB[(16 + rs + r - w + 1) * POOL_LD + c]); }
        LDS_WAIT(); __syncthreads();
        pool_mma_store(F, A, r0, g);
    } else {
        const int g = L - 512, w = 2 << g; const float invw = 1.0f / (float)w;
        const float* ps = WSP(float, WS_SACC + SA_PS);
        for (int r = 0; r < 32; ++r) { const int smp = strip * 32 + r; const float uv = ps[(size_t)smp * 2048 + g * 128 + c]; float s = uv;
            F.out[O_POOLS + (size_t)(smp * 15 + 14) * PW + g * 128 + c] = uv;
            for (int j = 1; j < w; ++j) s += ((const float*)A.in[6])[(size_t)(smp * 15 + 15 - j) * PW + g * 128 + c];
            DB[smp * POOL_LD + c] = (unsigned short)f2bf(s * invw - uv); }
        LDS_WAIT(); __syncthreads();
        pool_mma_store(F, A, MP, g);
    }
    LDS_WAIT(); __syncthreads();
}
__device__ __forceinline__ void sample_moba(Frame& F, const Args& A, int b) {
    int lane_ = LANE(); asm volatile("" : "+v"(lane_)); const int h = F.wave, lane = lane_, sub = lane & 15, rw = lane >> 4;
    LAS float* LG = (LAS float*)(F.lds + RING_OFF + h * 8192);
    const int* pt = ((const int*)A.in[7]) + b * NPAGES;
    const float* ps = WSP(float, WS_SACC + SA_PS) + (size_t)b * 2048;
    f32x4 qv, kn, vn;
    { const int i4 = 4 * (sub & 7); const float* rc = WSP(float, WS_ROPE) + 2048 * 32 + i4; const f32x4 c = *(const GAS f32x4*)rc, sn = *(const GAS f32x4*)(rc + 2049 * 32);
      const f32x4 q1 = *(const GAS f32x4*)(ps + 512 + h * 64 + i4), q2 = *(const GAS f32x4*)(ps + 512 + h * 64 + 32 + i4), k1 = *(const GAS f32x4*)(ps + 1024 + h * 64 + i4), k2 = *(const GAS f32x4*)(ps + 1024 + h * 64 + 32 + i4);
      qv = (sub < 8) ? (q1 * c - q2 * sn) : (q2 * c + q1 * sn); kn = (sub < 8) ? (k1 * c - k2 * sn) : (k2 * c + k1 * sn); vn = *(const GAS f32x4*)(ps + 1536 + h * 64 + 4 * sub);
      if (rw == 0) { *(GAS f32x4*)(F.out + O_KS + (size_t)b * 512 + h * 64 + 4 * sub) = kn; *(GAS f32x4*)(F.out + O_VS + (size_t)b * 512 + h * 64 + 4 * sub) = vn; }
      qv = qv * 0.125f; }
    LAS float* BS = (LAS float*)(F.lds + RING_OFF + 65536 + h * 64);
#pragma unroll 1
    for (int n = 0; n < 8; ++n) {
        float sacc = 0.f;
#pragma unroll 1
        for (int pg = 0; pg < 2; ++pg) { const int page = __builtin_amdgcn_readfirstlane(pt[2 * n + pg]);
            const float* base = ((const float*)A.in[2]) + ((size_t)page * PAGE * NH + h) * HD + 4 * sub;
            { f32x4 kv[32];
#pragma unroll
                for (int u = 0; u < 32; ++u) kv[u] = __builtin_nontemporal_load((const GAS f32x4*)(base + (size_t)(4 * u + rw) * (NH * HD)));
#pragma unroll
                for (int u = 0; u < 32; ++u) { float p = (kv[u][0] * qv[0] + kv[u][1] * qv[1]) + (kv[u][2] * qv[2] + kv[u][3] * qv[3]);
                    p += xshfl(p, 1, lane); p += xshfl(p, 2, lane); p += xshfl(p, 4, lane); p += xshfl(p, 8, lane);
                    if (sub == 0) LG[n * 256 + pg * 128 + 4 * u + rw] = p; sacc += p; } } }
        sacc += xshfl(sacc, 16, lane); sacc += xshfl(sacc, 32, lane); if (lane == 0) BS[n] = sacc;
    }
    LDS_WAIT();
    float bsum[8];
#pragma unroll
    for (int n = 0; n < 8; ++n) bsum[n] = BS[n];
    unsigned sel = 0u;
#pragma unroll
    for (int n = 0; n < 8; ++n) { int rk = 0;
#pragma unroll
        for (int m2 = 0; m2 < 8; ++m2) if (m2 != n) rk += (bsum[m2] > bsum[n] || (bsum[m2] == bsum[n] && m2 < n)) ? 1 : 0;
        if (rk < 3) sel |= 1u << n; }
    sel = __builtin_amdgcn_readfirstlane(sel);
    float pown = (kn[0] * qv[0] + kn[1] * qv[1]) + (kn[2] * qv[2] + kn[3] * qv[3]);
    pown += xshfl(pown, 1, lane); pown += xshfl(pown, 2, lane); pown += xshfl(pown, 4, lane); pown += xshfl(pown, 8, lane);
    LDS_WAIT();
    float mx = pown;
#pragma unroll
    for (int n = 0; n < 8; ++n) if ((sel >> n) & 1u) { const f32x4 l4 = *(const LAS f32x4*)(LG + n * 256 + 4 * lane); mx = __builtin_fmaxf(mx, __builtin_fmaxf(__builtin_fmaxf(l4[0], l4[1]), __builtin_fmaxf(l4[2], l4[3]))); }
    mx = wave_max(mx, lane);
    f32x4 oacc = {0.f, 0.f, 0.f, 0.f}; float lsum = 0.f;
#pragma unroll 1
    for (int n = 0; n < 8; ++n) if ((sel >> n) & 1u) {
#pragma unroll 1
        for (int pg = 0; pg < 2; ++pg) { const int page = __builtin_amdgcn_readfirstlane(pt[2 * n + pg]);
            const float* base = ((const float*)A.in[3]) + ((size_t)page * PAGE * NH + h) * HD + 4 * sub;
            { f32x4 vv[32];
#pragma unroll
                for (int u = 0; u < 32; ++u) vv[u] = __builtin_nontemporal_load((const GAS f32x4*)(base + (size_t)(4 * u + rw) * (NH * HD)));
#pragma unroll
                for (int u = 0; u < 32; ++u) { const float e = __expf(LG[n * 256 + pg * 128 + 4 * u + rw] - mx); lsum += e; oacc += vv[u] * e; } } } }
    { const float e = __expf(pown - mx); if (rw == 0) { lsum += e; oacc += vn * e; } }
    lsum += xshfl(lsum, 16, lane); lsum += xshfl(lsum, 32, lane);
#pragma unroll
    for (int j = 0; j < 4; ++j) { float v = oacc[j]; v += xshfl(v, 16, lane); v += xshfl(v, 32, lane); oacc[j] = v; }
    if (lane < 16) { const float inv = 1.0f / lsum; v2u o; o.x = pk2(oacc[0] * inv, oacc[1] * inv); o.y = pk2(oacc[2] * inv, oacc[3] * inv);
        *(GAS v2u*)(WSP(bf16, WS_MIX) + (size_t)(MP + b) * D + PW + h * 64 + 4 * sub) = o; }
    LDS_WAIT();
}
__device__ __forceinline__ void sample_cross(Frame& F, const Args& A, int b) {
    int lane_ = LANE(); asm volatile("" : "+v"(lane_)); const int lane = lane_, w = F.wave;
    LAS float* LG = (LAS float*)(F.lds + RING_OFF);
    LAS float* PO = (LAS float*)(F.lds + RING_OFF + 4096);
    f32x4 q[4];
#pragma unroll
    for (int hh = 0; hh < 4; ++hh) q[hh] = *(const GAS f32x4*)(WSP(float, WS_SACC + SA_AQ) + (size_t)b * D + hh * 256 + 4 * lane);
    const float* kb = ((const float*)A.in[4]) + (size_t)b * 256 * D;
    for (int k0 = 0; k0 < 32; k0 += 8) { f32x4 kv[8][4];
#pragma unroll
        for (int u = 0; u < 8; ++u)
#pragma unroll
            for (int hh = 0; hh < 4; ++hh) kv[u][hh] = __builtin_nontemporal_load((const GAS f32x4*)(kb + (size_t)(w + 8 * (k0 + u)) * D + hh * 256 + 4 * lane));
#pragma unroll
        for (int u = 0; u < 8; ++u)
#pragma unroll
            for (int hh = 0; hh < 4; ++hh) { float p = (kv[u][hh][0] * q[hh][0] + kv[u][hh][1] * q[hh][1]) + (kv[u][hh][2] * q[hh][2] + kv[u][hh][3] * q[hh][3]); p = wave_sum(p, lane); if (lane == 0) LG[hh * 256 + w + 8 * (k0 + u)] = p; } }
    LDS_WAIT(); __syncthreads();
    if (w < 4) { const f32x4 l4 = *(const LAS f32x4*)(LG + w * 256 + 4 * lane); const float mx = wave_max(__builtin_fmaxf(__builtin_fmaxf(l4[0], l4[1]), __builtin_fmaxf(l4[2], l4[3])), lane);
        f32x4 e; e[0] = __builtin_amdgcn_exp2f(l4[0] - mx); e[1] = __builtin_amdgcn_exp2f(l4[1] - mx); e[2] = __builtin_amdgcn_exp2f(l4[2] - mx); e[3] = __builtin_amdgcn_exp2f(l4[3] - mx);
        const float inv = 1.0f / wave_sum((e[0] + e[1]) + (e[2] + e[3]), lane); *(LAS f32x4*)(LG + w * 256 + 4 * lane) = e * inv; }
    LDS_WAIT(); __syncthreads();
    const float* vb = ((const float*)A.in[5]) + (size_t)b * 256 * D;
    f32x4 oacc[4];
#pragma unroll
    for (int hh = 0; hh < 4; ++hh) oacc[hh] = (f32x4){0.f, 0.f, 0.f, 0.f};
    for (int k0 = 0; k0 < 32; k0 += 8) { f32x4 vv[8][4];
#pragma unroll
        for (int u = 0; u < 8; ++u)
#pragma unroll
            for (int hh = 0; hh < 4; ++hh) vv[u][hh] = __builtin_nontemporal_load((const GAS f32x4*)(vb + (size_t)(w + 8 * (k0 + u)) * D + hh * 256 + 4 * lane));
#pragma unroll
        for (int u = 0; u < 8; ++u)
#pragma unroll
            for (int hh = 0; hh < 4; ++hh) oacc[hh] += vv[u][hh] * LG[hh * 256 + w + 8 * (k0 + u)]; }
#pragma unroll
    for (int hh = 0; hh < 4; ++hh) *(LAS f32x4*)(PO + w * 1024 + hh * 256 + 4 * lane) = oacc[hh];
    LDS_WAIT(); __syncthreads();
    { const int c = 2 * (w * 64 + lane); float a0 = 0.f, a1 = 0.f;
#pragma unroll
      for (int ww = 0; ww < 8; ++ww) { a0 += PO[ww * 1024 + c]; a1 += PO[ww * 1024 + c + 1]; }
      *(GAS unsigned*)(WSP(bf16, WS_OC) + (size_t)(MP + b) * D + c) = pk2(a0, a1); }
    LDS_WAIT(); __syncthreads();
}
__device__ __forceinline__ void cross_unit(Frame& F, int pm, int h) {
    const int b = pm >> 3;
    bf16* PB = WSP(bf16, WS_PB) + (size_t)blockIdx.x * 65536;
    { pg8::Gemm g{WSP(bf16, WS_QC) + (size_t)pm * 256 * D + h * 256, WSP(bf16, WS_MKB) + (size_t)b * 256 * D + h * 256, 256, D, D};
      pg8::EpiSoftmaxP E{PB}; pg8::OneUnit S;
      pg8::gemm_phase<pg8::EpiSoftmaxP, pg8::OneUnit, false, false>(F.lds + RING_OFF, g, S, E, F.wave); }
    VM_WAIT(); __syncthreads(); __builtin_amdgcn_fence(__ATOMIC_ACQUIRE, "agent"); VM_WAIT(); __syncthreads();
    { pg8::Gemm g{PB, WSP(bf16, WS_MVT) + (size_t)(b * 4 + h) * 65536, 256, 256, 256};
      pg8::EpiTile E{WSP(bf16, WS_OC) + (size_t)pm * 256 * D + h * 256, D}; pg8::OneUnit S;
      pg8::gemm_phase<pg8::EpiTile, pg8::OneUnit, false, false>(F.lds + RING_OFF, g, S, E, F.wave); }
    VM_WAIT(); __syncthreads();
}
__device__ __forceinline__ void final_norm(Frame& F, const Args& A) {
    const int gw = F.vcu * NWAVES + F.wave, NGW = F.G * NWAVES; const float* ss3 = (const float*)(F.ctl + CW_SS3); const GAS f32x4* gr = (const GAS f32x4*)((const float*)A.in[23]) + LANE();
    for (int m = gw; m < MP; m += 2 * NGW) { const int m2 = (m + NGW < MP) ? m + NGW : m;
        GAS f32x4* xa = (GAS f32x4*)(F.out + O_YP + (size_t)m * D) + LANE(); GAS f32x4* xb = (GAS f32x4*)(F.out + O_YP + (size_t)m2 * D) + LANE();
        f32x4 va[4], vb[4];
#pragma unroll
        for (int j = 0; j < 4; ++j) { va[j] = xa[64 * j]; vb[j] = xb[64 * j]; }
        const float ra = 1.0f / sqrtf(ss3[m] * (1.0f / D) + EPS), rb = 1.0f / sqrtf(ss3[m2] * (1.0f / D) + EPS);
#pragma unroll
        for (int j = 0; j < 4; ++j) { const f32x4 g = gr[64 * j]; xa[64 * j] = va[j] * ra * g; if (m2 != m) xb[64 * j] = vb[j] * rb * g; } }
    for (int m = MP + gw; m < MP + NS; m += NGW) {
        if (m < MP) { }
        else { const int b = m - MP; const GAS f32x4* x0 = (const GAS f32x4*)(WSP(float, WS_SACC + SA_A1) + (size_t)b * D) + LANE(); const GAS f32x4* x3 = (const GAS f32x4*)(WSP(float, WS_SACC + SA_AD) + (size_t)b * D) + LANE();
            f32x4 v[4]; float ss = 0.f;
#pragma unroll
            for (int j = 0; j < 4; ++j) { v[j] = x0[64 * j] + x3[64 * j]; ss += (v[j][0] * v[j][0] + v[j][1] * v[j][1]) + (v[j][2] * v[j][2] + v[j][3] * v[j][3]); }
            const float r = 1.0f / sqrtf(wave_sum(ss, LANE()) * (1.0f / D) + EPS); GAS f32x4* yr = (GAS f32x4*)(F.out + O_YS + (size_t)b * D) + LANE();
#pragma unroll
            for (int j = 0; j < 4; ++j) yr[64 * j] = v[j] * r * gr[64 * j]; }
    }
}
enum { SG_STORE = 0, SG_RES = 1, SG_SCALE = 2, SG_RELU2 = 3, SG_ATOMIC = 4 };
struct SGP { float* OUT; bf16* OUTB; const float* base; const float* gain; float* rowss; float sc; };
__device__ __forceinline__ int win_src_col(int c) { if (c < 512 || c >= 1536) return c; const int t = c & ~255, j = c & 255, p = j >> 7, hh = (j >> 5) & 3, i = j & 31; return t + 64 * hh + 32 * p + i; }
template <int EPI, bool WINPERM, int NSPLIT> __device__ __forceinline__ void sample_gemm(Frame& F, const bf16* Ab, int lda, const bf16* Bt, int ldb, int N, int K, const SGP P) {
    static_assert(NSPLIT == 1 || EPI == SG_ATOMIC, "only the atomic epilogue may split K");
    const int nsl = N / 16, ksteps = K / 32 / NSPLIT;
    int lane_ = LANE(); asm volatile("" : "+v"(lane_)); const int lane = lane_, fr = lane & 15, fq = lane >> 4, row = 16 * F.wave + fr;
    for (int v = F.vcu; v < nsl * NSPLIT; v += F.G) { const int sl = v % nsl, sp = v / nsl;
        f32x4 acc = {0.f, 0.f, 0.f, 0.f};
        const bf16* ap = Ab + (size_t)row * lda + 8 * fq + (size_t)sp * ksteps * 32; const bf16* bp = Bt + (size_t)(16 * sl + fr) * ldb + 8 * fq + (size_t)sp * ksteps * 32;
        for (int kb = 0; kb < ksteps; kb += 16) { bf16x8 a[16], b[16];
#pragma unroll
            for (int u = 0; u < 16; ++u) { a[u] = *(const GAS bf16x8*)(ap + (kb + u) * 32); b[u] = *(const GAS bf16x8*)(bp + (kb + u) * 32); }
#pragma unroll
            for (int u = 0; u < 16; ++u) acc = __builtin_amdgcn_mfma_f32_16x16x32_bf16(b[u], a[u], acc, 0, 0, 0); }
        const int col = WINPERM ? win_src_col(16 * sl + 4 * fq) : 16 * sl + 4 * fq;
        if (EPI == SG_STORE) { *(GAS f32x4*)(P.OUT + (size_t)row * N + col) = acc; }
        else if (EPI == SG_ATOMIC) { float* o = P.OUT + (size_t)row * N + col; unsafeAtomicAdd(o, acc[0]); unsafeAtomicAdd(o + 1, acc[1]); unsafeAtomicAdd(o + 2, acc[2]); unsafeAtomicAdd(o + 3, acc[3]); }
        else if (EPI == SG_RES) { const f32x4 x = *(const GAS f32x4*)(P.base + (size_t)row * N + col) + acc; *(GAS f32x4*)(P.OUT + (size_t)row * N + col) = x;
            v2u o; o.x = pk2(x[0], x[1]); o.y = pk2(x[2], x[3]); *(GAS v2u*)(P.OUTB + (size_t)row * N + col) = o;
            float ss = (x[0] * x[0] + x[1] * x[1]) + (x[2] * x[2] + x[3] * x[3]); ss += xshfl(ss, 16, lane); ss += xshfl(ss, 32, lane); if (fq == 0) unsafeAtomicAdd(P.rowss + row, ss); }
        else { const float r = P.sc / sqrtf(P.rowss[row] * (1.0f / D) + EPS); f32x4 hv = acc * r;
            if (EPI == SG_SCALE) { *(GAS f32x4*)(P.OUT + (size_t)row * N + col) = hv; }
            else { hv = __builtin_elementwise_max(hv, (f32x4){0.f, 0.f, 0.f, 0.f}); hv = hv * hv; v2u o; o.x = pk2(hv[0], hv[1]); o.y = pk2(hv[2], hv[3]); *(GAS v2u*)(P.OUTB + (size_t)row * N + col) = o; } }
    }
}
__device__ __forceinline__ int next_task(Frame& F, gu32* head) {
    int slot = 16; asm volatile("" : "+v"(slot));
    __syncthreads();
    if (TID(F) + slot == 16) F.MISC[slot] = __hip_atomic_fetch_add(head, 1u, RLX_AGENT);
    __syncthreads();
    return __builtin_amdgcn_readfirstlane((int)F.MISC[slot]);
}
#ifndef REPMASK
#define REPMASK 0
#endif
#define NREP(k) (1 + ((REPMASK >> (k)) & 1))
#ifndef SKIPMASK
#define SKIPMASK 0
#endif
__global__ void __launch_bounds__(NWAVES * 64, 2) mk_fwd(Args args) {
    const Args& A = args;
    extern __shared__ __attribute__((aligned(16))) unsigned char lds[];
    Frame F;
    F.lds = (LAS unsigned char*)lds;
    F.MISC = (volatile LAS unsigned*)(F.lds + MISC_OFF);
    F.wave = __builtin_amdgcn_readfirstlane((int)(threadIdx.x >> 6));
    F.G = gridDim.x; { const int bx = blockIdx.x; F.vcu = (F.G % 8 == 0) ? (bx % 8) * (F.G / 8) + bx / 8 : bx; }
    F.ws = args.ws; F.out = args.out; F.ctl = (gu32*)(args.ws + WS_CTL);
    for (int u = TID(F); u < (LDS_BYTES - LDSCTL_OFF) / 4; u += NWAVES * 64) ((LAS unsigned*)(F.lds + LDSCTL_OFF))[u] = 0u;
    __syncthreads();
    XcdBarrier bar; bar.bar = (unsigned*)(F.ctl + CW_BAR); bar.x = 0; bar.st = nullptr; bar.wave = F.wave;
    if (N_LAUNCHES != PER_PHASE) bar = xcd_barrier_post((unsigned*)(F.ctl + CW_BAR), F.MISC + 8, F.wave);
#define GRID_BAR(seam) do { if (N_LAUNCHES == PER_PHASE) { if (TID(F) == 0) __hip_atomic_store(F.ctl + CW_TMO, 0xBADBA0u | (unsigned)(seam), RLX_AGENT); } else { xcd_barrier(bar); } } while (0)
    const int lo = args.ph_lo, hi = args.ph_hi;
#define IN(k) (lo <= (k) && (k) < hi)
#define BOTH(k) (IN(k) && IN((k) + 1))
    float* const ss1 = (float*)(F.ctl + CW_SS1); float* const ss2 = (float*)(F.ctl + CW_SS2); float* const ss3 = (float*)(F.ctl + CW_SS3);
    float* const X1S = WSP(float, WS_SACC + SA_A1);

    if (IN(0) && !(SKIPMASK & (1 << 0))) { for (int rp = 0; rp < NREP(0); ++rp) p0_prologue(F, A); if (BOTH(0)) GRID_BAR(0);
        if (NREP(16) > 1) { for (int rp = 0; rp < 10; ++rp) GRID_BAR(0); }
        if (NREP(17) > 1) { for (int rp = 0; rp < 20; ++rp) (void)next_task(F, F.ctl + 2048 + 64 * rp); } }

    if (IN(1) && !(SKIPMASK & (1 << 1))) {
        sample_gemm<SG_STORE, true, 1>(F, WSP(bf16, WS_XN) + (size_t)MP * D, D, WSP(bf16, WS_WIN), D, 2048, D, SGP{WSP(float, WS_SACC + SA_PS), nullptr, nullptr, nullptr, nullptr, 1.f});
        for (int rp = 0; rp < NREP(1); ++rp) {
        pg8::Gemm g{WSP(bf16, WS_XN), WSP(bf16, WS_WIN), D, D, D}; pg8::StaticOrder S; S.init(MP, 2048, F.G, (int)blockIdx.x);
        float* rc = WSP(float, WS_ROPE);
        pg8::EpiQKV E{WSP(bf16, WS_U), WSP(bf16, WS_Q), WSP(bf16, WS_K), WSP(bf16, WS_V), WSP(bf16, WS_MKB), WSP(bf16, WS_MVT), (float*)(F.ctl + CW_KSUM), rc, rc + 2049 * 32,
                      F.out + O_KP, F.out + O_VP, F.out + O_POOLP, F.out + O_MK, F.out + O_MV, attn_body::C2};
        pg8::gemm_phase<pg8::EpiQKV, pg8::StaticOrder, true, true>(F.lds + RING_OFF, g, S, E, F.wave);
        }
        if (BOTH(1)) GRID_BAR(1);
    }

    if (IN(2) && !(SKIPMASK & (1 << 2))) {
        const attn_body::AttnTensors AT{(const attn_body::bf16*)WSP(bf16, WS_Q), (const attn_body::bf16*)WSP(bf16, WS_K), (const attn_body::bf16*)WSP(bf16, WS_V), (attn_body::bf16*)(WSP(bf16, WS_MIX) + PW), D, (const float*)(F.ctl + CW_KSUM)};
        for (int rp = 0; rp < NREP(10); ++rp)
        for (;;) { const int t = next_task(F, F.ctl + rp * 1024 + CW_Q2); if (t >= NS) break; sample_moba(F, A, t); }
        for (int rp = 0; rp < NREP(11); ++rp)
        for (;;) { const int i = next_task(F, F.ctl + rp * 1024 + CW_Q2 + 64); if (i >= 64) break;
            pg8::Gemm g{WSP(bf16, WS_XN), WSP(bf16, WS_WIN), D, D, D}; pg8::OneUnitAt S{65 + (i & 7), 8 + (i >> 3)};
            float* rc = WSP(float, WS_ROPE);
            pg8::EpiQKV E{WSP(bf16, WS_U), WSP(bf16, WS_Q), WSP(bf16, WS_K), WSP(bf16, WS_V), WSP(bf16, WS_MKB), WSP(bf16, WS_MVT), (float*)(F.ctl + CW_KSUM), rc, rc + 2049 * 32,
                          F.out + O_KP, F.out + O_VP, F.out + O_POOLP, F.out + O_MK, F.out + O_MV, attn_body::C2};
            pg8::gemm_phase<pg8::EpiQKV, pg8::OneUnitAt, false, true>(F.lds + RING_OFF, g, S, E, F.wave); }
        for (int rp = 0; rp < NREP(12); ++rp)
        for (;;) { const int i = next_task(F, F.ctl + rp * 1024 + CW_Q2 + 128); if (i >= 512) break; const int qb = 7 - (i >> 6), bh = i & 63;
            attn_body::attn_unit<8>(bh >> 3, bh & 7, qb, AT.Q, AT.K, AT.V, AT.O, AT.opitch, AT.KS, (char*)lds + RING_OFF, F.wave); }
        for (int rp = 0; rp < NREP(13); ++rp)
        for (;;) { const int i = next_task(F, F.ctl + rp * 1024 + CW_Q2 + 192); if (i >= 516) break; pool_unit(F, A, i); }
        if (BOTH(2)) GRID_BAR(2);
    }

    if (IN(3) && !(SKIPMASK & (1 << 3))) {
        sample_gemm<SG_RES, false, 1>(F, WSP(bf16, WS_MIX) + (size_t)MP * D, D, WSP(bf16, WS_WOUT), D, D, D, SGP{X1S, WSP(bf16, WS_XG) + (size_t)MP * D, ((const float*)A.in[1]), nullptr, ss1 + MP, 1.f});
        pg8::Gemm g{WSP(bf16, WS_MIX), WSP(bf16, WS_WOUT), D, D, D}; pg8::StaticOrder S; S.init(MP, D, F.G, (int)blockIdx.x);
        pg8::EpiResB E{WSP(bf16, WS_XB), WSP(bf16, WS_XG), nullptr, ss1};
        pg8::gemm_phase<pg8::EpiResB, pg8::StaticOrder, true, true>(F.lds + RING_OFF, g, S, E, F.wave);
        if (BOTH(3)) GRID_BAR(3);
    }
    if (IN(4) && !(SKIPMASK & (1 << 4))) {
        sample_gemm<SG_SCALE, false, 1>(F, WSP(bf16, WS_XG) + (size_t)MP * D, D, WSP(bf16, WS_WCQ), D, D, D, SGP{WSP(float, WS_SACC + SA_AQ), nullptr, nullptr, nullptr, ss1 + MP, CROSS_C2});
        for (int rp = 0; rp < NREP(4); ++rp) {
        pg8::Gemm g{WSP(bf16, WS_XG), WSP(bf16, WS_WCQ), D, D, D}; pg8::StaticOrder S; S.init(MP, D, F.G, (int)blockIdx.x);
        pg8::EpiScale<0> E{WSP(bf16, WS_QC), D, ss1, CROSS_C2};
        pg8::gemm_phase<pg8::EpiScale<0>, pg8::StaticOrder, true, true>(F.lds + RING_OFF, g, S, E, F.wave);
        }
        if (BOTH(4)) GRID_BAR(4);
    }
    if (IN(5) && !(SKIPMASK & (1 << 5))) {
        for (int rp = 0; rp < NREP(14); ++rp)
        for (;;) { const int t = next_task(F, F.ctl + rp * 1024 + CW_Q5); if (t >= NS) break; sample_cross(F, A, t); }
        for (int rp = 0; rp < NREP(15); ++rp)
        for (;;) { const int L = next_task(F, F.ctl + rp * 1024 + CW_Q5 + 64); if (L >= 256) break; cross_unit(F, L >> 2, L & 3); }
        if (BOTH(5)) GRID_BAR(5);
    }
    if (IN(6) && !(SKIPMASK & (1 << 6))) {
        sample_gemm<SG_RES, false, 1>(F, WSP(bf16, WS_OC) + (size_t)MP * D, D, WSP(bf16, WS_WCO), D, D, D, SGP{X1S, WSP(bf16, WS_XG) + (size_t)MP * D, X1S, nullptr, ss2 + MP, 1.f});
        pg8::Gemm g{WSP(bf16, WS_OC), WSP(bf16, WS_WCO), D, D, D}; pg8::StaticOrder S; S.init(MP, D, F.G, (int)blockIdx.x);
        pg8::EpiResB E{WSP(bf16, WS_XG), WSP(bf16, WS_XG), nullptr, ss2};
        pg8::gemm_phase<pg8::EpiResB, pg8::StaticOrder, true, true>(F.lds + RING_OFF, g, S, E, F.wave);
        if (BOTH(6)) GRID_BAR(6);
    }
    if (IN(7) && !(SKIPMASK & (1 << 7))) {
        sample_gemm<SG_RELU2, false, 1>(F, WSP(bf16, WS_XG) + (size_t)MP * D, D, WSP(bf16, WS_WUP), D, FF, D, SGP{nullptr, WSP(bf16, WS_HBS), nullptr, nullptr, ss2 + MP, 1.f});
        for (int rp = 0; rp < NREP(7); ++rp) {
        pg8::Gemm g{WSP(bf16, WS_XG), WSP(bf16, WS_WUP), D, D, D}; pg8::StaticOrder S; S.init(MP, FF, F.G, (int)blockIdx.x);
        pg8::EpiScale<1> E{WSP(bf16, WS_HB), FF, ss2, 1.0f};
        pg8::gemm_phase<pg8::EpiScale<1>, pg8::StaticOrder, true, true>(F.lds + RING_OFF, g, S, E, F.wave);
        }
        if (BOTH(7)) GRID_BAR(7);
    }
    if (IN(8) && !(SKIPMASK & (1 << 8))) {
        sample_gemm<SG_ATOMIC, false, 4>(F, WSP(bf16, WS_HBS), FF, WSP(bf16, WS_WDN), FF, D, FF, SGP{WSP(float, WS_SACC + SA_AD), nullptr, nullptr, nullptr, nullptr, 1.f});
        pg8::Gemm g{WSP(bf16, WS_HB), WSP(bf16, WS_WDN), FF, FF, FF}; pg8::StaticOrder S; S.init(MP, D, F.G, (int)blockIdx.x);
        pg8::EpiResB E{WSP(bf16, WS_XG), nullptr, F.out + O_YP, ss3};
        pg8::gemm_phase<pg8::EpiResB, pg8::StaticOrder, true, true>(F.lds + RING_OFF, g, S, E, F.wave);
        if (BOTH(8)) GRID_BAR(8);
    }
    if (IN(9) && !(SKIPMASK & (1 << 9))) { final_norm(F, A); }
#undef IN
#undef BOTH
}

extern "C" void kernel_launch(void* const* d_in, const int* in_sizes, int n_in, void* d_out, int out_size, void* d_ws, size_t ws_size, hipStream_t stream) {
    static int grid = 0;
    if (grid == 0) {
        if (n_in != 24 || in_sizes[0] != MP * D || (size_t)out_size != O_END || ws_size < WS_END) { fprintf(stderr, "kernel_launch: unexpected shapes: n_in %d in0 %d out %d ws %zu; nothing launched\n", n_in, n_in > 0 ? in_sizes[0] : -1, out_size, ws_size); grid = -1; return; }
        int dev = 0, cus = 0, per_cu = 0;
        if (hipGetDevice(&dev) != hipSuccess || hipDeviceGetAttribute(&cus, hipDeviceAttributeMultiprocessorCount, dev) != hipSuccess) { fprintf(stderr, "kernel_launch: hipGetDevice / hipDeviceGetAttribute failed\n"); grid = -1; return; }
        if (hipFuncSetAttribute((const void*)mk_fwd, hipFuncAttributeMaxDynamicSharedMemorySize, LDS_BYTES) != hipSuccess) { fprintf(stderr, "kernel_launch: hipFuncSetAttribute failed\n"); grid = -1; return; }
        if (hipOccupancyMaxActiveBlocksPerMultiprocessor(&per_cu, (const void*)mk_fwd, NWAVES * 64, LDS_BYTES) != hipSuccess || per_cu < 1) { fprintf(stderr, "kernel_launch: occupancy query reports %d workgroups per CU\n", per_cu); }
        (void)hipGetLastError();
        grid = cus;
        if (grid > 256) grid = 256;
    }
    if (grid < 0) return;
    if (hipMemsetAsync((char*)d_ws + WS_CTL, 0, CTL_ZERO_BYTES, stream) != hipSuccess) { fprintf(stderr, "kernel_launch: hipMemsetAsync failed\n"); return; }
    Args a{};
    for (int i = 0; i < 24; ++i) a.in[i] = d_in[i];
    a.out = (float*)d_out; a.ws = (unsigned char*)d_ws;
    for (int li = 0; li < N_LAUNCHES; ++li) {
        a.ph_lo = (N_LAUNCHES == PER_PHASE) ? li : 0; a.ph_hi = (N_LAUNCHES == PER_PHASE) ? li + 1 : PER_PHASE;
        hipLaunchKernelGGL(mk_fwd, dim3(grid), dim3(NWAVES * 64), LDS_BYTES, stream, a);
        const hipError_t le = hipPeekAtLastError();
        if (le != hipSuccess) { fprintf(stderr, "kernel_launch: launch %d failed: %s\n", li, hipGetErrorName(le)); break; }
    }
}
```

```cpp
#include <hip/hip_runtime.h>
#include <cstdio>
#include <cstdint>
#include <cmath>
namespace pg8 {
#define PG8_LAS __attribute__((address_space(3)))
typedef unsigned short bf16_t;
typedef short bf16x8 __attribute__((ext_vector_type(8)));
typedef float f32x4 __attribute__((ext_vector_type(4)));
typedef unsigned u32x4 __attribute__((ext_vector_type(4)));
constexpr int BM = 256, BK = 64, HALF = 128, HTB = HALF * BK * 2  , STAGE_BYTES = 8 * HTB, NXCD = 8, WGM = 8;

__host__ __device__ __forceinline__ int lds_byte(int r, int c) { const int st = (r >> 4) * 2 + (c >> 5), rr = r & 15, cc = c & 31, ob = rr * 64 + cc * 2; return st * 1024 + (ob ^ (((ob >> 9) & 1) << 5)); }
__host__ __device__ __forceinline__ void stage_rc(int b, int& R, int& C) { const int st = b / 1024, sb = b % 1024, swz = sb ^ (((sb >> 9) & 1) << 5); R = (st >> 1) * 16 + swz / 64; C = (st & 1) * 32 + (swz % 64) / 2; }
__host__ __device__ __forceinline__ int perm32(int rho) { const int n = rho >> 4, i = rho & 15; return 8 * (i >> 2) + 4 * n + (i & 3); }

struct Unit { int pm, pn; };
struct Gemm { const bf16_t* A; const bf16_t* Bt; int K, lda, ldb; };

struct StaticOrder {
    int nM, nN, nwg, G, c;
    __host__ __device__ void init(int M, int N, int G_, int c_) { nM = M / BM; nN = N / BM; nwg = nM * nN; G = G_; c = c_; }
    __host__ __device__ bool next(int i, Unit& u) const {
        const long L = (long)i * G + c; if (L >= nwg) return false;
        int wgid = (int)L; { const int q = nwg / NXCD, r = nwg % NXCD, xcd = wgid % NXCD, off = wgid / NXCD; wgid = (xcd < r ? xcd * (q + 1) : r * (q + 1) + (xcd - r) * q) + off; }
        const int nig = WGM * nN, gid = wgid / nig, fm = gid * WGM, gsz = (nM - fm) < WGM ? (nM - fm) : WGM;
        u.pm = fm + ((wgid % nig) % gsz); u.pn = (wgid % nig) / gsz; return true;
    }
    __device__ __forceinline__ void a_ready(const Unit&) const {}
    __device__ __forceinline__ void done(const Unit&) const {}
};

__device__ __forceinline__ unsigned cvt_pk_bf16(float lo, float hi) { unsigned r; asm volatile("v_cvt_pk_bf16_f32 %0, %1, %2" : "=v"(r) : "v"(lo), "v"(hi)); return r; }
typedef float f32x2 __attribute__((ext_vector_type(2)));
__device__ __forceinline__ float xshfl(float v, int m, int lane) { return __builtin_bit_cast(float, __builtin_amdgcn_ds_bpermute((lane ^ m) << 2, __builtin_bit_cast(int, v))); }
__device__ __forceinline__ u32x4 pack8(const f32x4 a, const f32x4 b) { u32x4 w; w.x = cvt_pk_bf16(a[0], a[1]); w.y = cvt_pk_bf16(a[2], a[3]); w.z = cvt_pk_bf16(b[0], b[1]); w.w = cvt_pk_bf16(b[2], b[3]); return w; }
__device__ __forceinline__ unsigned short bf16_1(float v) { return (unsigned short)(cvt_pk_bf16(v, 0.f) & 0xffffu); }


struct EpiQKV {
    static constexpr bool PERM = true, AFTER_DRAIN = false;
    bf16_t *U, *Q, *Kb, *V, *MKB, *MVT; float *ksum; const float *ropeC, *ropeS;
    float *o_kp, *o_vp, *o_poolp, *o_mk, *o_mv; float qscale;
    __device__ __forceinline__ void operator()(const f32x4 (&acc)[2][2][4][2], const Unit& u, int wr, int wc, int fr, int fq) const {
        const int pm = u.pm, pn = u.pn;
        if (pm >= 65) {
            const int isv = (pn - 8) >> 2, ct = (pn - 8) & 3;
#pragma unroll
            for (int ai = 0; ai < 2; ++ai)
#pragma unroll
                for (int m = 0; m < 4; ++m) { const int mrow = (pm - 65) * 256 + ai * 128 + wr * 64 + m * 16 + fr;
#pragma unroll
                    for (int bj = 0; bj < 2; ++bj) { const int cl = bj * 128 + wc * 32 + 8 * fq, col = ct * 256 + cl; const f32x4 v0 = acc[ai][bj][m][0], v1 = acc[ai][bj][m][1];
                        float* o = (isv ? o_mv : o_mk) + (size_t)mrow * 1024 + col; *(f32x4*)o = v0; *(f32x4*)(o + 4) = v1;
                        if (!isv) { *(u32x4*)(MKB + (size_t)mrow * 1024 + col) = pack8(v0, v1); }
                        else { const int b = mrow >> 8, key = mrow & 255; bf16_t* t = MVT + ((size_t)(b * 4 + ct) * 256 + cl) * 256 + key;
                            t[0 * 256] = bf16_1(v0[0]); t[1 * 256] = bf16_1(v0[1]); t[2 * 256] = bf16_1(v0[2]); t[3 * 256] = bf16_1(v0[3]);
                            t[4 * 256] = bf16_1(v1[0]); t[5 * 256] = bf16_1(v1[1]); t[6 * 256] = bf16_1(v1[2]); t[7 * 256] = bf16_1(v1[3]); } } }
            return;
        }
        const int kind = pn >> 1, half = pn & 1;
        if (kind == 0) {
#pragma unroll
            for (int ai = 0; ai < 2; ++ai)
#pragma unroll
                for (int m = 0; m < 4; ++m) { const int row = pm * 256 + ai * 128 + wr * 64 + m * 16 + fr;
#pragma unroll
                    for (int bj = 0; bj < 2; ++bj) { const int col = half * 256 + bj * 128 + wc * 32 + 8 * fq; const f32x4 v0 = acc[ai][bj][m][0], v1 = acc[ai][bj][m][1];
                        *(u32x4*)(U + (size_t)row * 512 + col) = pack8(v0, v1);
                        { const int pos = row & 2047; if (pos >= 2033) { float* o = o_poolp + ((size_t)((row >> 11) * 15 + pos - 2033) * 512 + col); *(f32x4*)o = v0; *(f32x4*)(o + 4) = v1; } } } }
        } else if (kind == 3) {
#pragma unroll
            for (int ai = 0; ai < 2; ++ai)
#pragma unroll
                for (int m = 0; m < 4; ++m) { const int row = pm * 256 + ai * 128 + wr * 64 + m * 16 + fr;
#pragma unroll
                    for (int bj = 0; bj < 2; ++bj) { const int col = half * 256 + bj * 128 + wc * 32 + 8 * fq; const f32x4 v0 = acc[ai][bj][m][0], v1 = acc[ai][bj][m][1];
                        *(u32x4*)(V + (size_t)row * 512 + col) = pack8(v0, v1);
                        { float* o = o_vp + (size_t)row * 512 + col; *(f32x4*)o = v0; *(f32x4*)(o + 4) = v1; } } }
        } else {
            const int head = half * 4 + wc, i0 = 8 * fq, col1 = head * 64 + i0, col2 = col1 + 32;
            f32x4 cs1a = {0.f, 0.f, 0.f, 0.f}, cs1b = cs1a, cs2a = cs1a, cs2b = cs1a;
#pragma unroll
            for (int ai = 0; ai < 2; ++ai)
#pragma unroll
                for (int m = 0; m < 4; ++m) { const int row = pm * 256 + ai * 128 + wr * 64 + m * 16 + fr; const int pos = row & 2047;
                    const f32x4 c0 = *(const f32x4*)(ropeC + pos * 32 + i0), c1 = *(const f32x4*)(ropeC + pos * 32 + i0 + 4), s0 = *(const f32x4*)(ropeS + pos * 32 + i0), s1 = *(const f32x4*)(ropeS + pos * 32 + i0 + 4);
                    const f32x4 x1a = acc[ai][0][m][0], x1b = acc[ai][0][m][1], x2a = acc[ai][1][m][0], x2b = acc[ai][1][m][1];
                    const f32x4 o1a = x1a * c0 - x2a * s0, o1b = x1b * c1 - x2b * s1, o2a = x2a * c0 + x1a * s0, o2b = x2b * c1 + x1b * s1;
                    if (kind == 1) {
                        *(u32x4*)(Q + (size_t)row * 512 + col1) = pack8(o1a * qscale, o1b * qscale); *(u32x4*)(Q + (size_t)row * 512 + col2) = pack8(o2a * qscale, o2b * qscale);
                    } else {
                        *(u32x4*)(Kb + (size_t)row * 512 + col1) = pack8(o1a, o1b); *(u32x4*)(Kb + (size_t)row * 512 + col2) = pack8(o2a, o2b);
                        { float* o = o_kp + (size_t)row * 512; *(f32x4*)(o + col1) = o1a; *(f32x4*)(o + col1 + 4) = o1b; *(f32x4*)(o + col2) = o2a; *(f32x4*)(o + col2 + 4) = o2b;
                            cs1a += o1a; cs1b += o1b; cs2a += o2a; cs2b += o2b; }
                    } }
            if (kind == 2) {
                float cs[16] = {cs1a[0], cs1a[1], cs1a[2], cs1a[3], cs1b[0], cs1b[1], cs1b[2], cs1b[3], cs2a[0], cs2a[1], cs2a[2], cs2a[3], cs2b[0], cs2b[1], cs2b[2], cs2b[3]};
#pragma unroll
                for (int j = 0; j < 16; ++j) { float v = cs[j]; v += xshfl(v, 1, fr + 16 * fq); v += xshfl(v, 2, fr + 16 * fq); v += xshfl(v, 4, fr + 16 * fq); v += xshfl(v, 8, fr + 16 * fq); cs[j] = v; }
                if (fr == 0) { float* kp = ksum + (size_t)pm * 512;
#pragma unroll
                    for (int j = 0; j < 8; ++j) { unsafeAtomicAdd(kp + col1 + j, cs[j]); unsafeAtomicAdd(kp + col2 + j, cs[8 + j]); } }
            }
        }
    }
};

struct EpiResB {
    static constexpr bool PERM = true, AFTER_DRAIN = false;
    const bf16_t* base; bf16_t* outb; float* outf; float* rowss;
    __device__ __forceinline__ void operator()(const f32x4 (&acc)[2][2][4][2], const Unit& u, int wr, int wc, int fr, int fq) const {
#pragma unroll
        for (int ai = 0; ai < 2; ++ai)
#pragma unroll
            for (int m = 0; m < 4; ++m) { const int row = u.pm * 256 + ai * 128 + wr * 64 + m * 16 + fr;
                float ss = 0.f;
#pragma unroll
                for (int bj = 0; bj < 2; ++bj) { const int col = u.pn * 256 + bj * 128 + wc * 32 + 8 * fq; const u32x4 bv = *(const u32x4*)(base + (size_t)row * 1024 + col);
                    const f32x4 b0 = {__uint_as_float(bv.x << 16), __uint_as_float(bv.x & 0xffff0000u), __uint_as_float(bv.y << 16), __uint_as_float(bv.y & 0xffff0000u)};
                    const f32x4 b1 = {__uint_as_float(bv.z << 16), __uint_as_float(bv.z & 0xffff0000u), __uint_as_float(bv.w << 16), __uint_as_float(bv.w & 0xffff0000u)};
                    const f32x4 x0 = b0 + acc[ai][bj][m][0], x1 = b1 + acc[ai][bj][m][1];
                    ss += (x0[0] * x0[0] + x0[1] * x0[1]) + (x0[2] * x0[2] + x0[3] * x0[3]) + (x1[0] * x1[0] + x1[1] * x1[1]) + (x1[2] * x1[2] + x1[3] * x1[3]);
                    if (outf) { float* op = outf + (size_t)row * 1024 + col; *(f32x4*)op = x0; *(f32x4*)(op + 4) = x1; }
                    else *(u32x4*)(outb + (size_t)row * 1024 + col) = pack8(x0, x1); }
                ss += xshfl(ss, 16, fr + 16 * fq); ss += xshfl(ss, 32, fr + 16 * fq);
                if (fq == 0) unsafeAtomicAdd(rowss + row, ss);
            }
    }
};
template <int ACT> struct EpiScale {
    static constexpr bool PERM = true, AFTER_DRAIN = false;
    bf16_t* O; int ldc; const float* rowss; float sc;
    __device__ __forceinline__ void operator()(const f32x4 (&acc)[2][2][4][2], const Unit& u, int wr, int wc, int fr, int fq) const {
#pragma unroll
        for (int ai = 0; ai < 2; ++ai)
#pragma unroll
            for (int m = 0; m < 4; ++m) { const int row = u.pm * 256 + ai * 128 + wr * 64 + m * 16 + fr;
                const float r = __builtin_amdgcn_rsqf(rowss[row] * (1.0f / 1024.0f) + 1e-6f) * sc;
#pragma unroll
                for (int bj = 0; bj < 2; ++bj) { const int col = u.pn * 256 + bj * 128 + wc * 32 + 8 * fq; f32x4 v0 = acc[ai][bj][m][0] * r, v1 = acc[ai][bj][m][1] * r;
                    if (ACT == 1) { v0 = __builtin_elementwise_max(v0, (f32x4){0.f, 0.f, 0.f, 0.f}); v1 = __builtin_elementwise_max(v1, (f32x4){0.f, 0.f, 0.f, 0.f}); v0 = v0 * v0; v1 = v1 * v1; }
                    *(u32x4*)(O + (size_t)row * ldc + col) = pack8(v0, v1); } }
    }
};
struct EpiTile {
    static constexpr bool PERM = true, AFTER_DRAIN = false;
    bf16_t* O; int ldc;
    __device__ __forceinline__ void operator()(const f32x4 (&acc)[2][2][4][2], const Unit&, int wr, int wc, int fr, int fq) const {
#pragma unroll
        for (int ai = 0; ai < 2; ++ai)
#pragma unroll
            for (int m = 0; m < 4; ++m) { const int row = ai * 128 + wr * 64 + m * 16 + fr;
#pragma unroll
                for (int bj = 0; bj < 2; ++bj) { const int col = bj * 128 + wc * 32 + 8 * fq; *(u32x4*)(O + (size_t)row * ldc + col) = pack8(acc[ai][bj][m][0], acc[ai][bj][m][1]); } }
    }
};
struct EpiSoftmaxP {
    static constexpr bool PERM = true, AFTER_DRAIN = true;
    bf16_t* P;
    __device__ __forceinline__ void fused(f32x4 (&acc)[2][2][4][2], const Unit&, int wr, int wc, int fr, int fq, PG8_LAS unsigned char* lds, int, int) const {
        PG8_LAS float* MX = (PG8_LAS float*)lds; PG8_LAS float* SM = (PG8_LAS float*)(lds + 4096);
#ifdef SOFTMAX_TRIVIAL
        if (fq == 0) MX[fr] = acc[0][0][0][0][0]; return;
#endif
#pragma unroll
        for (int ai = 0; ai < 2; ++ai)
#pragma unroll
            for (int m = 0; m < 4; ++m) { float mx = -INFINITY;
#pragma unroll
                for (int bj = 0; bj < 2; ++bj)
#pragma unroll
                    for (int n = 0; n < 2; ++n) { const f32x4 x = acc[ai][bj][m][n]; mx = __builtin_fmaxf(mx, __builtin_fmaxf(__builtin_fmaxf(x[0], x[1]), __builtin_fmaxf(x[2], x[3]))); }
                mx = __builtin_fmaxf(mx, xshfl(mx, 16, fr + 16 * fq)); mx = __builtin_fmaxf(mx, xshfl(mx, 32, fr + 16 * fq));
                if (fq == 0) MX[(ai * 128 + wr * 64 + m * 16 + fr) * 4 + wc] = mx; }
        asm volatile("s_waitcnt lgkmcnt(0)" ::: "memory"); __builtin_amdgcn_s_barrier(); asm volatile("" ::: "memory");
#pragma unroll
        for (int ai = 0; ai < 2; ++ai)
#pragma unroll
            for (int m = 0; m < 4; ++m) { const int r = ai * 128 + wr * 64 + m * 16 + fr; const f32x4 mv = *(const PG8_LAS f32x4*)(MX + r * 4);
                const float rm = __builtin_fmaxf(__builtin_fmaxf(mv[0], mv[1]), __builtin_fmaxf(mv[2], mv[3])); float s = 0.f;
#pragma unroll
                for (int bj = 0; bj < 2; ++bj)
#pragma unroll
                    for (int n = 0; n < 2; ++n) { f32x4 x = acc[ai][bj][m][n]; x[0] = __builtin_amdgcn_exp2f(x[0] - rm); x[1] = __builtin_amdgcn_exp2f(x[1] - rm); x[2] = __builtin_amdgcn_exp2f(x[2] - rm); x[3] = __builtin_amdgcn_exp2f(x[3] - rm);
                        s += (x[0] + x[1]) + (x[2] + x[3]); acc[ai][bj][m][n] = x; }
                s += xshfl(s, 16, fr + 16 * fq); s += xshfl(s, 32, fr + 16 * fq);
                if (fq == 0) SM[r * 4 + wc] = s; }
        asm volatile("s_waitcnt lgkmcnt(0)" ::: "memory"); __builtin_amdgcn_s_barrier(); asm volatile("" ::: "memory");
#pragma unroll
        for (int ai = 0; ai < 2; ++ai)
#pragma unroll
            for (int m = 0; m < 4; ++m) { const int r = ai * 128 + wr * 64 + m * 16 + fr; const f32x4 sv = *(const PG8_LAS f32x4*)(SM + r * 4);
                const float inv = 1.0f / ((sv[0] + sv[1]) + (sv[2] + sv[3]));
#pragma unroll
                for (int bj = 0; bj < 2; ++bj) { const int col = bj * 128 + wc * 32 + 8 * fq; *(u32x4*)(P + (size_t)r * 256 + col) = pack8(acc[ai][bj][m][0] * inv, acc[ai][bj][m][1] * inv); } }
    }
};
struct OneUnitAt {
    int pm, pn;
    __device__ __forceinline__ bool next(int i, Unit& u) const { if (i) return false; u.pm = pm; u.pn = pn; return true; }
    __device__ __forceinline__ void a_ready(const Unit&) const {}
    __device__ __forceinline__ void done(const Unit&) const {}
};
struct OneUnit {
    __device__ __forceinline__ bool next(int i, Unit& u) const { if (i) return false; u.pm = 0; u.pn = 0; return true; }
    __device__ __forceinline__ void a_ready(const Unit&) const {}
    __device__ __forceinline__ void done(const Unit&) const {}
};
struct SchedP1 {
    StaticOrder S1; int G, c;
    __device__ __forceinline__ void init(int G_, int c_) { S1.init(65 * 256, 2048, G_, c_); G = G_; c = c_; }
    __device__ __forceinline__ bool next(int i, Unit& u) const { if (S1.next(i, u)) return true; const long L = (long)i * G + c - 520; if (L < 0 || L >= 64) return false; u.pm = 65 + (int)(L & 7); u.pn = 8 + (int)(L >> 3); return true; }
    __device__ __forceinline__ void a_ready(const Unit&) const {}
    __device__ __forceinline__ void done(const Unit&) const {}
};

template <class Epi, class Sched, bool ALIGN_EPI = false, bool SP2 = false>
__device__ __forceinline__ void gemm_phase(PG8_LAS unsigned char* lds, const Gemm g, const Sched& S, const Epi& E, const int wid_in) {
    int lane_ = __builtin_amdgcn_mbcnt_hi(~0u, __builtin_amdgcn_mbcnt_lo(~0u, 0u)); asm volatile("" : "+v"(lane_));
    int wid_ = wid_in; asm volatile("" : "+s"(wid_));
    const int wid = wid_, lane = lane_, tid = wid * 64 + lane, wr = wid >> 2, wc = wid & 3, fr = lane & 15, fq = lane >> 4;
    const int K = g.K, nt = K / BK;
    unsigned voffA[2], voffB[2];
#pragma unroll
    for (int i = 0; i < 2; ++i) { int R, C; stage_rc(tid * 16 + i * 8192, R, C); const int Rb = Epi::PERM ? ((R & ~31) + perm32(R & 31)) : R;
        voffA[i] = (unsigned)(R * g.lda + C) * 2u; voffB[i] = (unsigned)(Rb * g.ldb + C) * 2u; }
    const size_t kstep = (size_t)(BK * 2);
    const size_t hstepA = (size_t)HALF * g.lda * 2, hstepB = (size_t)HALF * g.ldb * 2;
    const size_t tstepA = 2 * hstepA, tstepB = 2 * hstepB;
    const unsigned ldsw = (unsigned)wid * 1024u;
    const int aoff = lds_byte(wr * 64 + fr, fq * 8), boff = lds_byte(wc * 32 + fr, fq * 8);
#define PG8_SA(b, h) (((b) * 2 + (h)) * HTB)
#define PG8_SB(b, h) ((4 + (b) * 2 + (h)) * HTB)
#define PG8_STAGE(bufoff, gbase, voff) do { _Pragma("unroll") for (int _i = 0; _i < 2; ++_i) \
        __builtin_amdgcn_global_load_lds((const unsigned*)((const char*)(gbase) + (voff)[_i]), (PG8_LAS unsigned*)(lds + (bufoff) + ldsw + _i * 8192), 16, 0, 0); } while (0)
#define PG8_LDA(dst, b, h) do { _Pragma("unroll") for (int m = 0; m < 4; ++m) _Pragma("unroll") for (int k = 0; k < 2; ++k) dst[m][k] = *(const PG8_LAS bf16x8*)(lds + PG8_SA(b, h) + aoff + m * 2048 + k * 1024); } while (0)
#define PG8_LDB(dst, b, h) do { _Pragma("unroll") for (int n = 0; n < 2; ++n) _Pragma("unroll") for (int k = 0; k < 2; ++k) dst[n][k] = *(const PG8_LAS bf16x8*)(lds + PG8_SB(b, h) + boff + n * 2048 + k * 1024); } while (0)
#define PG8_MMA(ai, bj, At, Bt) do { __builtin_amdgcn_s_setprio(1); _Pragma("unroll") for (int m = 0; m < 4; ++m) _Pragma("unroll") for (int n = 0; n < 2; ++n) _Pragma("unroll") for (int k = 0; k < 2; ++k) \
        acc[ai][bj][m][n] = __builtin_amdgcn_mfma_f32_16x16x32_bf16(Bt[n][k], At[m][k], acc[ai][bj][m][n], 0, 0, 0); __builtin_amdgcn_s_setprio(0); } while (0)
#define PG8_WAIT_V(n) asm volatile("s_waitcnt vmcnt(" #n ")" ::: "memory")
#define PG8_WAIT_L(n) asm volatile("s_waitcnt lgkmcnt(" #n ")" ::: "memory")
#define PG8_BAR __builtin_amdgcn_s_barrier()
#define PG8_SCHED __builtin_amdgcn_sched_barrier(0)
    Unit cur, nxt; int ui = 0;
    if (!S.next(0, cur)) return;
    f32x4 acc[2][2][4][2];
#pragma unroll
    for (int a = 0; a < 2; ++a)
#pragma unroll
        for (int b = 0; b < 2; ++b)
#pragma unroll
            for (int m = 0; m < 4; ++m)
#pragma unroll
                for (int n = 0; n < 2; ++n) acc[a][b][m][n] = (f32x4){0.f, 0.f, 0.f, 0.f};
    bf16x8 At[4][2], B0[2][2], B1[2][2];
    const char* cA = (const char*)g.A + (size_t)cur.pm * tstepA; const char* cB = (const char*)g.Bt + (size_t)cur.pn * tstepB;
    S.a_ready(cur);
    if constexpr (SP2) {
        PG8_STAGE(PG8_SB(0, 0), cB, voffB); PG8_STAGE(PG8_SB(0, 1), cB + hstepB, voffB); PG8_STAGE(PG8_SA(0, 0), cA, voffA); PG8_STAGE(PG8_SA(0, 1), cA + hstepA, voffA);
        if (wr == 1) PG8_BAR;
        PG8_WAIT_V(2); PG8_BAR;
        PG8_STAGE(PG8_SB(1, 0), cB + kstep, voffB); PG8_STAGE(PG8_SA(1, 0), cA + kstep, voffA); PG8_STAGE(PG8_SB(1, 1), cB + hstepB + kstep, voffB);
        PG8_WAIT_V(6); PG8_BAR;
    } else {
        PG8_STAGE(PG8_SB(0, 0), cB, voffB); PG8_STAGE(PG8_SA(0, 0), cA, voffA); PG8_STAGE(PG8_SB(0, 1), cB + hstepB, voffB); PG8_STAGE(PG8_SA(0, 1), cA + hstepA, voffA);
        if (wr == 1) PG8_BAR;
        PG8_WAIT_V(4); PG8_BAR;
        PG8_STAGE(PG8_SB(1, 0), cB + kstep, voffB); PG8_STAGE(PG8_SA(1, 0), cA + kstep, voffA); PG8_STAGE(PG8_SB(1, 1), cB + hstepB + kstep, voffB);
        PG8_WAIT_V(6); PG8_BAR;
    }
    for (;;) {
        const bool has_next = S.next(ui + 1, nxt);
        const char* nA = has_next ? (const char*)g.A + (size_t)nxt.pm * tstepA : cA; const char* nB = has_next ? (const char*)g.Bt + (size_t)nxt.pn * tstepB : cB;
        for (int t = 0; t < nt; t += 2) {
            const bool last = (t == nt - 2);
            const char* a1 = cA + (size_t)(t + 1) * kstep;
            const char* a2 = last ? nA : cA + (size_t)(t + 2) * kstep; const char* b2 = last ? nB : cB + (size_t)(t + 2) * kstep;
            const char* a3 = a2 + kstep; const char* b3 = b2 + kstep;
            if (last && has_next) S.a_ready(nxt);
            if constexpr (SP2) {
            PG8_LDB(B0, 0, 0); PG8_LDB(B1, 0, 1); PG8_SCHED; PG8_LDA(At, 0, 0); PG8_STAGE(PG8_SA(1, 1), a1 + hstepA, voffA);
            PG8_WAIT_V(8); PG8_WAIT_L(0); PG8_BAR; PG8_MMA(0, 0, At, B0); PG8_MMA(0, 1, At, B1); PG8_BAR; PG8_SCHED;
            PG8_LDA(At, 0, 1); PG8_STAGE(PG8_SB(0, 0), b2, voffB); PG8_STAGE(PG8_SB(0, 1), b2 + hstepB, voffB); PG8_STAGE(PG8_SA(0, 0), a2, voffA);
            PG8_WAIT_V(8); PG8_WAIT_L(0); PG8_BAR; PG8_MMA(1, 0, At, B0); PG8_MMA(1, 1, At, B1); PG8_BAR; PG8_SCHED;
            PG8_LDB(B0, 1, 0); PG8_LDB(B1, 1, 1); PG8_SCHED; PG8_LDA(At, 1, 0); PG8_STAGE(PG8_SA(0, 1), a2 + hstepA, voffA);
            PG8_WAIT_V(8); PG8_WAIT_L(0); PG8_BAR; PG8_MMA(0, 0, At, B0); PG8_MMA(0, 1, At, B1); PG8_BAR; PG8_SCHED;
            PG8_LDA(At, 1, 1); PG8_STAGE(PG8_SB(1, 0), b3, voffB); PG8_STAGE(PG8_SB(1, 1), b3 + hstepB, voffB); PG8_STAGE(PG8_SA(1, 0), a3, voffA);
            PG8_WAIT_V(8); PG8_WAIT_L(0); PG8_BAR; PG8_MMA(1, 0, At, B0); PG8_MMA(1, 1, At, B1); PG8_BAR; PG8_SCHED;
            } else {
            PG8_LDB(B0, 0, 0); PG8_SCHED; PG8_LDA(At, 0, 0); PG8_STAGE(PG8_SA(1, 1), a1 + hstepA, voffA);
            PG8_WAIT_L(8); PG8_BAR; PG8_WAIT_L(0); PG8_MMA(0, 0, At, B0); PG8_BAR; PG8_SCHED;
            PG8_LDB(B1, 0, 1); PG8_STAGE(PG8_SB(0, 0), b2, voffB);
            PG8_BAR; PG8_WAIT_L(0); PG8_MMA(0, 1, At, B1); PG8_BAR;
            PG8_LDA(At, 0, 1); PG8_STAGE(PG8_SA(0, 0), a2, voffA);
            PG8_BAR; PG8_WAIT_L(0); PG8_MMA(1, 0, At, B0); PG8_BAR; PG8_SCHED;
            PG8_STAGE(PG8_SB(0, 1), b2 + hstepB, voffB);
            PG8_WAIT_V(6); PG8_BAR; PG8_MMA(1, 1, At, B1); PG8_BAR;
            PG8_LDB(B0, 1, 0); PG8_SCHED; PG8_LDA(At, 1, 0); PG8_STAGE(PG8_SA(0, 1), a2 + hstepA, voffA);
            PG8_WAIT_L(8); PG8_BAR; PG8_WAIT_L(0); PG8_MMA(0, 0, At, B0); PG8_BAR; PG8_SCHED;
            PG8_LDB(B1, 1, 1); PG8_STAGE(PG8_SB(1, 0), b3, voffB);
            PG8_BAR; PG8_WAIT_L(0); PG8_MMA(0, 1, At, B1); PG8_BAR;
            PG8_LDA(At, 1, 1); PG8_STAGE(PG8_SA(1, 0), a3, voffA);
            PG8_BAR; PG8_WAIT_L(0); PG8_MMA(1, 0, At, B0); PG8_BAR; PG8_SCHED;
            PG8_STAGE(PG8_SB(1, 1), b3 + hstepB, voffB);
            PG8_WAIT_V(6); PG8_BAR; PG8_MMA(1, 1, At, B1); PG8_BAR;
            }
        }
        if constexpr (ALIGN_EPI) { if (wr == 0) PG8_BAR; }
        if constexpr (!Epi::AFTER_DRAIN) { E(acc, cur, wr, wc, fr, fq); S.done(cur); }
        if (!has_next) break;
#pragma unroll
        for (int a = 0; a < 2; ++a)
#pragma unroll
            for (int b = 0; b < 2; ++b)
#pragma unroll
                for (int m = 0; m < 4; ++m)
#pragma unroll
                    for (int n = 0; n < 2; ++n) acc[a][b][m][n] = (f32x4){0.f, 0.f, 0.f, 0.f};
        cur = nxt; cA = nA; cB = nB; ++ui;
        if constexpr (ALIGN_EPI) { if (wr == 1) PG8_BAR; }
    }
    PG8_WAIT_V(0);
    if constexpr (!ALIGN_EPI) { if (wr == 0) PG8_BAR; }
    PG8_BAR;
    if constexpr (Epi::AFTER_DRAIN) { E.fused(acc, cur, wr, wc, fr, fq, lds, wid, lane); S.done(cur); }
#undef PG8_SA
#undef PG8_SB
#undef PG8_STAGE
#undef PG8_LDA
#undef PG8_LDB
#undef PG8_MMA
#undef PG8_WAIT_V
#undef PG8_WAIT_L
#undef PG8_BAR
#undef PG8_SCHED
}
}

#include <hip/hip_bf16.h>
namespace attn_body {
using bf16=__hip_bfloat16;
using bf16x8=__attribute__((ext_vector_type(8)))short;
using s16x4=__attribute__((ext_vector_type(4)))short;
using f32x16=__attribute__((ext_vector_type(16)))float;
using u32x4=__attribute__((ext_vector_type(4)))unsigned;
constexpr int BATCH=8,NHEAD=8,SEQ=2048,D=64,DM=NHEAD*D;
constexpr int NW=8,QBLK=32,QB=QBLK*NW,KVBLK=64,NQB=SEQ/QB;
constexpr int ATTN_PITCH=DM, ATTN_UNIT_ROWS=QB;
__device__ __forceinline__ int crow(int r,int hi){return (r&3)+8*(r>>2)+4*hi;}
#define SBAR() __builtin_amdgcn_sched_barrier(0)
__device__ __forceinline__ void cmask(f32x16&p0,f32x16&p1,int jb,int qrel,int hi){
  const float NEG=-INFINITY; int kb=64*jb+4*hi;
  #pragma unroll
  for(int r=0;r<16;++r){int kv=kb+(r&3)+8*(r>>2); if(kv>qrel)p0[r]=NEG; if(kv+32>qrel)p1[r]=NEG;}
}

constexpr int NSLOT=3, SLOTB=8192;
constexpr int LDS_K=0, LDS_V=NSLOT*SLOTB, LDS_WS=2*NSLOT*SLOTB, LDS_OST=LDS_WS+NW*64*4, LDS_BYTES=LDS_OST+NW*4096;
constexpr float C2=0.125f*1.4426950408889634f;
__device__ __forceinline__ void glds16(const void*gsrc,unsigned lds_dst){unsigned keep;
  asm volatile("s_mov_b32 %0, m0\n\ts_mov_b32 m0, %2\n\ts_nop 0\n\tglobal_load_lds_dwordx4 %1, off\n\ts_mov_b32 m0, %0":"=&s"(keep):"v"(gsrc),"s"(lds_dst):"memory");}
__device__ __forceinline__ float max3f(float a,float b,float c){float r;asm("v_max3_f32 %0, %1, %2, %3":"=v"(r):"v"(a),"v"(b),"v"(c));return r;}
__device__ __forceinline__ float max2f(float a,float b){float r;asm("v_max_f32_e32 %0, %1, %2":"=v"(r):"v"(a),"v"(b));return r;}
__device__ __forceinline__ float fadd_s(float a,float b){float r;asm("v_add_f32_e32 %0, %1, %2":"=v"(r):"v"(a),"v"(b));return r;}
__device__ __forceinline__ float fsub_s(float a,float b){float r;asm("v_sub_f32_e32 %0, %1, %2":"=v"(r):"v"(a),"v"(b));return r;}
typedef float f32x2_t __attribute__((ext_vector_type(2))); typedef __bf16 bf16x2_t __attribute__((ext_vector_type(2)));
__device__ __forceinline__ unsigned cvtpk_s(float lo,float hi){f32x2_t v={lo,hi};bf16x2_t b=__builtin_convertvector(v,bf16x2_t);return __builtin_bit_cast(unsigned,b);}
#define WAIT_BAR(N) asm volatile("s_waitcnt vmcnt(" #N ") lgkmcnt(0)\n\ts_barrier":::"memory")

__device__ __forceinline__ void qkt(f32x16&p0,f32x16&p1,const char*Kslot,const bf16x8*qr,const f32x16&negm,int r32,int hi){
  const char*kb=Kslot+hi*1024+r32*16;
  #pragma unroll
  for(int d0=0;d0<4;++d0){
    const bf16x8 b0=*reinterpret_cast<const bf16x8*>(kb+d0*2048);
    const bf16x8 b1=*reinterpret_cast<const bf16x8*>(kb+d0*2048+512);
    if(d0==0){p0=__builtin_amdgcn_mfma_f32_32x32x16_bf16(b0,qr[0],negm,0,0,0);p1=__builtin_amdgcn_mfma_f32_32x32x16_bf16(b1,qr[0],negm,0,0,0);}
    else{p0=__builtin_amdgcn_mfma_f32_32x32x16_bf16(b0,qr[d0],p0,0,0,0);p1=__builtin_amdgcn_mfma_f32_32x32x16_bf16(b1,qr[d0],p1,0,0,0);}}
}
typedef __attribute__((address_space(3))) const char* lds_cptr;
typedef short v4i16_t __attribute__((ext_vector_type(4)));
__device__ __forceinline__ void kload8(bf16x8*kf,lds_cptr kp){
  kf[0]=*(const __attribute__((address_space(3))) bf16x8*)(kp);      kf[1]=*(const __attribute__((address_space(3))) bf16x8*)(kp+512);
  kf[2]=*(const __attribute__((address_space(3))) bf16x8*)(kp+2048); kf[3]=*(const __attribute__((address_space(3))) bf16x8*)(kp+2560);
  kf[4]=*(const __attribute__((address_space(3))) bf16x8*)(kp+4096); kf[5]=*(const __attribute__((address_space(3))) bf16x8*)(kp+4608);
  kf[6]=*(const __attribute__((address_space(3))) bf16x8*)(kp+6144); kf[7]=*(const __attribute__((address_space(3))) bf16x8*)(kp+6656);
}
__device__ __forceinline__ void kload2(bf16x8*kf,lds_cptr kp,int j){ kf[2*j]=*(const __attribute__((address_space(3))) bf16x8*)(kp+j*2048); kf[2*j+1]=*(const __attribute__((address_space(3))) bf16x8*)(kp+j*2048+512); }
__device__ __forceinline__ s16x4 vtr(lds_cptr p){ return __builtin_bit_cast(s16x4,__builtin_amdgcn_ds_read_tr16_b64_v4i16((__attribute__((address_space(3))) v4i16_t*)p)); }
__device__ __forceinline__ float rowmax(const f32x16&p0,const f32x16&p1){
  float a=max3f(p0[0],p0[1],p1[0]),b=max3f(p0[2],p0[3],p1[1]);a=max3f(a,p1[2],p1[3]);
  #pragma unroll
  for(int r=4;r<16;r+=4){a=max3f(a,p0[r],p0[r+1]);b=max3f(b,p0[r+2],p0[r+3]);a=max3f(a,p1[r],p1[r+1]);b=max3f(b,p1[r+2],p1[r+3]);}
  const float m=max2f(a,b);
  auto rr=__builtin_amdgcn_permlane32_swap(__float_as_uint(m),__float_as_uint(m),false,false);
  return max2f(__uint_as_float(rr[0]),__uint_as_float(rr[1]));
}
__device__ __forceinline__ void pv(f32x16*o,int vb,bf16x8 pa0,bf16x8 pa1,bf16x8 pa2,bf16x8 pa3){
  #pragma unroll
  for(int d0=0;d0<2;++d0){s16x4 lo[4],hi[4];
    #pragma unroll
    for(int ks=0;ks<4;++ks){
      asm volatile("ds_read_b64_tr_b16 %0,%1 offset:%c2":"=&v"(lo[ks]):"v"(vb),"i"(d0*4096+ks*1024):"memory");
      asm volatile("ds_read_b64_tr_b16 %0,%1 offset:%c2":"=&v"(hi[ks]):"v"(vb),"i"(d0*4096+ks*1024+512):"memory");}
    asm volatile("s_waitcnt lgkmcnt(0)":::"memory");SBAR();
    #define PK(k) (bf16x8){lo[k][0],lo[k][1],lo[k][2],lo[k][3],hi[k][0],hi[k][1],hi[k][2],hi[k][3]}
    o[d0]=__builtin_amdgcn_mfma_f32_32x32x16_bf16(pa0,PK(0),o[d0],0,0,0);
    o[d0]=__builtin_amdgcn_mfma_f32_32x32x16_bf16(pa1,PK(1),o[d0],0,0,0);
    o[d0]=__builtin_amdgcn_mfma_f32_32x32x16_bf16(pa2,PK(2),o[d0],0,0,0);
    o[d0]=__builtin_amdgcn_mfma_f32_32x32x16_bf16(pa3,PK(3),o[d0],0,0,0);
    #undef PK
  }
}

#ifndef ATTN_STORE16
#define ATTN_STORE16(p,v) (*(u32x4*)(p)=(v))
#endif
template<int THRL> __device__ __forceinline__ void attn_unit(int b,int h,int qb,const bf16*Q,const bf16*__restrict__ K,const bf16*__restrict__ V,bf16*O,int opitch,const float*__restrict__ KS,char*shm,const int wid){
  int lane_=__builtin_amdgcn_mbcnt_hi(~0u,__builtin_amdgcn_mbcnt_lo(~0u,0u)); asm volatile("":"+v"(lane_)); const int lane=lane_,r32=lane&31,hi=lane>>5;
  const long rowbase=(long)b*SEQ; const int q0=qb*QB;
  const bf16*Qw=Q+(rowbase+q0+wid*QBLK)*DM+h*D;
  const bf16*Kh=K+rowbase*DM+h*D,*Vh=V+rowbase*DM+h*D;
  const unsigned lds0=(unsigned)(uintptr_t)shm;
  float*wsf=(float*)(shm+LDS_WS)+wid*64;
  const bf16*ksrc=Kh+(long)lane*DM+wid*8;
  const bf16*vsrc=Vh+(long)(16*(wid&3)+(lane>>2))*DM+(wid>>2)*32+(lane&3)*8;
  const unsigned kdst=lds0+LDS_K+wid*1024, vdst=lds0+LDS_V+wid*1024;
  #define DMA_K(t,slot) glds16(ksrc+(long)(t)*KVBLK*DM,(unsigned)__builtin_amdgcn_readfirstlane(kdst+(slot)))
  #define DMA_V(t,slot) glds16(vsrc+(long)(t)*KVBLK*DM,(unsigned)__builtin_amdgcn_readfirstlane(vdst+(slot)))
  const int vb0=(int)(lds0+LDS_V)+((lane>>4)&1)*32+(lane&3)*8+(4*hi+((lane&15)>>2))*64;
  const char*Kbase=shm+LDS_K; bf16x8 kf[8];
  const lds_cptr shm3=(lds_cptr)shm; const lds_cptr kp0=shm3+LDS_K+hi*1024+r32*16; const lds_cptr vp0=shm3+LDS_V+((lane>>4)&1)*32+(lane&3)*8+(4*hi+((lane&15)>>2))*64;
  const int NT=(q0+QB)/KVBLK;
  DMA_K(0,0);DMA_V(0,0);DMA_K(1,SLOTB);
  bf16x8 qr[4];
  #pragma unroll
  for(int d0=0;d0<4;++d0)qr[d0]=*reinterpret_cast<const bf16x8*>(&Qw[(long)r32*DM+d0*16+hi*8]);
  unsigned selmask=(1u<<qb)-1u;
  if(qb>3){
    float sc[7];
    #pragma unroll
    for(int n=0;n<7;++n){ sc[n]=-INFINITY;
      if(n<qb){ const float*kp=KS+((long)(b*8+n)*DM+h*D+hi*8); float a=0.f;
        #pragma unroll
        for(int d0=0;d0<4;++d0){ const float4 k0=*reinterpret_cast<const float4*>(kp+d0*16),k1=*reinterpret_cast<const float4*>(kp+d0*16+4);
          #define QF(j) __uint_as_float(((unsigned)(unsigned short)qr[d0][j])<<16)
          a+=QF(0)*k0.x+QF(1)*k0.y+QF(2)*k0.z+QF(3)*k0.w+QF(4)*k1.x+QF(5)*k1.y+QF(6)*k1.z+QF(7)*k1.w;
          #undef QF
        }
        { auto rr=__builtin_amdgcn_permlane32_swap(__float_as_uint(a),__float_as_uint(a),false,false); a=__uint_as_float(rr[0])+__uint_as_float(rr[1]); } sc[n]=a; }
      asm volatile("":::"memory"); }
    selmask=0u;
    #pragma unroll
    for(int n=0;n<7;++n){ int rk=0;
      #pragma unroll
      for(int m2=0;m2<7;++m2){ if(m2!=n) rk+=(sc[m2]>sc[n]||(sc[m2]==sc[n]&&m2<n))?1:0; }
      if(n<qb&&rk<3)selmask|=(1u<<n); }
  }
  float mhat=0.f,l_reg=0.f;f32x16 o[2];o[0]=f32x16{};o[1]=f32x16{};const f32x16 negm=f32x16{};
  const int qrel=wid*QBLK+r32;
  #define CMASK(P0,P1,t) do{const int t_=(t); const int jb_=t_-(NT-4); if(jb_>=0)cmask(P0,P1,jb_,qrel,hi); else if(!((selmask>>(t_>>2))&1u)){ _Pragma("unroll") for(int r_=0;r_<16;++r_){P0[r_]=-INFINITY;P1[r_]=-INFINITY;} } }while(0)
  bool resc=false;
  #define START(P0,P1) do{ const float rm=rowmax(P0,P1); resc=false; \
    { const float dl=__builtin_fmaxf(rm,-100.f); mhat=fadd_s(mhat,dl); \
      _Pragma("unroll") for(int r=0;r<16;++r){P0[r]=fsub_s(P0[r],dl);P1[r]=fsub_s(P1[r],dl);} \
      } \
    _Pragma("unroll") for(int r=0;r<16;++r)P0[r]=__builtin_amdgcn_exp2f(P0[r]); }while(0)
  #define RESC() do{ if(resc){ asm volatile("s_waitcnt lgkmcnt(0)":::"memory"); \
      _Pragma("unroll") for(int d_=0;d_<2;++d_) _Pragma("unroll") for(int r=0;r<16;++r)o[d_][r]*=wsf[crow(r,hi)]; } }while(0)
  f32x16 pA0,pA1,pB0,pB1;
  int sl_prev=0,sl_cur=0,sl_next=SLOTB;
  #define ROT() do{sl_prev=sl_cur;sl_cur=sl_next;sl_next=(sl_next==(NSLOT-1)*SLOTB)?0:sl_next+SLOTB;}while(0)
  DMA_K(2,2*SLOTB);
  WAIT_BAR(3);
  qkt(pA0,pA1,Kbase,qr,negm,r32,hi);asm volatile("s_nop 15\n\ts_nop 7":"+v"(pA0),"+v"(pA1));CMASK(pA0,pA1,0);
  START(pA0,pA1);
  _Pragma("unroll") for(int r=0;r<16;++r)pA1[r]=__builtin_amdgcn_exp2f(pA1[r]);
  WAIT_BAR(0);
  DMA_K(3,0);DMA_V(1,SLOTB);
  ROT();
  kload8(kf,kp0+sl_cur);
  WAIT_BAR(2);
  s16x4 vlo[8],vhi[8]; u32x4 pw0,pw1,pw2,pw3;
  #define PKW(P,B) cvtpk_s(P[B],P[B+1])
  #define PAF(k) __builtin_bit_cast(bf16x8,pw##k)
  #define VFR(i) (bf16x8){vlo[i][0],vlo[i][1],vlo[i][2],vlo[i][3],vhi[i][0],vhi[i][1],vhi[i][2],vhi[i][3]}
  #define PIN(x) asm volatile("":"+v"(x))
  #define MX3(a,b,c) __builtin_fmaxf(__builtin_fmaxf((a),(b)),(c))
  #define GAPA(MF,A0,A1,A2,A3,W0,W1,PW) do{ MF; sacc+=A0; sacc+=A1; sacc+=A2; sacc+=A3; PIN(sacc); W0; W1; PIN(PW); SBAR(); }while(0)
  #define EX(v) __builtin_amdgcn_exp2f(v)
  #define GAPB(MF,X,B) do{ MF; X[B]=EX(X[B]); X[B+1]=EX(X[B+1]); X[B+2]=EX(X[B+2]); X[B+3]=EX(X[B+3]); PIN(X); SBAR(); }while(0)
  #define VRD(i) do{ vlo[i]=vtr(vp_+(((i)>>2)*4096+((i)&3)*1024)); vhi[i]=vtr(vp_+(((i)>>2)*4096+((i)&3)*1024+512)); }while(0)
  #define KRD(G,j) do{ if(G){ kload2(kf,kp0+sl_next,j); SBAR(); } }while(0)
  #define STEP(C0,C1,P0,P1,t,GK,GV,GL) do{ SBAR(); \
    const lds_cptr vp_=vp0+sl_prev; \
    VRD(0); SBAR(); float sacc=(P0[0]+P0[1]); \
    GAPA(C0=__builtin_amdgcn_mfma_f32_32x32x16_bf16(kf[0],qr[0],negm,0,0,0), P0[2],P0[3],P0[4],P0[5],     pw0[0]=PKW(P0,0), pw0[1]=PKW(P0,2), pw0); \
    VRD(4); SBAR(); GAPA(C1=__builtin_amdgcn_mfma_f32_32x32x16_bf16(kf[1],qr[0],negm,0,0,0), P0[6],P0[7],P0[8],P0[9],     pw0[2]=PKW(P0,4), pw0[3]=PKW(P0,6), pw0); \
    VRD(1); SBAR(); GAPA(C0=__builtin_amdgcn_mfma_f32_32x32x16_bf16(kf[2],qr[1],C0,0,0,0),   P0[10],P0[11],P0[12],P0[13], pw1[0]=PKW(P0,8), pw1[1]=PKW(P0,10), pw1); \
    VRD(5); SBAR(); GAPA(C1=__builtin_amdgcn_mfma_f32_32x32x16_bf16(kf[3],qr[1],C1,0,0,0),   P0[14],P0[15],P1[0],P1[1],   pw1[2]=PKW(P0,12),pw1[3]=PKW(P0,14), pw1); \
    VRD(2); SBAR(); GAPA(C0=__builtin_amdgcn_mfma_f32_32x32x16_bf16(kf[4],qr[2],C0,0,0,0),   P1[2],P1[3],P1[4],P1[5],     pw2[0]=PKW(P1,0), pw2[1]=PKW(P1,2), pw2); \
    VRD(6); SBAR(); GAPA(C1=__builtin_amdgcn_mfma_f32_32x32x16_bf16(kf[5],qr[2],C1,0,0,0),   P1[6],P1[7],P1[8],P1[9],     pw2[2]=PKW(P1,4), pw2[3]=PKW(P1,6), pw2); \
    VRD(3); SBAR(); GAPA(C0=__builtin_amdgcn_mfma_f32_32x32x16_bf16(kf[6],qr[3],C0,0,0,0),   P1[10],P1[11],P1[12],P1[13], pw3[0]=PKW(P1,8), pw3[1]=PKW(P1,10), pw3); \
    VRD(7); SBAR(); GAPA(C1=__builtin_amdgcn_mfma_f32_32x32x16_bf16(kf[7],qr[3],C1,0,0,0),   P1[14],P1[15],0.f,0.f,       pw3[2]=PKW(P1,12),pw3[3]=PKW(P1,14), pw3); \
    l_reg+=sacc; \
    if(GK){DMA_K((t)+3,sl_cur);} if(GV){DMA_V((t)+1,sl_next);} \
    _Pragma("unroll") for(int r=0;r<16;++r){C0[r]-=mhat;C1[r]-=mhat;} \
    CMASK(C0,C1,t); \
    { float a=MX3(C0[0],C0[1],C1[0]),b=MX3(C0[2],C0[3],C1[1]); a=MX3(a,C1[2],C1[3]); \
      _Pragma("unroll") for(int r=4;r<16;r+=4){a=MX3(a,C0[r],C0[r+1]);b=MX3(b,C0[r+2],C0[r+3]);a=MX3(a,C1[r],C1[r+1]);b=MX3(b,C1[r+2],C1[r+3]);} \
      float rm=__builtin_fmaxf(a,b); { auto rr=__builtin_amdgcn_permlane32_swap(__float_as_uint(rm),__float_as_uint(rm),false,false); rm=__builtin_fmaxf(__uint_as_float(rr[0]),__uint_as_float(rr[1])); } \
      resc=false; \
      if(__builtin_expect(__any(rm>(float)THRL),0)){ const float dl=__builtin_fmaxf(rm,0.f); mhat+=dl; \
        _Pragma("unroll") for(int r=0;r<16;++r){C0[r]-=dl;C1[r]-=dl;} \
        const float f=__builtin_amdgcn_exp2f(-dl); l_reg*=f; if(hi==0)wsf[r32]=f; resc=true; } } \
    SBAR(); \
    GAPB(o[0]=__builtin_amdgcn_mfma_f32_32x32x16_bf16(PAF(0),VFR(0),o[0],0,0,0), C0,0); \
    GAPB(o[1]=__builtin_amdgcn_mfma_f32_32x32x16_bf16(PAF(0),VFR(4),o[1],0,0,0), C0,4); \
    KRD(GL,0); GAPB(o[0]=__builtin_amdgcn_mfma_f32_32x32x16_bf16(PAF(1),VFR(1),o[0],0,0,0), C0,8); \
    KRD(GL,1); GAPB(o[1]=__builtin_amdgcn_mfma_f32_32x32x16_bf16(PAF(1),VFR(5),o[1],0,0,0), C0,12); \
    KRD(GL,2); GAPB(o[0]=__builtin_amdgcn_mfma_f32_32x32x16_bf16(PAF(2),VFR(2),o[0],0,0,0), C1,0); \
    KRD(GL,3); GAPB(o[1]=__builtin_amdgcn_mfma_f32_32x32x16_bf16(PAF(2),VFR(6),o[1],0,0,0), C1,4); \
    GAPB(o[0]=__builtin_amdgcn_mfma_f32_32x32x16_bf16(PAF(3),VFR(3),o[0],0,0,0), C1,8); \
    GAPB(o[1]=__builtin_amdgcn_mfma_f32_32x32x16_bf16(PAF(3),VFR(7),o[1],0,0,0), C1,12); \
    }while(0)
  int t=1;
  #undef CMASK
  #define CMASK(P0,P1,t) do{ if(!((selmask>>((t)>>2))&1u)){ _Pragma("unroll") for(int r_=0;r_<16;++r_){P0[r_]=-INFINITY;P1[r_]=-INFINITY;} } }while(0)
  for(;t+5<NT;t+=2){
    STEP(pB0,pB1,pA0,pA1,t,true,true,true);     WAIT_BAR(2); RESC(); ROT();
    STEP(pA0,pA1,pB0,pB1,t+1,true,true,true);   WAIT_BAR(2); RESC(); ROT();
  }
  #undef CMASK
  int qrel2=qrel,hi2=hi; asm volatile("":"+v"(qrel2),"+v"(hi2));
  #define CMASK(P0,P1,t) do{const int t_=(t); const int jb_=t_-(NT-4); if(jb_>=0)cmask(P0,P1,jb_,qrel2,hi2); else if(!((selmask>>(t_>>2))&1u)){ _Pragma("unroll") for(int r_=0;r_<16;++r_){P0[r_]=-INFINITY;P1[r_]=-INFINITY;} } }while(0)
  #define ENDW(tt) do{ if((tt)+3<NT){WAIT_BAR(2);} else if((tt)+2<NT){WAIT_BAR(1);} else {WAIT_BAR(0);} }while(0)
  for(;t+1<NT;t+=2){
    STEP(pB0,pB1,pA0,pA1,t,(t+3<NT),(t+1<NT),(t+1<NT));       ENDW(t);   RESC(); ROT();
    STEP(pA0,pA1,pB0,pB1,t+1,(t+4<NT),(t+2<NT),(t+2<NT));     ENDW(t+1); RESC(); ROT();
  }
  STEP(pB0,pB1,pA0,pA1,NT-1,false,false,false); RESC();
  { float sacc=pB0[0]+pB0[1]; _Pragma("unroll") for(int r=2;r<16;++r)sacc+=pB0[r]; _Pragma("unroll") for(int r=0;r<16;++r)sacc+=pB1[r]; l_reg+=sacc;
    pw0=(u32x4){PKW(pB0,0),PKW(pB0,2),PKW(pB0,4),PKW(pB0,6)};pw1=(u32x4){PKW(pB0,8),PKW(pB0,10),PKW(pB0,12),PKW(pB0,14)};pw2=(u32x4){PKW(pB1,0),PKW(pB1,2),PKW(pB1,4),PKW(pB1,6)};pw3=(u32x4){PKW(pB1,8),PKW(pB1,10),PKW(pB1,12),PKW(pB1,14)};
    SBAR(); pv(o,vb0+sl_cur,PAF(0),PAF(1),PAF(2),PAF(3)); }
  #undef PKW
  #undef PAF
  #undef VFR
  #undef PIN
  #undef MX3
  #undef GAPA
  #undef GAPB
  #undef EX
  #undef VRD
  #undef KRD
  #undef STEP
  #undef ENDW
  {auto rr=__builtin_amdgcn_permlane32_swap(__float_as_uint(l_reg),__float_as_uint(l_reg),false,false);l_reg=__uint_as_float(rr[0])+__uint_as_float(rr[1]);}
  if(hi==0)wsf[32+r32]=l_reg;asm volatile("s_waitcnt lgkmcnt(0)":::"memory");
  float rli[16];
  #pragma unroll
  for(int r=0;r<16;++r)rli[r]=__builtin_amdgcn_rcpf(wsf[32+crow(r,hi)]);
  bf16*Ow=O+(rowbase+q0+wid*QBLK)*(long)opitch+h*D;
  { bf16*stg=(bf16*)(shm+LDS_OST)+wid*2048;
    #pragma unroll
    for(int r=0;r<16;++r){const int orow=crow(r,hi);
      #pragma unroll
      for(int d0=0;d0<2;++d0)stg[orow*64+d0*32+r32]=__float2bfloat16(o[d0][r]*rli[r]);}
    asm volatile("s_waitcnt lgkmcnt(0)":::"memory");
    #pragma unroll
    for(int i=0;i<4;++i){const int row=i*8+(lane>>3),ch=lane&7; const u32x4 v=*(const u32x4*)(stg+row*64+ch*8); ATTN_STORE16(Ow+(long)row*opitch+ch*8,v);} }
  asm volatile("s_waitcnt lgkmcnt(0)\n\ts_barrier":::"memory");
  #undef DMA_K
  #undef DMA_V
  #undef CMASK
  #undef START
  #undef RESC
  #undef ROT
}
constexpr int ATTN_LDS_BYTES=LDS_BYTES;
struct AttnTensors { const bf16* Q; const bf16* K; const bf16* V; bf16* O; int opitch; const float* KS; };
#undef SBAR
#undef WAIT_BAR
}
constexpr int NWAVES = 8;
#ifndef MK_N_LAUNCHES
#define MK_N_LAUNCHES 1
#endif
constexpr int N_LAUNCHES = MK_N_LAUNCHES;
constexpr int PER_PHASE = 10;

constexpr int D = 1024, NBATCH = 8, SEQ = 2048, MP = NBATCH * SEQ, NS = 128, MALL = MP + 256, NPAN = MALL / 256;
constexpr int MEMR = 2048, XNROWS = MALL + MEMR;
constexpr int FF = 4096, PW = 512, AW = 512, NH = 8, HD = 64, PST = 15, NPAGES = 16, PAGE = 128;
constexpr float EPS = 1e-6f;
constexpr float CROSS_C2 = 0.0625f * 1.4426950408889634f;
constexpr size_t O_YP = 0, O_YS = O_YP + (size_t)MP * D, O_KP = O_YS + (size_t)NS * D, O_VP = O_KP + (size_t)MP * AW, O_POOLP = O_VP + (size_t)MP * AW,
                 O_MK = O_POOLP + (size_t)NBATCH * PST * PW, O_MV = O_MK + (size_t)MEMR * D, O_KS = O_MV + (size_t)MEMR * D, O_VS = O_KS + (size_t)NS * AW, O_POOLS = O_VS + (size_t)NS * AW,
                 O_END = O_POOLS + (size_t)NS * PST * PW;
static_assert(O_END == 39055360, "output size");

constexpr size_t MiB = 1u << 20;
constexpr size_t WS_CTL = 0, CTL_ZERO_BYTES = 1 * MiB;
constexpr size_t WS_WIN = 2 * MiB;
constexpr size_t WS_WOUT = 10 * MiB, WS_WCQ = 12 * MiB, WS_WCO = 14 * MiB;
constexpr size_t WS_WUP = 16 * MiB;
constexpr size_t WS_WDN = 24 * MiB;
constexpr size_t WS_WPOOL = 32 * MiB;
constexpr size_t WS_ROPE = 33 * MiB;
constexpr size_t WS_SACC = 516 * MiB;
constexpr size_t SA_PS = 0, SA_A1 = 1 * MiB, SA_AQ = SA_A1 + 512 * 1024, SA_A3 = SA_AQ + 512 * 1024, SA_AD = SA_A3 + 512 * 1024, SACC_BYTES = 3 * MiB;
constexpr size_t WS_HBS = 351 * MiB;
constexpr size_t WS_XN = 36 * MiB;
constexpr size_t WS_U = 74 * MiB, WS_Q = 91 * MiB, WS_K = 108 * MiB, WS_V = 125 * MiB;
constexpr size_t WS_MIX = 142 * MiB;
constexpr size_t WS_XB = 176 * MiB;
constexpr size_t WS_XG = 242 * MiB;
constexpr size_t WS_QC = 276 * MiB;
constexpr size_t WS_OC = 310 * MiB;
constexpr size_t WS_MKB = 343 * MiB;
constexpr size_t WS_MVT = 347 * MiB;
constexpr size_t WS_PB = 352 * MiB;
constexpr size_t WS_HB = 384 * MiB;
constexpr size_t WS_END = 520 * MiB;
constexpr size_t WS_DUMMY = 520 * MiB;
static_assert(WS_XN + (size_t)XNROWS * D * 2 <= WS_U && WS_V + (size_t)MALL * 512 * 2 <= WS_MIX && WS_MIX + (size_t)MALL * D * 2 <= WS_XB && WS_XB + (size_t)MP * D * 2 <= WS_XG &&
              WS_XG + (size_t)MALL * D * 2 <= WS_QC && WS_QC + (size_t)MALL * D * 2 <= WS_OC && WS_OC + (size_t)MALL * D * 2 <= WS_MKB && WS_MKB + 4 * MiB <= WS_MVT && WS_MVT + 4 * MiB <= WS_HBS && WS_HBS + MiB <= WS_PB && WS_HB + (size_t)MALL * FF * 2 <= WS_SACC && WS_SACC + SACC_BYTES <= WS_END, "d_ws map");
constexpr int CW_TMO = 0, CW_CODE = 1;
constexpr int CW_Q2 = 256, CW_Q5 = 512;
constexpr int CW_BAR = 4096;
constexpr int CW_KSUM = 16384;
constexpr int CW_SS1 = 49152, CW_SS2 = CW_SS1 + 16896, CW_SS3 = CW_SS2 + 16896;
constexpr int CW_SSD = CW_SS3 + 16896;
static_assert((CW_SSD + 16896) * 4 <= (int)CTL_ZERO_BYTES && CW_KSUM + 8 * 8 * 512 <= CW_SS1, "CTL words inside the memset region");

constexpr int RING_OFF = 0, RING_BYTES = 131072;
constexpr int LDSCTL_OFF = RING_BYTES, MISC_OFF = LDSCTL_OFF + 320;
constexpr int LDS_BYTES = 147456;
static_assert(MISC_OFF + 128 <= LDS_BYTES, "LDS map");

#define GAS __attribute__((address_space(1)))
#define LAS __attribute__((address_space(3)))
typedef unsigned short bf16;
typedef unsigned v4u __attribute__((ext_vector_type(4)));
typedef unsigned v2u __attribute__((ext_vector_type(2)));
typedef float f32x4 __attribute__((ext_vector_type(4)));
typedef short bf16x8 __attribute__((ext_vector_type(8)));
typedef GAS unsigned gu32;
typedef GAS unsigned long long gu64;
#define RLX_AGENT __ATOMIC_RELAXED, __HIP_MEMORY_SCOPE_AGENT
#define LDS_WAIT() asm volatile("s_waitcnt lgkmcnt(0)" ::: "memory")
#define VM_WAIT() asm volatile("s_waitcnt vmcnt(0)" ::: "memory")
__device__ __forceinline__ unsigned f2bf(float f) { unsigned u = __builtin_bit_cast(unsigned, f); return (u + 0x7fffu + ((u >> 16) & 1u)) >> 16; }
__device__ __forceinline__ unsigned pk2(float lo, float hi) { return f2bf(lo) | (f2bf(hi) << 16); }
__device__ __forceinline__ float bf2f(unsigned short b) { return __uint_as_float(((unsigned)b) << 16); }

#define XB_TMO      128
#define XB_XCNT(j)  (256  + 64 * (j))
#define XB_XSUB(j)  (1280 + 64 * (j))
#define XB_XGEN(j)  (2304 + 64 * (j))
#define XB_TOP      3328
#define XB_TOPGEN   3392
#define XCD_BAR_WORDS 3456
#define XB_SPIN_CAP (1u << 18)

__device__ __forceinline__ unsigned xb_ld(unsigned* p)              { return __hip_atomic_load(p, __ATOMIC_RELAXED, __HIP_MEMORY_SCOPE_AGENT); }
__device__ __forceinline__ unsigned xb_add(unsigned* p, unsigned v) { return __hip_atomic_fetch_add(p, v, __ATOMIC_RELAXED, __HIP_MEMORY_SCOPE_AGENT); }
__device__ __forceinline__ unsigned xb_xcc_id() { return (unsigned)__builtin_amdgcn_s_getreg((3 << 11) | 20) & 0xFu; }
#define XB_SPIN(cond, bar) do { unsigned _sp = 0; while (cond) { __builtin_amdgcn_s_sleep(1); \
    if ((++_sp & 255u) == 0u) { if (xb_ld(&(bar)[XB_TMO])) break; if (_sp > XB_SPIN_CAP) { atomicAdd(&(bar)[XB_TMO], 1u); break; } } } } while (0)

struct XcdBarrier {
    unsigned* bar; unsigned x;
    int wave;
    volatile LAS unsigned* st;
};

__device__ __forceinline__ bool xb_thread0(int wave) { return wave == 0 && __builtin_amdgcn_mbcnt_hi(~0u, __builtin_amdgcn_mbcnt_lo(~0u, 0u)) == 0u; }
__device__ __forceinline__ XcdBarrier xcd_barrier_post(unsigned* bar, volatile LAS unsigned* st, int wave) {
    XcdBarrier b; b.bar = bar; b.x = xb_xcc_id(); b.st = st; b.wave = wave;
    if (xb_thread0(wave)) (void)xb_add(&bar[XB_XCNT(b.x)], 1u);
    return b;
}
__device__ __forceinline__ void xcd_barrier_complete(unsigned* bar, unsigned x, unsigned& nloc, unsigned& nx) {
    const unsigned G = gridDim.x * gridDim.y * gridDim.z;
    unsigned sum, cnt, mine, sp = 0u;
    for (;;) {
        sum = 0u; cnt = 0u; mine = 0u;
#pragma unroll
        for (unsigned j = 0; j < 16; ++j) { const unsigned c = xb_ld(&bar[XB_XCNT(j)]); sum += c; cnt += (c > 0u) ? 1u : 0u; mine = (j == x) ? c : mine; }
        if (sum == G) break;
        __builtin_amdgcn_s_sleep(1);
        if ((++sp & 255u) == 0u) { if (xb_ld(&bar[XB_TMO])) break; if (sp > XB_SPIN_CAP) { atomicAdd(&bar[XB_TMO], 1u); break; } }
    }
    nloc = mine > 0u ? mine : 1u; nx = cnt > 0u ? cnt : 1u;
}

__device__ __forceinline__ void xcd_barrier(const XcdBarrier& b) {
    asm volatile("s_waitcnt vmcnt(0)" ::: "memory");
    __syncthreads();
    if (xb_thread0(b.wave)) {
        unsigned* bar = b.bar;
        __builtin_amdgcn_s_waitcnt(0);
        unsigned nloc = b.st[0], nx = b.st[1];
        if (nloc == 0u) { xcd_barrier_complete(bar, b.x, nloc, nx); b.st[0] = nloc; b.st[1] = nx; }
        const unsigned old = xb_add(&bar[XB_XSUB(b.x)], 1u);
        const unsigned gen = old / nloc;
        if (old + 1u == (gen + 1u) * nloc) {
            __builtin_amdgcn_fence(__ATOMIC_RELEASE, "agent");
            asm volatile("s_waitcnt vmcnt(0)" ::: "memory");
            const unsigned og = xb_add(&bar[XB_TOP], 1u);
            const unsigned tg = og / nx;
            if (og + 1u == (tg + 1u) * nx) xb_add(&bar[XB_TOPGEN], 1u);
            else XB_SPIN(xb_ld(&bar[XB_TOPGEN]) == tg, bar);
            __builtin_amdgcn_fence(__ATOMIC_ACQUIRE, "agent");
            xb_add(&bar[XB_XGEN(b.x)], 1u);
            asm volatile("s_waitcnt vmcnt(0)" ::: "memory");
        } else {
            XB_SPIN(xb_ld(&bar[XB_XGEN(b.x)]) == gen, bar);
            __builtin_amdgcn_fence(__ATOMIC_ACQUIRE, "agent");
            asm volatile("s_waitcnt vmcnt(0)" ::: "memory");
        }
    }
    __syncthreads();
}


struct Args { const void* in[24]; float* out; unsigned char* ws; int ph_lo, ph_hi; };
struct Frame {
    LAS unsigned char* lds;
    volatile LAS unsigned* MISC;
    gu32* ctl;
    int wave;
    int vcu, G;
    float* out;
    unsigned char* ws;
};
#define WSP(T, off) ((T*)(F.ws + (off)))
__device__ __forceinline__ int LANE() { return (int)__builtin_amdgcn_mbcnt_hi(~0u, __builtin_amdgcn_mbcnt_lo(~0u, 0u)); }
#define TID(F) ((F).wave * 64 + LANE())

__device__ __forceinline__ float xshfl(float v, int m, int lane) { return __builtin_bit_cast(float, __builtin_amdgcn_ds_bpermute((lane ^ m) << 2, __builtin_bit_cast(int, v))); }
__device__ __forceinline__ float wave_sum(float v, int lane) {
#pragma unroll
    for (int o = 1; o < 64; o <<= 1) v += xshfl(v, o, lane);
    return v;
}
__device__ __forceinline__ float wave_max(float v, int lane) {
#pragma unroll
    for (int o = 1; o < 64; o <<= 1) v = __builtin_fmaxf(v, xshfl(v, o, lane));
    return v;
}
__device__ __forceinline__ int win_dst_row(int n) { if (n < 512 || n >= 1536) return n; const int t = n & ~255, j = n & 255, hh = j >> 6, p = (j >> 5) & 1, i = j & 31; return t + 128 * p + 32 * hh + i; }
template <bool WINPERM> __device__ __forceinline__ void p0_transpose_item(const float* W, int K, int N, bf16* WT, int row_off, LAS float* scr, int item, int lane, const float* kgain = nullptr) {
    const int nblk = N / 32, kb = item / nblk, nb = item % nblk, k0 = 64 * kb, n0 = 32 * nb;
    float wv[32];
#pragma unroll
    for (int i = 0; i < 32; ++i) { const int kk = 2 * i + (lane >> 5); wv[i] = W[(size_t)(k0 + kk) * N + n0 + (lane & 31)]; }
    if (kgain) {
#pragma unroll
        for (int i = 0; i < 32; ++i) wv[i] *= kgain[k0 + 2 * i + (lane >> 5)]; }
#pragma unroll
    for (int i = 0; i < 32; ++i) { const int kk = 2 * i + (lane >> 5); scr[kk * 33 + (lane & 31)] = wv[i]; }
    LDS_WAIT(); asm volatile("" ::: "memory");
    const int c = lane & 7;
#pragma unroll
    for (int j = 0; j < 4; ++j) { const int n = (lane >> 3) + 8 * j; const LAS float* s = scr + (8 * c) * 33 + n;
        v4u o; o.x = pk2(s[0 * 33], s[1 * 33]); o.y = pk2(s[2 * 33], s[3 * 33]); o.z = pk2(s[4 * 33], s[5 * 33]); o.w = pk2(s[6 * 33], s[7 * 33]);
        const int drow = WINPERM ? win_dst_row(n0 + n) : (n0 + n);
        *(GAS v4u*)(WT + (size_t)(row_off + drow) * K + k0 + 8 * c) = o; }
    LDS_WAIT(); asm volatile("" ::: "memory");
}
__device__ __forceinline__ void rms_row_to_bf16(int lane, const float* xrow, const float* gain, bf16* orow, bf16* rawrow = nullptr) {
    const GAS f32x4* xr = (const GAS f32x4*)xrow + lane; const GAS f32x4* gr = (const GAS f32x4*)gain + lane;
    f32x4 v[4]; float s = 0.f;
#pragma unroll
    for (int j = 0; j < 4; ++j) { v[j] = xr[64 * j]; s += (v[j].x * v[j].x + v[j].y * v[j].y) + (v[j].z * v[j].z + v[j].w * v[j].w); }
    const float rstd = 1.f / sqrtf(wave_sum(s, lane) * (1.f / D) + EPS);
    GAS unsigned long long* o8 = (GAS unsigned long long*)orow + lane;
    if (rawrow) { GAS unsigned long long* r8 = (GAS unsigned long long*)rawrow + lane;
#pragma unroll
        for (int j = 0; j < 4; ++j) r8[64 * j] = (unsigned long long)pk2(v[j].x, v[j].y) | ((unsigned long long)pk2(v[j].z, v[j].w) << 32); }
#pragma unroll
    for (int j = 0; j < 4; ++j) { const f32x4 g = gr[64 * j]; o8[64 * j] = (unsigned long long)pk2(v[j].x * rstd * g.x, v[j].y * rstd * g.y) | ((unsigned long long)pk2(v[j].z * rstd * g.z, v[j].w * rstd * g.w) << 32); }
}
__device__ __forceinline__ void p0_prologue(Frame& F, const Args& A) {
    LAS float* scr = (LAS float*)(F.lds + RING_OFF + F.wave * 16384);
    const int gw = F.vcu * NWAVES + F.wave, NGW = F.G * NWAVES;
    bf16* WIN = WSP(bf16, WS_WIN);
    constexpr int I_IN = (D / 64) * (2048 / 32), I_SQ = (D / 64) * (D / 32), I_UP = (D / 64) * (FF / 32), I_DN = (FF / 64) * (D / 32), I_PL = (128 / 64) * (128 / 32);
    constexpr int NITEMS = I_IN + 5 * I_SQ + I_UP + I_DN + 4 * I_PL;
    for (int it = gw; it < NITEMS; it += NGW) {
        int r = it;
        if (r < I_IN) { p0_transpose_item<true>(((const float*)A.in[10]), D, 2048, WIN, 0, scr, r, LANE()); continue; } r -= I_IN;
        if (r < I_SQ) { p0_transpose_item<false>(((const float*)A.in[17]), D, D, WIN, 2048, scr, r, LANE()); continue; } r -= I_SQ;
        if (r < I_SQ) { p0_transpose_item<false>(((const float*)A.in[18]), D, D, WIN, 3072, scr, r, LANE()); continue; } r -= I_SQ;
        if (r < I_SQ) { p0_transpose_item<false>(((const float*)A.in[13]), D, D, WSP(bf16, WS_WOUT), 0, scr, r, LANE()); continue; } r -= I_SQ;
        if (r < I_SQ) { p0_transpose_item<false>(((const float*)A.in[16]), D, D, WSP(bf16, WS_WCQ), 0, scr, r, LANE(), ((const float*)A.in[14])); continue; }     r -= I_SQ;
        if (r < I_SQ) { p0_transpose_item<false>(((const float*)A.in[19]), D, D, WSP(bf16, WS_WCO), 0, scr, r, LANE()); continue; } r -= I_SQ;
        if (r < I_UP) { p0_transpose_item<false>(((const float*)A.in[21]), D, FF, WSP(bf16, WS_WUP), 0, scr, r, LANE(), ((const float*)A.in[20])); continue; }     r -= I_UP;
        if (r < I_DN) { p0_transpose_item<false>(((const float*)A.in[22]), FF, D, WSP(bf16, WS_WDN), 0, scr, r, LANE()); continue; } r -= I_DN;
        { const int g = r / I_PL; p0_transpose_item<false>(((const float*)A.in[11]) + (size_t)g * 128 * 128, 128, 128, WSP(bf16, WS_WPOOL) + (size_t)g * 128 * 128, 0, scr, r % I_PL, LANE()); }
    }
    bf16* XN = WSP(bf16, WS_XN);
    for (int m = gw; m < MP; m += 2 * NGW) { const int m2 = m + NGW; const int lane = LANE();
        const GAS f32x4* xa = (const GAS f32x4*)(((const float*)A.in[0]) + (size_t)m * D) + lane; const GAS f32x4* xb = (const GAS f32x4*)(((const float*)A.in[0]) + (size_t)(m2 < MP ? m2 : m) * D) + lane;
        const GAS f32x4* gr = (const GAS f32x4*)((const float*)A.in[9]) + lane;
        f32x4 va[4], vb[4]; float sa = 0.f, sb = 0.f;
#pragma unroll
        for (int j = 0; j < 4; ++j) { va[j] = xa[64 * j]; vb[j] = xb[64 * j]; }
#pragma unroll
        for (int j = 0; j < 4; ++j) { sa += (va[j].x * va[j].x + va[j].y * va[j].y) + (va[j].z * va[j].z + va[j].w * va[j].w); sb += (vb[j].x * vb[j].x + vb[j].y * vb[j].y) + (vb[j].z * vb[j].z + vb[j].w * vb[j].w); }
        const float ra = 1.f / sqrtf(wave_sum(sa, lane) * (1.f / D) + EPS), rb = 1.f / sqrtf(wave_sum(sb, lane) * (1.f / D) + EPS);
        GAS unsigned long long* oa = (GAS unsigned long long*)(XN + (size_t)m * D) + lane; GAS unsigned long long* ra8 = (GAS unsigned long long*)(WSP(bf16, WS_XB) + (size_t)m * D) + lane;
#pragma unroll
        for (int j = 0; j < 4; ++j) { const f32x4 g = gr[64 * j]; oa[64 * j] = (unsigned long long)pk2(va[j].x * ra * g.x, va[j].y * ra * g.y) | ((unsigned long long)pk2(va[j].z * ra * g.z, va[j].w * ra * g.w) << 32);
            ra8[64 * j] = (unsigned long long)pk2(va[j].x, va[j].y) | ((unsigned long long)pk2(va[j].z, va[j].w) << 32); }
        if (m2 < MP) { GAS unsigned long long* ob = (GAS unsigned long long*)(XN + (size_t)m2 * D) + lane; GAS unsigned long long* rb8 = (GAS unsigned long long*)(WSP(bf16, WS_XB) + (size_t)m2 * D) + lane;
#pragma unroll
            for (int j = 0; j < 4; ++j) { const f32x4 g = gr[64 * j]; ob[64 * j] = (unsigned long long)pk2(vb[j].x * rb * g.x, vb[j].y * rb * g.y) | ((unsigned long long)pk2(vb[j].z * rb * g.z, vb[j].w * rb * g.w) << 32);
                rb8[64 * j] = (unsigned long long)pk2(vb[j].x, vb[j].y) | ((unsigned long long)pk2(vb[j].z, vb[j].w) << 32); } }
    }
    for (int m = MP + gw; m < XNROWS; m += NGW) {
        if (m < MP + NS) rms_row_to_bf16(LANE(), ((const float*)A.in[1]) + (size_t)(m - MP) * D, ((const float*)A.in[9]), XN + (size_t)m * D);
        else if (m < MALL) { GAS unsigned long long* o8 = (GAS unsigned long long*)(XN + (size_t)m * D) + LANE(); o8[0] = 0ull; o8[64] = 0ull; o8[128] = 0ull; o8[192] = 0ull; }
        else rms_row_to_bf16(LANE(), ((const float*)A.in[8]) + (size_t)(m - MALL) * D, ((const float*)A.in[15]), XN + (size_t)m * D);
    }
    { float* rc = WSP(float, WS_ROPE); float* rs = rc + 2049 * 32; const int gt = F.vcu * (NWAVES * 64) + TID(F), NT = F.G * NWAVES * 64;
      for (int e = gt; e < 2049 * 32; e += NT) { const int pos = e >> 5, i = e & 31; const float invf = exp2f(-(float)i * (13.287712379549449f / 32.0f)); const double a = (double)pos * (double)invf; const double kq = __builtin_rint(a * 0.15915494309189535); const float rr = (float)(a - kq * 6.283185307179586); rc[e] = cosf(rr); rs[e] = sinf(rr); }
      { GAS f32x4* z = (GAS f32x4*)WSP(float, WS_SACC); for (int e = gt; e < (int)(SACC_BYTES / 16); e += NT) z[e] = (f32x4){0.f, 0.f, 0.f, 0.f}; }
      const GAS f32x4* sp = (const GAS f32x4*)((const float*)A.in[6]); GAS f32x4* po = (GAS f32x4*)(F.out + O_POOLS);
      for (int e = gt; e < NS * 14 * (PW / 4); e += NT) { const int s = e / (14 * 128), r = (e / 128) % 14, c = e & 127; po[(s * 15 + r) * 128 + c] = sp[(s * 15 + r + 1) * 128 + c]; } }
}
constexpr int POOL_LD = 136;
__device__ __forceinline__ void pool_mma_store(Frame& F, const Args& A, int row0, int g) {
    const LAS unsigned char* DB = F.lds + RING_OFF + 40960;
    const int fr = LANE() & 15, fq = LANE() >> 4, w = F.wave;
    const bf16* WP = WSP(bf16, WS_WPOOL) + (size_t)g * 128 * 128;
    f32x4 acc[8]; bf16x8 bw[4][8];
#pragma unroll
    for (int ks = 0; ks < 4; ++ks)
#pragma unroll
        for (int nb = 0; nb < 8; ++nb) bw[ks][nb] = *(const GAS bf16x8*)(WP + (size_t)(nb * 16 + fr) * 128 + ks * 32 + 8 * fq);
#pragma unroll
    for (int nb = 0; nb < 8; ++nb) acc[nb] = (f32x4){0.f, 0.f, 0.f, 0.f};
#pragma unroll
    for (int ks = 0; ks < 4; ++ks) {
        const bf16x8 a = *(const LAS bf16x8*)(DB + ((16 * w + fr) * POOL_LD + ks * 32 + 8 * fq) * 2);
#pragma unroll
        for (int nb = 0; nb < 8; ++nb) acc[nb] = __builtin_amdgcn_mfma_f32_16x16x32_bf16(bw[ks][nb], a, acc[nb], 0, 0, 0);
    }
    bf16* MIX = WSP(bf16, WS_MIX);
#pragma unroll
    for (int nb = 0; nb < 8; ++nb) { const int col = g * 128 + nb * 16 + 4 * fq; const f32x4 sp = *(const GAS f32x4*)(((const float*)A.in[12]) + col); const f32x4 v = acc[nb] * sp;
        v2u o; o.x = pk2(v[0], v[1]); o.y = pk2(v[2], v[3]); *(GAS v2u*)(MIX + (size_t)(row0 + 16 * w + fr) * D + col) = o; }
}
__device__ __forceinline__ void pool_unit(Frame& F, const Args& A, int L) {
    LAS unsigned short* UB = (LAS unsigned short*)(F.lds + RING_OFF);
    LAS unsigned short* DB = (LAS unsigned short*)(F.lds + RING_OFF + 40960);
    const int c = TID(F) & 127, strip = TID(F) >> 7;
    if (L < 512) {
        const int pnl = L >> 2, g = L & 3, r0 = pnl * 128, w = 2 << g; const bool first = (r0 & (SEQ - 1)) == 0;
        const bf16* U = WSP(bf16, WS_U);
        for (int e = TID(F); e < 144 * 16; e += NWAVES * 64) { const int rr = e >> 4, ch = e & 15; v4u v = {0u, 0u, 0u, 0u};
            if (!(first && rr < 16)) v = *(const GAS v4u*)(U + (size_t)(r0 - 16 + rr) * PW + g * 128 + ch * 8);
            *(LAS v4u*)(UB + rr * POOL_LD + ch * 8) = v; }
        LDS_WAIT(); __syncthreads();
        const int rs = strip * 32; float s = 0.f;
        for (int j = 1; j < w; ++j) s += bf2f(UB[(16 + rs - j) * POOL_LD + c]);
        const int pos0 = (r0 & (SEQ - 1)) + rs; const float invw = 1.0f / (float)w;
        for (int r = 0; r < 32; ++r) { const float uv = bf2f(UB[(16 + rs + r) * POOL_LD + c]); s += uv; const int pos = pos0 + r;
            const float inv = (pos + 1 >= w) ? invw : 1.0f / (float)(pos + 1);
            DB[(rs + r) * POOL_LD + c] = (unsigned short)f2bf(s * inv - uv); s -= bf2f(UB[(16 + rs + r - w + 1) * POOL_LD + c]); }
        LDS_WAIT(); __syncthreads();
        pool_mma_store(F, A, r0, g);
    } else {
        const int g = L - 512, w = 2 << g; const float invw = 1.0f / (float)w;
        const float* ps = WSP(float, WS_SACC + SA_PS);
        for (int r = 0; r < 32; ++r) { const int smp = strip * 32 + r; const float uv = ps[(size_t)smp * 2048 + g * 128 + c]; float s = uv;
            F.out[O_POOLS + (size_t)(smp * 15 + 14) * PW + g * 128 + c] = uv;
            for (int j = 1; j < w; ++j) s += ((const float*)A.in[6])[(size_t)(smp * 15 + 15 - j) * PW + g * 128 + c];
            DB[smp * POOL_LD + c] = (unsigned short)f2bf(s * invw - uv); }
        LDS_WAIT(); __syncthreads();
        pool_mma_store(F, A, MP, g);
    }
    LDS_WAIT(); __syncthreads();
}
#define TR_STAGE(src, dst, n, mask) _Pragma("unroll") for (int j_ = 0; j_ < (n); ++j_) { const bool hi_ = (lane & (mask)) != 0; const float snd_ = hi_ ? src[j_] : src[j_ + (n)]; const float kp_ = hi_ ? src[j_ + (n)] : src[j_]; dst[j_] = kp_ + xshfl(snd_, (mask), lane); }
__device__ __forceinline__ void sample_moba(Frame& F, const Args& A, int b) {
    int lane_ = LANE(); asm volatile("" : "+v"(lane_)); const int h = F.wave, lane = lane_, sub = lane & 15, rw = lane >> 4;
    LAS float* LG = (LAS float*)(F.lds + RING_OFF + h * 8192);
    const int* pt = ((const int*)A.in[7]) + b * NPAGES;
    const float* ps = WSP(float, WS_SACC + SA_PS) + (size_t)b * 2048;
    f32x4 qv, kn, vn;
    { const int i4 = 4 * (sub & 7); const float* rc = WSP(float, WS_ROPE) + 2048 * 32 + i4; const f32x4 c = *(const GAS f32x4*)rc, sn = *(const GAS f32x4*)(rc + 2049 * 32);
      const f32x4 q1 = *(const GAS f32x4*)(ps + 512 + h * 64 + i4), q2 = *(const GAS f32x4*)(ps + 512 + h * 64 + 32 + i4), k1 = *(const GAS f32x4*)(ps + 1024 + h * 64 + i4), k2 = *(const GAS f32x4*)(ps + 1024 + h * 64 + 32 + i4);
      qv = (sub < 8) ? (q1 * c - q2 * sn) : (q2 * c + q1 * sn); kn = (sub < 8) ? (k1 * c - k2 * sn) : (k2 * c + k1 * sn); vn = *(const GAS f32x4*)(ps + 1536 + h * 64 + 4 * sub);
      if (rw == 0) { *(GAS f32x4*)(F.out + O_KS + (size_t)b * 512 + h * 64 + 4 * sub) = kn; *(GAS f32x4*)(F.out + O_VS + (size_t)b * 512 + h * 64 + 4 * sub) = vn; }
      qv = qv * 0.125f; }
    LAS float* BS = (LAS float*)(F.lds + RING_OFF + 65536 + h * 64);
#pragma unroll 1
    for (int n = 0; n < 8; ++n) {
        float sacc = 0.f;
#pragma unroll 1
        for (int pg = 0; pg < 2; ++pg) { const int page = __builtin_amdgcn_readfirstlane(pt[2 * n + pg]);
            const float* base = ((const float*)A.in[2]) + ((size_t)page * PAGE * NH + h) * HD + 4 * sub;
            { f32x4 kv[32];
#pragma unroll
                for (int u = 0; u < 32; ++u) kv[u] = __builtin_nontemporal_load((const GAS f32x4*)(base + (size_t)(4 * u + rw) * (NH * HD)));
                float p32[32], p16[16], p8[8], p4[4], p2[2];
#pragma unroll
                for (int u = 0; u < 32; ++u) p32[u] = (kv[u][0] * qv[0] + kv[u][1] * qv[1]) + (kv[u][2] * qv[2] + kv[u][3] * qv[3]);
                TR_STAGE(p32, p16, 16, 8) TR_STAGE(p16, p8, 8, 4) TR_STAGE(p8, p4, 4, 2) TR_STAGE(p4, p2, 2, 1)
                const int u0 = ((lane >> 3) & 1) * 16 + ((lane >> 2) & 1) * 8 + ((lane >> 1) & 1) * 4 + (lane & 1) * 2;
                LG[n * 256 + pg * 128 + 4 * u0 + rw] = p2[0]; LG[n * 256 + pg * 128 + 4 * (u0 + 1) + rw] = p2[1]; sacc += p2[0] + p2[1]; } }
        sacc = wave_sum(sacc, lane); if (lane == 0) BS[n] = sacc;
    }
    LDS_WAIT();
    float bsum[8];
#pragma unroll
    for (int n = 0; n < 8; ++n) bsum[n] = BS[n];
    unsigned sel = 0u;
#pragma unroll
    for (int n = 0; n < 8; ++n) { int rk = 0;
#pragma unroll
        for (int m2 = 0; m2 < 8; ++m2) if (m2 != n) rk += (bsum[m2] > bsum[n] || (bsum[m2] == bsum[n] && m2 < n)) ? 1 : 0;
        if (rk < 3) sel |= 1u << n; }
    sel = __builtin_amdgcn_readfirstlane(sel);
    float pown = (kn[0] * qv[0] + kn[1] * qv[1]) + (kn[2] * qv[2] + kn[3] * qv[3]);
    pown += xshfl(pown, 1, lane); pown += xshfl(pown, 2, lane); pown += xshfl(pown, 4, lane); pown += xshfl(pown, 8, lane);
    LDS_WAIT();
    float mx = pown;
#pragma unroll
    for (int n = 0; n < 8; ++n) if ((sel >> n) & 1u) { const f32x4 l4 = *(const LAS f32x4*)(LG + n * 256 + 4 * lane); mx = __builtin_fmaxf(mx, __builtin_fmaxf(__builtin_fmaxf(l4[0], l4[1]), __builtin_fmaxf(l4[2], l4[3]))); }
    mx = wave_max(mx, lane);
    f32x4 oacc = {0.f, 0.f, 0.f, 0.f}; float lsum = 0.f;
#pragma unroll 1
    for (int n = 0; n < 8; ++n) if ((sel >> n) & 1u) {
#pragma unroll 1
        for (int pg = 0; pg < 2; ++pg) { const int page = __builtin_amdgcn_readfirstlane(pt[2 * n + pg]);
            const float* base = ((const float*)A.in[3]) + ((size_t)page * PAGE * NH + h) * HD + 4 * sub;
            { f32x4 vv[32];
#pragma unroll
                for (int u = 0; u < 32; ++u) vv[u] = __builtin_nontemporal_load((const GAS f32x4*)(base + (size_t)(4 * u + rw) * (NH * HD)));
#pragma unroll
                for (int u = 0; u < 32; ++u) { const float e = __expf(LG[n * 256 + pg * 128 + 4 * u + rw] - mx); lsum += e; oacc += vv[u] * e; } } } }
    { const float e = __expf(pown - mx); if (rw == 0) { lsum += e; oacc += vn * e; } }
    lsum += xshfl(lsum, 16, lane); lsum += xshfl(lsum, 32, lane);
#pragma unroll
    for (int j = 0; j < 4; ++j) { float v = oacc[j]; v += xshfl(v, 16, lane); v += xshfl(v, 32, lane); oacc[j] = v; }
    if (lane < 16) { const float inv = 1.0f / lsum; v2u o; o.x = pk2(oacc[0] * inv, oacc[1] * inv); o.y = pk2(oacc[2] * inv, oacc[3] * inv);
        *(GAS v2u*)(WSP(bf16, WS_MIX) + (size_t)(MP + b) * D + PW + h * 64 + 4 * sub) = o; }
    LDS_WAIT();
}
__device__ __forceinline__ void sample_cross(Frame& F, const Args& A, int b) {
    int lane_ = LANE(); asm volatile("" : "+v"(lane_)); const int lane = lane_, w = F.wave;
    LAS float* LG = (LAS float*)(F.lds + RING_OFF);
    LAS float* PO = (LAS float*)(F.lds + RING_OFF + 4096);
    f32x4 q[4];
#pragma unroll
    for (int hh = 0; hh < 4; ++hh) q[hh] = *(const GAS f32x4*)(WSP(float, WS_SACC + SA_AQ) + (size_t)b * D + hh * 256 + 4 * lane);
    const float* kb = ((const float*)A.in[4]) + (size_t)b * 256 * D;
    for (int k0 = 0; k0 < 32; k0 += 8) { f32x4 kv[8][4];
#pragma unroll
        for (int u = 0; u < 8; ++u)
#pragma unroll
            for (int hh = 0; hh < 4; ++hh) kv[u][hh] = __builtin_nontemporal_load((const GAS f32x4*)(kb + (size_t)(w + 8 * (k0 + u)) * D + hh * 256 + 4 * lane));
        float p32[32], p16[16], p8[8], p4[4], p2[2], p1[1];
#pragma unroll
        for (int u = 0; u < 8; ++u)
#pragma unroll
            for (int hh = 0; hh < 4; ++hh) p32[4 * u + hh] = (kv[u][hh][0] * q[hh][0] + kv[u][hh][1] * q[hh][1]) + (kv[u][hh][2] * q[hh][2] + kv[u][hh][3] * q[hh][3]);
        TR_STAGE(p32, p16, 16, 32) TR_STAGE(p16, p8, 8, 16) TR_STAGE(p8, p4, 4, 8) TR_STAGE(p4, p2, 2, 4) TR_STAGE(p2, p1, 1, 2)
        const float pv = p1[0] + xshfl(p1[0], 1, lane);
        const int ui = ((lane >> 5) & 1) * 16 + ((lane >> 4) & 1) * 8 + ((lane >> 3) & 1) * 4 + ((lane >> 2) & 1) * 2 + ((lane >> 1) & 1);
        if ((lane & 1) == 0) LG[(ui & 3) * 256 + w + 8 * (k0 + (ui >> 2))] = pv; }
    LDS_WAIT(); __syncthreads();
    if (w < 4) { const f32x4 l4 = *(const LAS f32x4*)(LG + w * 256 + 4 * lane); const float mx = wave_max(__builtin_fmaxf(__builtin_fmaxf(l4[0], l4[1]), __builtin_fmaxf(l4[2], l4[3])), lane);
        f32x4 e; e[0] = __builtin_amdgcn_exp2f(l4[0] - mx); e[1] = __builtin_amdgcn_exp2f(l4[1] - mx); e[2] = __builtin_amdgcn_exp2f(l4[2] - mx); e[3] = __builtin_amdgcn_exp2f(l4[3] - mx);
        const float inv = 1.0f / wave_sum((e[0] + e[1]) + (e[2] + e[3]), lane); *(LAS f32x4*)(LG + w * 256 + 4 * lane) = e * inv; }
    LDS_WAIT(); __syncthreads();
    const float* vb = ((const float*)A.in[5]) + (size_t)b * 256 * D;
    f32x4 oacc[4];
#pragma unroll
    for (int hh = 0; hh < 4; ++hh) oacc[hh] = (f32x4){0.f, 0.f, 0.f, 0.f};
    for (int k0 = 0; k0 < 32; k0 += 8) { f32x4 vv[8][4];
#pragma unroll
        for (int u = 0; u < 8; ++u)
#pragma unroll
            for (int hh = 0; hh < 4; ++hh) vv[u][hh] = __builtin_nontemporal_load((const GAS f32x4*)(vb + (size_t)(w + 8 * (k0 + u)) * D + hh * 256 + 4 * lane));
#pragma unroll
        for (int u = 0; u < 8; ++u)
#pragma unroll
            for (int hh = 0; hh < 4; ++hh) oacc[hh] += vv[u][hh] * LG[hh * 256 + w + 8 * (k0 + u)]; }
#pragma unroll
    for (int hh = 0; hh < 4; ++hh) *(LAS f32x4*)(PO + w * 1024 + hh * 256 + 4 * lane) = oacc[hh];
    LDS_WAIT(); __syncthreads();
    { const int c = 2 * (w * 64 + lane); float a0 = 0.f, a1 = 0.f;
#pragma unroll
      for (int ww = 0; ww < 8; ++ww) { a0 += PO[ww * 1024 + c]; a1 += PO[ww * 1024 + c + 1]; }
      *(GAS unsigned*)(WSP(bf16, WS_OC) + (size_t)(MP + b) * D + c) = pk2(a0, a1); }
    LDS_WAIT(); __syncthreads();
}
__device__ __forceinline__ void cross_unit(Frame& F, int pm, int h) {
    const int b = pm >> 3;
    bf16* PB = WSP(bf16, WS_PB) + (size_t)blockIdx.x * 65536;
    { pg8::Gemm g{WSP(bf16, WS_QC) + (size_t)pm * 256 * D + h * 256, WSP(bf16, WS_MKB) + (size_t)b * 256 * D + h * 256, 256, D, D};
      pg8::EpiSoftmaxP E{PB}; pg8::OneUnit S;
      pg8::gemm_phase<pg8::EpiSoftmaxP, pg8::OneUnit, false, false>(F.lds + RING_OFF, g, S, E, F.wave); }
    VM_WAIT(); __syncthreads(); __builtin_amdgcn_fence(__ATOMIC_ACQUIRE, "agent"); VM_WAIT(); __syncthreads();
    { pg8::Gemm g{PB, WSP(bf16, WS_MVT) + (size_t)(b * 4 + h) * 65536, 256, 256, 256};
      pg8::EpiTile E{WSP(bf16, WS_OC) + (size_t)pm * 256 * D + h * 256, D}; pg8::OneUnit S;
      pg8::gemm_phase<pg8::EpiTile, pg8::OneUnit, false, false>(F.lds + RING_OFF, g, S, E, F.wave); }
    VM_WAIT(); __syncthreads();
}
__device__ __forceinline__ void final_norm(Frame& F, const Args& A) {
    const int gw = F.vcu * NWAVES + F.wave, NGW = F.G * NWAVES; const float* ss3 = (const float*)(F.ctl + CW_SS3); const GAS f32x4* gr = (const GAS f32x4*)((const float*)A.in[23]) + LANE();
    for (int m = gw; m < MP; m += 2 * NGW) { const int m2 = (m + NGW < MP) ? m + NGW : m;
        GAS f32x4* xa = (GAS f32x4*)(F.out + O_YP + (size_t)m * D) + LANE(); GAS f32x4* xb = (GAS f32x4*)(F.out + O_YP + (size_t)m2 * D) + LANE();
        f32x4 va[4], vb[4];
#pragma unroll
        for (int j = 0; j < 4; ++j) { va[j] = xa[64 * j]; vb[j] = xb[64 * j]; }
        const float ra = 1.0f / sqrtf(ss3[m] * (1.0f / D) + EPS), rb = 1.0f / sqrtf(ss3[m2] * (1.0f / D) + EPS);
#pragma unroll
        for (int j = 0; j < 4; ++j) { const f32x4 g = gr[64 * j]; xa[64 * j] = va[j] * ra * g; if (m2 != m) xb[64 * j] = vb[j] * rb * g; } }
    for (int m = MP + gw; m < MP + NS; m += NGW) {
        if (m < MP) { }
        else { const int b = m - MP; const GAS f32x4* x0 = (const GAS f32x4*)(WSP(float, WS_SACC + SA_A1) + (size_t)b * D) + LANE(); const GAS f32x4* x3 = (const GAS f32x4*)(WSP(float, WS_SACC + SA_AD) + (size_t)b * D) + LANE();
            f32x4 v[4]; float ss = 0.f;
#pragma unroll
            for (int j = 0; j < 4; ++j) { v[j] = x0[64 * j] + x3[64 * j]; ss += (v[j][0] * v[j][0] + v[j][1] * v[j][1]) + (v[j][2] * v[j][2] + v[j][3] * v[j][3]); }
            const float r = 1.0f / sqrtf(wave_sum(ss, LANE()) * (1.0f / D) + EPS); GAS f32x4* yr = (GAS f32x4*)(F.out + O_YS + (size_t)b * D) + LANE();
#pragma unroll
            for (int j = 0; j < 4; ++j) yr[64 * j] = v[j] * r * gr[64 * j]; }
    }
}
enum { SG_STORE = 0, SG_RES = 1, SG_SCALE = 2, SG_RELU2 = 3, SG_ATOMIC = 4 };
struct SGP { float* OUT; bf16* OUTB; const float* base; const float* gain; float* rowss; float sc; };
__device__ __forceinline__ int win_src_col(int c) { if (c < 512 || c >= 1536) return c; const int t = c & ~255, j = c & 255, p = j >> 7, hh = (j >> 5) & 3, i = j & 31; return t + 64 * hh + 32 * p + i; }
template <int EPI, bool WINPERM, int NSPLIT> __device__ __forceinline__ void sample_gemm(Frame& F, const bf16* Ab, int lda, const bf16* Bt, int ldb, int N, int K, const SGP P) {
    static_assert(NSPLIT == 1 || EPI == SG_ATOMIC, "only the atomic epilogue may split K");
    const int nsl = N / 16, ksteps = K / 32 / NSPLIT;
    int lane_ = LANE(); asm volatile("" : "+v"(lane_)); const int lane = lane_, fr = lane & 15, fq = lane >> 4, row = 16 * F.wave + fr;
    for (int v = F.vcu; v < nsl * NSPLIT; v += F.G) { const int sl = v % nsl, sp = v / nsl;
        f32x4 acc = {0.f, 0.f, 0.f, 0.f};
        const bf16* ap = Ab + (size_t)row * lda + 8 * fq + (size_t)sp * ksteps * 32; const bf16* bp = Bt + (size_t)(16 * sl + fr) * ldb + 8 * fq + (size_t)sp * ksteps * 32;
        for (int kb = 0; kb < ksteps; kb += 16) { bf16x8 a[16], b[16];
#pragma unroll
            for (int u = 0; u < 16; ++u) { a[u] = *(const GAS bf16x8*)(ap + (kb + u) * 32); b[u] = *(const GAS bf16x8*)(bp + (kb + u) * 32); }
#pragma unroll
            for (int u = 0; u < 16; ++u) acc = __builtin_amdgcn_mfma_f32_16x16x32_bf16(b[u], a[u], acc, 0, 0, 0); }
        const int col = WINPERM ? win_src_col(16 * sl + 4 * fq) : 16 * sl + 4 * fq;
        if (EPI == SG_STORE) { *(GAS f32x4*)(P.OUT + (size_t)row * N + col) = acc; }
        else if (EPI == SG_ATOMIC) { float* o = P.OUT + (size_t)row * N + col; unsafeAtomicAdd(o, acc[0]); unsafeAtomicAdd(o + 1, acc[1]); unsafeAtomicAdd(o + 2, acc[2]); unsafeAtomicAdd(o + 3, acc[3]); }
        else if (EPI == SG_RES) { const f32x4 x = *(const GAS f32x4*)(P.base + (size_t)row * N + col) + acc; *(GAS f32x4*)(P.OUT + (size_t)row * N + col) = x;
            v2u o; o.x = pk2(x[0], x[1]); o.y = pk2(x[2], x[3]); *(GAS v2u*)(P.OUTB + (size_t)row * N + col) = o;
            float ss = (x[0] * x[0] + x[1] * x[1]) + (x[2] * x[2] + x[3] * x[3]); ss += xshfl(ss, 16, lane); ss += xshfl(ss, 32, lane); if (fq == 0) unsafeAtomicAdd(P.rowss + row, ss); }
        else { const float r = P.sc / sqrtf(P.rowss[row] * (1.0f / D) + EPS); f32x4 hv = acc * r;
            if (EPI == SG_SCALE) { *(GAS f32x4*)(P.OUT + (size_t)row * N + col) = hv; }
            else { hv = __builtin_elementwise_max(hv, (f32x4){0.f, 0.f, 0.f, 0.f}); hv = hv * hv; v2u o; o.x = pk2(hv[0], hv[1]); o.y = pk2(hv[2], hv[3]); *(GAS v2u*)(P.OUTB + (size_t)row * N + col) = o; } }
    }
}
__device__ __forceinline__ int next_task(Frame& F, gu32* head) {
    int slot = 16; asm volatile("" : "+v"(slot));
    __syncthreads();
    if (TID(F) + slot == 16) F.MISC[slot] = __hip_atomic_fetch_add(head, 1u, RLX_AGENT);
    __syncthreads();
    return __builtin_amdgcn_readfirstlane((int)F.MISC[slot]);
}
#ifndef REPMASK
#define REPMASK 0
#endif
#define NREP(k) (1 + ((REPMASK >> (k)) & 1))
#ifndef SKIPMASK
#define SKIPMASK 0
#endif
__global__ void __launch_bounds__(NWAVES * 64, 2) mk_fwd(Args args) {
    const Args& A = args;
    extern __shared__ __attribute__((aligned(16))) unsigned char lds[];
    Frame F;
    F.lds = (LAS unsigned char*)lds;
    F.MISC = (volatile LAS unsigned*)(F.lds + MISC_OFF);
    F.wave = __builtin_amdgcn_readfirstlane((int)(threadIdx.x >> 6));
    F.G = gridDim.x; { const int bx = blockIdx.x; F.vcu = (F.G % 8 == 0) ? (bx % 8) * (F.G / 8) + bx / 8 : bx; }
    F.ws = args.ws; F.out = args.out; F.ctl = (gu32*)(args.ws + WS_CTL);
    for (int u = TID(F); u < (LDS_BYTES - LDSCTL_OFF) / 4; u += NWAVES * 64) ((LAS unsigned*)(F.lds + LDSCTL_OFF))[u] = 0u;
    __syncthreads();
    XcdBarrier bar; bar.bar = (unsigned*)(F.ctl + CW_BAR); bar.x = 0; bar.st = nullptr; bar.wave = F.wave;
    if (N_LAUNCHES != PER_PHASE) bar = xcd_barrier_post((unsigned*)(F.ctl + CW_BAR), F.MISC + 8, F.wave);
#define GRID_BAR(seam) do { if (N_LAUNCHES == PER_PHASE) { if (TID(F) == 0) __hip_atomic_store(F.ctl + CW_TMO, 0xBADBA0u | (unsigned)(seam), RLX_AGENT); } else { xcd_barrier(bar); } } while (0)
    const int lo = args.ph_lo, hi = args.ph_hi;
#define IN(k) (lo <= (k) && (k) < hi)
#define BOTH(k) (IN(k) && IN((k) + 1))
    float* const ss1 = (float*)(F.ctl + CW_SS1); float* const ss2 = (float*)(F.ctl + CW_SS2); float* const ss3 = (float*)(F.ctl + CW_SS3);
    float* const X1S = WSP(float, WS_SACC + SA_A1);

    if (IN(0) && !(SKIPMASK & (1 << 0))) { for (int rp = 0; rp < NREP(0); ++rp) p0_prologue(F, A); if (BOTH(0)) GRID_BAR(0);
        if (NREP(16) > 1) { for (int rp = 0; rp < 10; ++rp) GRID_BAR(0); }
        if (NREP(17) > 1) { for (int rp = 0; rp < 20; ++rp) (void)next_task(F, F.ctl + 2048 + 64 * rp); } }

    if (IN(1) && !(SKIPMASK & (1 << 1))) {
        sample_gemm<SG_STORE, true, 1>(F, WSP(bf16, WS_XN) + (size_t)MP * D, D, WSP(bf16, WS_WIN), D, 2048, D, SGP{WSP(float, WS_SACC + SA_PS), nullptr, nullptr, nullptr, nullptr, 1.f});
        for (int rp = 0; rp < NREP(1); ++rp) {
        pg8::Gemm g{WSP(bf16, WS_XN), WSP(bf16, WS_WIN), D, D, D}; pg8::StaticOrder S; S.init(MP, 2048, F.G, (int)blockIdx.x);
        float* rc = WSP(float, WS_ROPE);
        pg8::EpiQKV E{WSP(bf16, WS_U), WSP(bf16, WS_Q), WSP(bf16, WS_K), WSP(bf16, WS_V), WSP(bf16, WS_MKB), WSP(bf16, WS_MVT), (float*)(F.ctl + CW_KSUM), rc, rc + 2049 * 32,
                      F.out + O_KP, F.out + O_VP, F.out + O_POOLP, F.out + O_MK, F.out + O_MV, attn_body::C2};
        pg8::gemm_phase<pg8::EpiQKV, pg8::StaticOrder, true, true>(F.lds + RING_OFF, g, S, E, F.wave);
        }
        if (BOTH(1)) GRID_BAR(1);
    }

    if (IN(2) && !(SKIPMASK & (1 << 2))) {
        const attn_body::AttnTensors AT{(const attn_body::bf16*)WSP(bf16, WS_Q), (const attn_body::bf16*)WSP(bf16, WS_K), (const attn_body::bf16*)WSP(bf16, WS_V), (attn_body::bf16*)(WSP(bf16, WS_MIX) + PW), D, (const float*)(F.ctl + CW_KSUM)};
        for (int rp = 0; rp < NREP(10); ++rp)
        for (;;) { const int t = next_task(F, F.ctl + rp * 1024 + CW_Q2); if (t >= NS) break; sample_moba(F, A, t); }
        for (int rp = 0; rp < NREP(11); ++rp)
        for (;;) { const int i = next_task(F, F.ctl + rp * 1024 + CW_Q2 + 64); if (i >= 64) break;
            pg8::Gemm g{WSP(bf16, WS_XN), WSP(bf16, WS_WIN), D, D, D}; pg8::OneUnitAt S{65 + (i & 7), 8 + (i >> 3)};
            float* rc = WSP(float, WS_ROPE);
            pg8::EpiQKV E{WSP(bf16, WS_U), WSP(bf16, WS_Q), WSP(bf16, WS_K), WSP(bf16, WS_V), WSP(bf16, WS_MKB), WSP(bf16, WS_MVT), (float*)(F.ctl + CW_KSUM), rc, rc + 2049 * 32,
                          F.out + O_KP, F.out + O_VP, F.out + O_POOLP, F.out + O_MK, F.out + O_MV, attn_body::C2};
            pg8::gemm_phase<pg8::EpiQKV, pg8::OneUnitAt, false, true>(F.lds + RING_OFF, g, S, E, F.wave); }
        for (int rp = 0; rp < NREP(12); ++rp)
        for (;;) { const int i = next_task(F, F.ctl + rp * 1024 + CW_Q2 + 128); if (i >= 512) break; const int qb = 7 - (i >> 6), bh = i & 63;
            attn_body::attn_unit<8>(bh >> 3, bh & 7, qb, AT.Q, AT.K, AT.V, AT.O, AT.opitch, AT.KS, (char*)lds + RING_OFF, F.wave); }
        for (int rp = 0; rp < NREP(13); ++rp)
        for (;;) { const int i = next_task(F, F.ctl + rp * 1024 + CW_Q2 + 192); if (i >= 516) break; pool_unit(F, A, i); }
        if (BOTH(2)) GRID_BAR(2);
    }

    if (IN(3) && !(SKIPMASK & (1 << 3))) {
        sample_gemm<SG_RES, false, 1>(F, WSP(bf16, WS_MIX) + (size_t)MP * D, D, WSP(bf16, WS_WOUT), D, D, D, SGP{X1S, WSP(bf16, WS_XG) + (size_t)MP * D, ((const float*)A.in[1]), nullptr, ss1 + MP, 1.f});
        pg8::Gemm g{WSP(bf16, WS_MIX), WSP(bf16, WS_WOUT), D, D, D}; pg8::StaticOrder S; S.init(MP, D, F.G, (int)blockIdx.x);
        pg8::EpiResB E{WSP(bf16, WS_XB), WSP(bf16, WS_XG), nullptr, ss1};
        pg8::gemm_phase<pg8::EpiResB, pg8::StaticOrder, true, true>(F.lds + RING_OFF, g, S, E, F.wave);
        if (BOTH(3)) GRID_BAR(3);
    }
    if (IN(4) && !(SKIPMASK & (1 << 4))) {
        sample_gemm<SG_SCALE, false, 1>(F, WSP(bf16, WS_XG) + (size_t)MP * D, D, WSP(bf16, WS_WCQ), D, D, D, SGP{WSP(float, WS_SACC + SA_AQ), nullptr, nullptr, nullptr, ss1 + MP, CROSS_C2});
        for (int rp = 0; rp < NREP(4); ++rp) {
        pg8::Gemm g{WSP(bf16, WS_XG), WSP(bf16, WS_WCQ), D, D, D}; pg8::StaticOrder S; S.init(MP, D, F.G, (int)blockIdx.x);
        pg8::EpiScale<0> E{WSP(bf16, WS_QC), D, ss1, CROSS_C2};
        pg8::gemm_phase<pg8::EpiScale<0>, pg8::StaticOrder, true, true>(F.lds + RING_OFF, g, S, E, F.wave);
        }
        if (BOTH(4)) GRID_BAR(4);
    }
    if (IN(5) && !(SKIPMASK & (1 << 5))) {
        for (int rp = 0; rp < NREP(14); ++rp)
        for (;;) { const int t = next_task(F, F.ctl + rp * 1024 + CW_Q5); if (t >= NS) break; sample_cross(F, A, t); }
        for (int rp = 0; rp < NREP(15); ++rp)
        for (;;) { const int L = next_task(F, F.ctl + rp * 1024 + CW_Q5 + 64); if (L >= 256) break; cross_unit(F, L >> 2, L & 3); }
        if (BOTH(5)) GRID_BAR(5);
    }
    if (IN(6) && !(SKIPMASK & (1 << 6))) {
        sample_gemm<SG_RES, false, 1>(F, WSP(bf16, WS_OC) + (size_t)MP * D, D, WSP(bf16, WS_WCO), D, D, D, SGP{X1S, WSP(bf16, WS_XG) + (size_t)MP * D, X1S, nullptr, ss2 + MP, 1.f});
        pg8::Gemm g{WSP(bf16, WS_OC), WSP(bf16, WS_WCO), D, D, D}; pg8::StaticOrder S; S.init(MP, D, F.G, (int)blockIdx.x);
        pg8::EpiResB E{WSP(bf16, WS_XG), WSP(bf16, WS_XG), nullptr, ss2};
        pg8::gemm_phase<pg8::EpiResB, pg8::StaticOrder, true, true>(F.lds + RING_OFF, g, S, E, F.wave);
        if (BOTH(6)) GRID_BAR(6);
    }
    if (IN(7) && !(SKIPMASK & (1 << 7))) {
        sample_gemm<SG_RELU2, false, 1>(F, WSP(bf16, WS_XG) + (size_t)MP * D, D, WSP(bf16, WS_WUP), D, FF, D, SGP{nullptr, WSP(bf16, WS_HBS), nullptr, nullptr, ss2 + MP, 1.f});
        for (int rp = 0; rp < NREP(7); ++rp) {
        pg8::Gemm g{WSP(bf16, WS_XG), WSP(bf16, WS_WUP), D, D, D}; pg8::StaticOrder S; S.init(MP, FF, F.G, (int)blockIdx.x);
        pg8::EpiScale<1> E{WSP(bf16, WS_HB), FF, ss2, 1.0f};
        pg8::gemm_phase<pg8::EpiScale<1>, pg8::StaticOrder, true, true>(F.lds + RING_OFF, g, S, E, F.wave);
        }
        if (BOTH(7)) GRID_BAR(7);
    }
    if (IN(8) && !(SKIPMASK & (1 << 8))) {
        sample_gemm<SG_ATOMIC, false, 4>(F, WSP(bf16, WS_HBS), FF, WSP(bf16, WS_WDN), FF, D, FF, SGP{WSP(float, WS_SACC + SA_AD), nullptr, nullptr, nullptr, nullptr, 1.f});
        pg8::Gemm g{WSP(bf16, WS_HB), WSP(bf16, WS_WDN), FF, FF, FF}; pg8::StaticOrder S; S.init(MP, D, F.G, (int)blockIdx.x);
        pg8::EpiResB E{WSP(bf16, WS_XG), nullptr, F.out + O_YP, ss3};
        pg8::gemm_phase<pg8::EpiResB, pg8::StaticOrder, true, true>(F.lds + RING_OFF, g, S, E, F.wave);
        if (BOTH(8)) GRID_BAR(8);
    }
    if (IN(9) && !(SKIPMASK & (1 << 9))) { final_norm(F, A); }
#undef IN
#undef BOTH
}

extern "C" void kernel_launch(void* const* d_in, const int* in_sizes, int n_in, void* d_out, int out_size, void* d_ws, size_t ws_size, hipStream_t stream) {
    static int grid = 0;
    if (grid == 0) {
        if (n_in != 24 || in_sizes[0] != MP * D || (size_t)out_size != O_END || ws_size < WS_END) { fprintf(stderr, "kernel_launch: unexpected shapes: n_in %d in0 %d out %d ws %zu; nothing launched\n", n_in, n_in > 0 ? in_sizes[0] : -1, out_size, ws_size); grid = -1; return; }
        int dev = 0, cus = 0, per_cu = 0;
        if (hipGetDevice(&dev) != hipSuccess || hipDeviceGetAttribute(&cus, hipDeviceAttributeMultiprocessorCount, dev) != hipSuccess) { fprintf(stderr, "kernel_launch: hipGetDevice / hipDeviceGetAttribute failed\n"); grid = -1; return; }
        if (hipFuncSetAttribute((const void*)mk_fwd, hipFuncAttributeMaxDynamicSharedMemorySize, LDS_BYTES) != hipSuccess) { fprintf(stderr, "kernel_launch: hipFuncSetAttribute failed\n"); grid = -1; return; }
        if (hipOccupancyMaxActiveBlocksPerMultiprocessor(&per_cu, (const void*)mk_fwd, NWAVES * 64, LDS_BYTES) != hipSuccess || per_cu < 1) { fprintf(stderr, "kernel_launch: occupancy query reports %d workgroups per CU\n", per_cu); }
        (void)hipGetLastError();
        grid = cus;
        if (grid > 256) grid = 256;
    }
    if (grid < 0) return;
    if (hipMemsetAsync((char*)d_ws + WS_CTL, 0, CTL_ZERO_BYTES, stream) != hipSuccess) { fprintf(stderr, "kernel_launch: hipMemsetAsync failed\n"); return; }
    Args a{};
    for (int i = 0; i < 24; ++i) a.in[i] = d_in[i];
    a.out = (float*)d_out; a.ws = (unsigned char*)d_ws;
    for (int li = 0; li < N_LAUNCHES; ++li) {
        a.ph_lo = (N_LAUNCHES == PER_PHASE) ? li : 0; a.ph_hi = (N_LAUNCHES == PER_PHASE) ? li + 1 : PER_PHASE;
        hipLaunchKernelGGL(mk_fwd, dim3(grid), dim3(NWAVES * 64), LDS_BYTES, stream, a);
        const hipError_t le = hipPeekAtLastError();
        if (le != hipSuccess) { fprintf(stderr, "kernel_launch: launch %d failed: %s\n", li, hipGetErrorName(le)); break; }
    }
}
```
